# Optimizing an MI355X kernel written in HIP

```python
import jax, jax.numpy as jnp
from jax import lax
import numpy as np

D_MODEL = 2048
BATCH = 4
SEQ = 8192
DEPTH = 4

GRID_W = 64
CTX_LEN = 256
N_MIXERS = 4
HEAD_DIM = 128
N_HEADS = D_MODEL // HEAD_DIM
NA_ROWS = 8
NA_COLS = 16
SWA_KV_HEADS = 2
SWA_WINDOW = 128
BLOCK = 128
GQA_KV_HEADS = 4
ML_HEADS = 4
ML_V_DIM = D_MODEL // ML_HEADS
ML_QK_DIM = ML_V_DIM // 2
ML_CHUNK = 64
ML_FGATE_BIAS = 3.0
D_FF = 5632
CONV_W = 3
ROPE_BASE = 10000.0
NORM_EPS = 1e-6
NEG_INF = -1e30

kernel_name = 'hybrid_diffusion_backbone'


def rms_norm(x, g):
    xf = x.astype(jnp.float32)
    y = xf * lax.rsqrt(jnp.mean(xf * xf, axis=-1, keepdims=True) + NORM_EPS)
    return (y * g.astype(jnp.float32)).astype(x.dtype)


def adaln(cond, w, b):
    return jnp.split(jax.nn.silu(cond) @ w + b, 6, axis=-1)


def modulate(h, shift, scale):
    return h * (1 + scale) + shift


def axial_rope_tables(n_tokens):
    t = jnp.arange(n_tokens)
    row = (t // GRID_W).astype(jnp.float32)
    col = (t % GRID_W).astype(jnp.float32)
    n_freq = HEAD_DIM // 4
    inv = ROPE_BASE ** (-jnp.arange(n_freq, dtype=jnp.float32) / n_freq)
    ang = jnp.stack([row[:, None] * inv, col[:, None] * inv], axis=1)
    return jnp.cos(ang), jnp.sin(ang)


def apply_rope(x, cos, sin):
    B, T, H, Dh = x.shape
    xr = x.astype(jnp.float32).reshape(B, T, H, 2, 2, Dh // 4)
    x1, x2 = xr[..., 0, :], xr[..., 1, :]
    c, s = cos[None, :, None], sin[None, :, None]
    out = jnp.stack([x1 * c - x2 * s, x2 * c + x1 * s], axis=-2)
    return out.reshape(B, T, H, Dh).astype(x.dtype)


def softmax_with_sink(s, sink):
    if sink is None:
        return jax.nn.softmax(s, axis=-1)
    m = jnp.maximum(jnp.max(s, axis=-1, keepdims=True), sink)
    e = jnp.exp(s - m)
    return e / (jnp.sum(e, axis=-1, keepdims=True) + jnp.exp(sink - m))


def multi_source_attention(q, sources, sink=None):
    scale = q.shape[-1] ** -0.5
    scores = []
    for k, _, mask in sources:
        s = jnp.einsum('bqngd,bknd->bngqk', q, k, preferred_element_type=jnp.float32) * scale
        scores.append(s if mask is None else jnp.where(mask, s, NEG_INF))
    p = softmax_with_sink(jnp.concatenate(scores, axis=-1), sink)
    out, start = None, 0
    for (_, v, _), s in zip(sources, scores):
        n = s.shape[-1]
        o = jnp.einsum('bngqk,bknd->bqngd', p[..., start:start + n].astype(v.dtype), v)
        out = o if out is None else out + o
        start += n
    return out


def project_gqa(h, w_qkv, q_g, k_g, n_kv):
    B, T, _ = h.shape
    q, k, v = jnp.split(h @ w_qkv, [N_HEADS * HEAD_DIM, (N_HEADS + n_kv) * HEAD_DIM], axis=-1)
    q = rms_norm(q.reshape(B, T, N_HEADS, HEAD_DIM), q_g)
    k = rms_norm(k.reshape(B, T, n_kv, HEAD_DIM), k_g)
    return q, k, v.reshape(B, T, n_kv, HEAD_DIM)


def group_heads(q, n_kv):
    B, T = q.shape[:2]
    return q.reshape(B, T, n_kv, N_HEADS // n_kv, HEAD_DIM)


def context_self_attention(qc, kc, vc, n_kv, w_o, sink=None):
    B, L = qc.shape[:2]
    o = multi_source_attention(group_heads(qc, n_kv), [(kc, vc, None)], sink)
    return o.reshape(B, L, D_MODEL) @ w_o


def neighbourhood_attention(hx, hc, w_qkv, q_g, k_g, rel_bias, w_o, need_ctx):
    B, S, _ = hx.shape
    rows = S // GRID_W
    kr = min(NA_ROWS, rows)
    q, k, v = project_gqa(hx, w_qkv, q_g, k_g, N_HEADS)
    qc, kc, vc = project_gqa(hc, w_qkv, q_g, k_g, N_HEADS)
    scale = HEAD_DIM ** -0.5
    qg = q.reshape(B, rows, GRID_W, N_HEADS, HEAD_DIM)
    kg = k.reshape(B, rows, GRID_W, N_HEADS, HEAD_DIM)
    vg = v.reshape(B, rows, GRID_W, N_HEADS, HEAD_DIM)
    row_start = jnp.clip(jnp.arange(rows) - kr // 2, 0, rows - kr)
    qcol = jnp.arange(GRID_W)
    col_idx = jnp.clip(qcol - NA_COLS // 2, 0, GRID_W - NA_COLS)[:, None] + jnp.arange(NA_COLS)
    dcol = col_idx - qcol[:, None] + (NA_COLS - 1)
    rb = rel_bias.astype(jnp.float32)
    n_loc = kr * NA_COLS

    def one_row(r):
        r0 = row_start[r]
        k_win = lax.dynamic_slice_in_dim(kg, r0, kr, axis=1)[:, :, col_idx]
        v_win = lax.dynamic_slice_in_dim(vg, r0, kr, axis=1)[:, :, col_idx]
        q_r = lax.dynamic_index_in_dim(qg, r, axis=1, keepdims=False)
        drow = r0 + jnp.arange(kr) - r + (NA_ROWS - 1)
        bias = rb[:, drow[None, :, None], dcol[:, None, :]]
        s_loc = jnp.einsum('bqhd,brqkhd->bhqrk', q_r, k_win, preferred_element_type=jnp.float32) * scale + bias
        s_ctx = jnp.einsum('bqhd,blhd->bhql', q_r, kc, preferred_element_type=jnp.float32) * scale
        p = jax.nn.softmax(jnp.concatenate([s_loc.reshape(B, N_HEADS, GRID_W, n_loc), s_ctx], axis=-1), axis=-1)
        p_loc = p[..., :n_loc].reshape(B, N_HEADS, GRID_W, kr, NA_COLS).astype(v.dtype)
        return (jnp.einsum('bhqrk,brqkhd->bqhd', p_loc, v_win)
                + jnp.einsum('bhql,blhd->bqhd', p[..., n_loc:].astype(v.dtype), vc))

    o = lax.map(one_row, jnp.arange(rows))
    out_x = jnp.moveaxis(o, 0, 1).reshape(B, S, D_MODEL) @ w_o
    out_c = context_self_attention(qc, kc, vc, N_HEADS, w_o) if need_ctx else None
    return out_x, out_c


def sliding_window_attention(hx, hc, w_qkv, q_g, k_g, sinks, w_o, cos, sin, need_ctx):
    B, S, _ = hx.shape
    q, k, v = project_gqa(hx, w_qkv, q_g, k_g, SWA_KV_HEADS)
    qc, kc, vc = project_gqa(hc, w_qkv, q_g, k_g, SWA_KV_HEADS)
    qb = group_heads(apply_rope(q, cos, sin), SWA_KV_HEADS)
    pad = ((0, 0), (BLOCK, BLOCK), (0, 0), (0, 0))
    k_pad = jnp.pad(apply_rope(k, cos, sin), pad)
    v_pad = jnp.pad(v, pad)
    rel = jnp.arange(3 * BLOCK)[None, :] - BLOCK - jnp.arange(BLOCK)[:, None]
    band = jnp.abs(rel) <= SWA_WINDOW
    sink = sinks.astype(jnp.float32).reshape(SWA_KV_HEADS, N_HEADS // SWA_KV_HEADS)[None, :, :, None, None]

    def one_block(i):
        start = i * BLOCK
        q_blk = lax.dynamic_slice_in_dim(qb, start, BLOCK, axis=1)
        k_blk = lax.dynamic_slice_in_dim(k_pad, start, 3 * BLOCK, axis=1)
        v_blk = lax.dynamic_slice_in_dim(v_pad, start, 3 * BLOCK, axis=1)
        kpos = start - BLOCK + jnp.arange(3 * BLOCK)
        mask = band & ((kpos >= 0) & (kpos < S))[None, :]
        return multi_source_attention(q_blk, [(k_blk, v_blk, mask), (kc, vc, None)], sink)

    o = lax.map(one_block, jnp.arange(S // BLOCK))
    out_x = jnp.moveaxis(o, 0, 1).reshape(B, S, D_MODEL) @ w_o
    out_c = context_self_attention(qc, kc, vc, SWA_KV_HEADS, w_o, sink) if need_ctx else None
    return out_x, out_c


def dense_gqa_attention(hx, hc, w_qkv, q_g, k_g, w_o, cos, sin, need_ctx):
    B, S, _ = hx.shape
    q, k, v = project_gqa(hx, w_qkv, q_g, k_g, GQA_KV_HEADS)
    qc, kc, vc = project_gqa(hc, w_qkv, q_g, k_g, GQA_KV_HEADS)
    qb = group_heads(apply_rope(q, cos, sin), GQA_KV_HEADS)
    k = apply_rope(k, cos, sin)

    def one_block(i):
        q_blk = lax.dynamic_slice_in_dim(qb, i * BLOCK, BLOCK, axis=1)
        return multi_source_attention(q_blk, [(k, v, None), (kc, vc, None)])

    o = lax.map(one_block, jnp.arange(S // BLOCK))
    out_x = jnp.moveaxis(o, 0, 1).reshape(B, S, D_MODEL) @ w_o
    out_c = context_self_attention(qc, kc, vc, GQA_KV_HEADS, w_o) if need_ctx else None
    return out_x, out_c


def mlstm_scan(q, k, v, log_i, log_f, state, emit):
    B, T = q.shape[:2]
    nc = T // ML_CHUNK

    def chunks(a):
        return jnp.moveaxis(a.reshape((B, nc, ML_CHUNK) + a.shape[2:]), 1, 0)

    lower = jnp.tril(jnp.ones((ML_CHUNK, ML_CHUNK), dtype=bool))

    def step(carry, xs):
        C, n, m = carry
        qc, kc, vc, lic, lfc = xs
        b = jnp.moveaxis(jnp.cumsum(lfc, axis=1), 1, 2)
        li = jnp.moveaxis(lic, 1, 2)
        out = None
        if emit:
            dmat = jnp.where(lower, b[..., :, None] - b[..., None, :] + li[..., None, :], NEG_INF)
            g = b + m[..., None]
            m_t = jnp.maximum(g, jnp.max(dmat, axis=-1))
            w = jnp.exp(dmat - m_t[..., None]) * jnp.einsum('bthd,bshd->bhts', qc, kc)
            w_prev = jnp.exp(g - m_t)
            num = jnp.einsum('bhts,bshv->bhtv', w, vc) + w_prev[..., None] * jnp.einsum('bthd,bhdv->bhtv', qc, C)
            den = jnp.sum(w, axis=-1) + w_prev * jnp.einsum('bthd,bhd->bht', qc, n)
            h = num / jnp.maximum(jnp.abs(den), jnp.exp(-m_t))[..., None]
            out = jnp.moveaxis(h, 1, 2)
        b_end = b[..., -1]
        lw = b_end[..., None] - b + li
        m_new = jnp.maximum(b_end + m, jnp.max(lw, axis=-1))
        decay = jnp.exp(b_end + m - m_new)
        ws = jnp.exp(lw - m_new[..., None])
        C_new = decay[..., None, None] * C + jnp.einsum('bhs,bshd,bshv->bhdv', ws, kc, vc)
        n_new = decay[..., None] * n + jnp.einsum('bhs,bshd->bhd', ws, kc)
        return (C_new, n_new, m_new), out

    state, hs = lax.scan(step, state, tuple(chunks(a) for a in (q, k, v, log_i, log_f)))
    if emit:
        hs = jnp.moveaxis(hs, 0, 1).reshape(B, T, ML_HEADS, ML_V_DIM)
    return hs, state


def mlstm_mixer(hx, hc, w_in, gate_b, head_g, w_o, need_ctx):
    f32 = jnp.float32
    qk, vd = ML_HEADS * ML_QK_DIM, ML_HEADS * ML_V_DIM

    def project(h):
        B, T, _ = h.shape
        q, k, v, o, gates = jnp.split(h @ w_in, [qk, 2 * qk, 2 * qk + vd, 2 * qk + 2 * vd], axis=-1)
        q = q.reshape(B, T, ML_HEADS, ML_QK_DIM).astype(f32)
        k = k.reshape(B, T, ML_HEADS, ML_QK_DIM).astype(f32) * ML_QK_DIM ** -0.5
        v = v.reshape(B, T, ML_HEADS, ML_V_DIM).astype(f32)
        gates = (gates.astype(f32) + gate_b.astype(f32)).reshape(B, T, 4, ML_HEADS)
        fwd = (gates[:, :, 0], jax.nn.log_sigmoid(gates[:, :, 1]))
        bwd = (gates[:, :, 2], jax.nn.log_sigmoid(gates[:, :, 3]))
        return (q, k, v), o, fwd, bwd

    def flip(a):
        return jnp.flip(a, axis=1)

    def run_both(qkv, fwd, bwd, st_f, st_b, emit):
        h_f, st_f = mlstm_scan(*qkv, *fwd, st_f, emit)
        h_b, st_b = mlstm_scan(*(flip(a) for a in qkv), *(flip(a) for a in bwd), st_b, emit)
        h = (h_f + flip(h_b)) if emit else None
        return h, st_f, st_b

    def read_out(h, o):
        B, T = h.shape[:2]
        hn = rms_norm(h, head_g.reshape(ML_HEADS, ML_V_DIM)).reshape(B, T, vd).astype(o.dtype)
        return (jax.nn.sigmoid(o) * hn) @ w_o

    qkv_x, o_x, fwd_x, bwd_x = project(hx)
    qkv_c, o_c, fwd_c, bwd_c = project(hc)
    B = hx.shape[0]
    init = (jnp.zeros((B, ML_HEADS, ML_QK_DIM, ML_V_DIM), f32),
            jnp.zeros((B, ML_HEADS, ML_QK_DIM), f32),
            jnp.zeros((B, ML_HEADS), f32))
    h_c, st_f, st_b = run_both(qkv_c, fwd_c, bwd_c, init, init, need_ctx)
    h_x, _, _ = run_both(qkv_x, fwd_x, bwd_x, st_f, st_b, True)
    out_x = read_out(h_x, o_x)
    out_c = read_out(h_c, o_c) if need_ctx else None
    return out_x, out_c


def conv_glu(h, w_in, conv_w, conv_b, w_out):
    T = h.shape[1]
    g, u = jnp.split(h @ w_in, 2, axis=-1)
    pad = CONV_W // 2
    gp = jnp.pad(g, ((0, 0), (pad, pad), (0, 0)))
    gc = conv_b
    for j in range(CONV_W):
        gc = gc + gp[:, j:j + T] * conv_w[j]
    return (jax.nn.gelu(gc) * u) @ w_out


def setup_inputs(seed: int = 0) -> dict:
    key = jax.random.key(seed)
    ks = iter(jax.random.split(key, 48))
    f32 = jnp.float32
    D = D_MODEL

    def nrm(shape, scale):
        return scale * jax.random.normal(next(ks), shape, f32)

    def gain(shape):
        return 1.0 + nrm(shape, 0.02)

    nA, nB, nC, nD = (len(range(m, DEPTH, N_MIXERS)) for m in range(N_MIXERS))
    hd = N_HEADS * HEAD_DIM
    w_swa = (N_HEADS + 2 * SWA_KV_HEADS) * HEAD_DIM
    w_gqa = (N_HEADS + 2 * GQA_KV_HEADS) * HEAD_DIM
    w_ml = 2 * ML_HEADS * ML_QK_DIM + 2 * ML_HEADS * ML_V_DIM + 4 * ML_HEADS
    gate_base = jnp.array([0.0, ML_FGATE_BIAS, 0.0, ML_FGATE_BIAS], f32)[None, :, None]
    return {
        'x': nrm((BATCH, SEQ, D), 1.0),
        'c': nrm((BATCH, D), 1.0),
        'ctx': nrm((BATCH, CTX_LEN, D), 1.0),
        'c_ctx': nrm((D,), 1.0),
        'ada_w': nrm((DEPTH, D, 6 * D), 0.5 * D ** -0.5),
        'ada_b': nrm((DEPTH, 6 * D), 0.02),
        'norm1_g': gain((DEPTH, D)),
        'norm2_g': gain((DEPTH, D)),
        'ffn_w_in': nrm((DEPTH, D, 2 * D_FF), D ** -0.5),
        'ffn_conv_w': nrm((DEPTH, CONV_W, D_FF), CONV_W ** -0.5),
        'ffn_conv_b': nrm((DEPTH, D_FF), 0.02),
        'ffn_w_out': nrm((DEPTH, D_FF, D), D_FF ** -0.5),
        'na_w_qkv': nrm((nA, D, 3 * hd), D ** -0.5),
        'na_q_g': gain((nA, HEAD_DIM)),
        'na_k_g': gain((nA, HEAD_DIM)),
        'na_rel_bias': nrm((nA, N_HEADS, 2 * NA_ROWS - 1, 2 * NA_COLS - 1), 0.1),
        'na_w_o': nrm((nA, hd, D), hd ** -0.5),
        'swa_w_qkv': nrm((nB, D, w_swa), D ** -0.5),
        'swa_q_g': gain((nB, HEAD_DIM)),
        'swa_k_g': gain((nB, HEAD_DIM)),
        'swa_sinks': nrm((nB, N_HEADS), 1.0),
        'swa_w_o': nrm((nB, hd, D), hd ** -0.5),
        'ml_w_in': nrm((nC, D, w_ml), D ** -0.5),
        'ml_gate_b': (gate_base + nrm((nC, 4, ML_HEADS), 0.1)).reshape(nC, 4 * ML_HEADS),
        'ml_head_g': gain((nC, ML_HEADS * ML_V_DIM)),
        'ml_w_o': nrm((nC, ML_HEADS * ML_V_DIM, D), (ML_HEADS * ML_V_DIM) ** -0.5),
        'gqa_w_qkv': nrm((nD, D, w_gqa), D ** -0.5),
        'gqa_q_g': gain((nD, HEAD_DIM)),
        'gqa_k_g': gain((nD, HEAD_DIM)),
        'gqa_w_o': nrm((nD, hd, D), hd ** -0.5),
    }


def reference(x, c, ctx, c_ctx, ada_w, ada_b, norm1_g, norm2_g, ffn_w_in, ffn_conv_w, ffn_conv_b, ffn_w_out,
              na_w_qkv, na_q_g, na_k_g, na_rel_bias, na_w_o,
              swa_w_qkv, swa_q_g, swa_k_g, swa_sinks, swa_w_o,
              ml_w_in, ml_gate_b, ml_head_g, ml_w_o,
              gqa_w_qkv, gqa_q_g, gqa_k_g, gqa_w_o):
    S = x.shape[1]
    cos, sin = axial_rope_tables(S)
    xc = ctx
    for i in range(DEPTH):
        kind, j = i % N_MIXERS, i // N_MIXERS
        need_ctx = i < DEPTH - 1
        sh1, sc1, g1, sh2, sc2, g2 = adaln(c[:, None, :], ada_w[i], ada_b[i])
        csh1, csc1, cg1, csh2, csc2, cg2 = adaln(c_ctx[None, :], ada_w[i], ada_b[i])
        hx = modulate(rms_norm(x, norm1_g[i]), sh1, sc1)
        hc = modulate(rms_norm(xc, norm1_g[i]), csh1, csc1)
        if kind == 0:
            ox, oc = neighbourhood_attention(hx, hc, na_w_qkv[j], na_q_g[j], na_k_g[j], na_rel_bias[j], na_w_o[j], need_ctx)
        elif kind == 1:
            ox, oc = sliding_window_attention(hx, hc, swa_w_qkv[j], swa_q_g[j], swa_k_g[j], swa_sinks[j], swa_w_o[j],
                                              cos, sin, need_ctx)
        elif kind == 2:
            ox, oc = mlstm_mixer(hx, hc, ml_w_in[j], ml_gate_b[j], ml_head_g[j], ml_w_o[j], need_ctx)
        else:
            ox, oc = dense_gqa_attention(hx, hc, gqa_w_qkv[j], gqa_q_g[j], gqa_k_g[j], gqa_w_o[j], cos, sin, need_ctx)
        x = x + g1 * ox
        hx = modulate(rms_norm(x, norm2_g[i]), sh2, sc2)
        x = x + g2 * conv_glu(hx, ffn_w_in[i], ffn_conv_w[i], ffn_conv_b[i], ffn_w_out[i])
        if need_ctx:
            xc = xc + cg1 * oc
            hc = modulate(rms_norm(xc, norm2_g[i]), csh2, csc2)
            xc = xc + cg2 * conv_glu(hc, ffn_w_in[i], ffn_conv_w[i], ffn_conv_b[i], ffn_w_out[i])
    return x
```

```cpp
#include <hip/hip_runtime.h>
#include <cstdio>
#include <cstdint>
__device__ __forceinline__ int opq(int v) { asm volatile("" : "+v"(v)); return v; }
__device__ __forceinline__ const float* ldarg(int i) {
    const char __attribute__((address_space(4)))* ka = (const char __attribute__((address_space(4)))*)__builtin_amdgcn_kernarg_segment_ptr();
    int off = i * 8; asm volatile("" : "+s"(off)); off = __builtin_amdgcn_readfirstlane(off);
    return *(const float* const __attribute__((address_space(4)))*)(ka + off);
}
__device__ __forceinline__ unsigned char* opq_ptr(unsigned char* p) { unsigned long long v = (unsigned long long)p; asm volatile("" : "+s"(v));
    const unsigned lo = (unsigned)__builtin_amdgcn_readfirstlane((int)(unsigned)v), hi = (unsigned)__builtin_amdgcn_readfirstlane((int)(unsigned)(v >> 32)); return (unsigned char*)(((unsigned long long)hi << 32) | lo); }
template <int CTRL, int ROWMASK = 0xf, bool BOUND = false> __device__ __forceinline__ float dppf(float oldv, float v) {
    return __builtin_bit_cast(float, __builtin_amdgcn_update_dpp(__builtin_bit_cast(int, oldv), __builtin_bit_cast(int, v), CTRL, ROWMASK, 0xf, BOUND)); }
__device__ __forceinline__ float row_sum16(float v) {
    v += dppf<0x121>(0.f, v); v += dppf<0x122>(0.f, v); v += dppf<0x124>(0.f, v); v += dppf<0x128>(0.f, v); return v; }
__device__ __forceinline__ float row_max16(float v) {
    v = fmaxf(v, dppf<0x121>(v, v)); v = fmaxf(v, dppf<0x122>(v, v)); v = fmaxf(v, dppf<0x124>(v, v)); v = fmaxf(v, dppf<0x128>(v, v)); return v; }
__device__ __forceinline__ float rdl(float v, int l) { return __builtin_bit_cast(float, __builtin_amdgcn_readlane(__builtin_bit_cast(int, v), l)); }
__device__ __forceinline__ float wave_sum(float v) { v = row_sum16(v); return (rdl(v, 0) + rdl(v, 16)) + (rdl(v, 32) + rdl(v, 48)); }
__device__ __forceinline__ float wave_max(float v) { v = row_max16(v); return fmaxf(fmaxf(rdl(v, 0), rdl(v, 16)), fmaxf(rdl(v, 32), rdl(v, 48))); }
__device__ __forceinline__ float sum16(float v) { return row_sum16(v); }
__device__ __forceinline__ float scan_add(float v) {
    v += dppf<0x111, 0xf, true>(0.f, v); v += dppf<0x112, 0xf, true>(0.f, v); v += dppf<0x114, 0xf, true>(0.f, v); v += dppf<0x118, 0xf, true>(0.f, v);
    v += dppf<0x142, 0xa>(0.f, v); v += dppf<0x143, 0xc>(0.f, v); return v; }
__device__ __forceinline__ float scan_max(float v) {
    const float ninf = -3.0e38f;
    v = fmaxf(v, dppf<0x111>(ninf, v)); v = fmaxf(v, dppf<0x112>(ninf, v)); v = fmaxf(v, dppf<0x114>(ninf, v)); v = fmaxf(v, dppf<0x118>(ninf, v));
    v = fmaxf(v, dppf<0x142, 0xa>(ninf, v)); v = fmaxf(v, dppf<0x143, 0xc>(ninf, v)); return v; }
__device__ __forceinline__ float swz_xor16(float v) { return __builtin_bit_cast(float, __builtin_amdgcn_ds_swizzle(__builtin_bit_cast(int, v), 0x401F)); }
__device__ __forceinline__ float swap32(float v) { auto r = __builtin_amdgcn_permlane32_swap(__builtin_bit_cast(unsigned, v), __builtin_bit_cast(unsigned, v), false, false); return __builtin_bit_cast(float, (unsigned)r[0]) ; }
__device__ __forceinline__ float sum_xor16_32(float v) { v += swz_xor16(v); auto r = __builtin_amdgcn_permlane32_swap(__builtin_bit_cast(unsigned, v), __builtin_bit_cast(unsigned, v), false, false);
    return __builtin_bit_cast(float, (unsigned)r[0]) + __builtin_bit_cast(float, (unsigned)r[1]); }
__device__ __forceinline__ float xor4_in16(float v, int lane) { const float up = dppf<0x104>(v, v), dn = dppf<0x114>(v, v); return (lane & 4) ? dn : up; }
__device__ __forceinline__ int lane_now() { int l; asm volatile("v_mbcnt_lo_u32_b32 %0, -1, 0\n\tv_mbcnt_hi_u32_b32 %0, -1, %0" : "=v"(l)); return l; }
__device__ __forceinline__ unsigned opq_u(unsigned v) { asm volatile("" : "+s"(v)); return (unsigned)__builtin_amdgcn_readfirstlane((int)v); }
namespace pg8 {
#define PG8_LAS __attribute__((address_space(3)))
typedef unsigned short bf16_t;
typedef short bf16x8 __attribute__((ext_vector_type(8)));
typedef float f32x4 __attribute__((ext_vector_type(4)));
typedef unsigned u32x4 __attribute__((ext_vector_type(4)));
constexpr int BM = 256, BK = 64, HALF = 128, HTB = HALF * BK * 2  , STAGE_BYTES = 8 * HTB, NXCD = 8, WGM = 4;

__host__ __device__ __forceinline__ int lds_byte(int r, int c) { const int st = (r >> 4) * 2 + (c >> 5), rr = r & 15, cc = c & 31, ob = rr * 64 + cc * 2; return st * 1024 + (ob ^ (((ob >> 9) & 1) << 5)); }
__host__ __device__ __forceinline__ void stage_rc(int b, int& R, int& C) { const int st = b / 1024, sb = b % 1024, swz = sb ^ (((sb >> 9) & 1) << 5); R = (st >> 1) * 16 + swz / 64; C = (st & 1) * 32 + (swz % 64) / 2; }
__host__ __device__ __forceinline__ int perm32(int rho) { const int n = rho >> 4, i = rho & 15; return 8 * (i >> 2) + 4 * n + (i & 3); }

struct Unit { int pm, pn, ko, nt, ks; };
struct Gemm { const bf16_t* A; const bf16_t* Bt; int M, N, K; };

struct StaticOrder {
    int nM, nN, nwg, G, c; int ord = 0;
    int wgm = WGM;
    int ntf, nsplit, kblk, xM;
    __host__ __device__ void init(int M, int N, int G_, int c_, int K_ = 0, int nsplit_ = 0, int xM_ = 0) { nM = M / BM; nN = N / BM; nwg = nM * nN; G = G_; c = c_; ntf = K_ / BK; nsplit = nsplit_; kblk = K_ / 128; xM = xM_; }
    __host__ __device__ bool next(int i, Unit& u) const {
        const int P = G / NXCD, vc = (G % NXCD == 0) ? (c % NXCD) * P + c / NXCD : c;
        const long L = (long)i * G + (ord ? vc : c);
        const bool split = L >= nwg;
        if (split && (nsplit == 0 || L - nwg >= (long)nsplit * xM * nN)) return false;
        int wgid = split ? 0 : (int)L; { const int q = nwg / NXCD, r = nwg % NXCD, xcd = wgid % NXCD, off = wgid / NXCD; const int w0 = (xcd < r ? xcd * (q + 1) : r * (q + 1) + (xcd - r) * q) + off; wgid = ord == 0 ? w0 : (ord == 1 ? wgid : nwg - 1 - wgid); }
        const int nig = wgm * nN, gid = wgid / nig, fm = gid * wgm, gsz = (nM - fm) < wgm ? (nM - fm) : wgm;
        const int pm0 = fm + ((wgid % nig) % gsz), pn0 = (wgid % nig) / gsz;
        const int j = split ? (int)(L - nwg) : 0, per = xM * nN > 0 ? xM * nN : 1, ns = nsplit > 0 ? nsplit : 1;
        const int s = j / per, rem = j - s * per, q2 = kblk / ns, r2 = kblk % ns;
        const int pm1 = nM + rem / nN, pn1 = rem % nN, ko1 = 128 * (s * q2 + (s < r2 ? s : r2)), nt1 = 2 * (q2 + (s < r2 ? 1 : 0));
        u.pm = split ? pm1 : pm0; u.pn = split ? pn1 : pn0; u.ko = split ? ko1 : 0; u.nt = split ? nt1 : ntf; u.ks = split ? s : -1;
#if defined(__HIP_DEVICE_COMPILE__)
        u.pm = __builtin_amdgcn_readfirstlane(u.pm); u.pn = __builtin_amdgcn_readfirstlane(u.pn); u.ko = __builtin_amdgcn_readfirstlane(u.ko); u.nt = __builtin_amdgcn_readfirstlane(u.nt); u.ks = __builtin_amdgcn_readfirstlane(u.ks);
#endif
        return true;
    }
    __device__ __forceinline__ void a_ready(const Unit&) const {}
    __device__ __forceinline__ void done(const Unit&) const {}
};
__device__ __forceinline__ unsigned cvt_pk_bf16(float lo, float hi) { unsigned r; asm volatile("v_cvt_pk_bf16_f32 %0, %1, %2" : "=v"(r) : "v"(lo), "v"(hi)); return r; }
typedef float f32x2 __attribute__((ext_vector_type(2)));
typedef unsigned u32x2 __attribute__((ext_vector_type(2)));
struct EpiStore {
    static constexpr bool PERM = true, AFTER_DRAIN = false;
    bf16_t* O; int ldc;
    __device__ __forceinline__ void operator()(f32x4 (&acc)[2][2][4][2], const Unit& u, int wr, int wc, int fr, int fq) const {
        const int row0 = u.pm * BM + wr * 64 + fr, col0 = u.pn * BM + wc * 32 + 8 * fq;
#pragma unroll
        for (int ai = 0; ai < 2; ++ai)
#pragma unroll
            for (int m = 0; m < 4; ++m) { bf16_t* rowp = O + (size_t)(row0 + ai * HALF + m * 16) * ldc + col0;
#pragma unroll
                for (int bj = 0; bj < 2; ++bj) { const f32x4 v0 = acc[ai][bj][m][0], v1 = acc[ai][bj][m][1];
                    u32x4 w; w.x = cvt_pk_bf16(v0[0], v0[1]); w.y = cvt_pk_bf16(v0[2], v0[3]); w.z = cvt_pk_bf16(v1[0], v1[1]); w.w = cvt_pk_bf16(v1[2], v1[3]);
                    *(u32x4*)(rowp + bj * HALF) = w; } }
    }
};
struct EpiQK {
    static constexpr bool PERM = true, AFTER_DRAIN = false;
    bf16_t* O; int ldc; int nqk_tiles; const float* qg; const float* kg; const float* rope_c; const float* rope_s; PG8_LAS float* xch;
    __device__ __forceinline__ void operator()(f32x4 (&acc)[2][2][4][2], const Unit& u, int wr, int wc, int fr, int fq) const {
        const int row0 = u.pm * BM + wr * 64 + fr, col0 = u.pn * BM + wc * 32 + 8 * fq;
        if (u.pn < nqk_tiles) {
#pragma unroll
            for (int ai = 0; ai < 2; ++ai)
#pragma unroll
                for (int m = 0; m < 4; ++m)
#pragma unroll
                    for (int bj = 0; bj < 2; ++bj) { const f32x4 a = acc[ai][bj][m][0], b = acc[ai][bj][m][1];
                        float ss = (a[0] * a[0] + a[1] * a[1]) + (a[2] * a[2] + a[3] * a[3]) + (b[0] * b[0] + b[1] * b[1]) + (b[2] * b[2] + b[3] * b[3]);
                        ss = sum_xor16_32(ss);
                        if (fq == 0) xch[((ai * HALF + wr * 64 + m * 16 + fr) * 2 + bj) * 4 + wc] = ss; }
            asm volatile("s_waitcnt lgkmcnt(0)" ::: "memory"); __builtin_amdgcn_s_barrier(); asm volatile("" ::: "memory");
            const int ah = wc >> 1, fb = 16 * (wc & 1) + 4 * fq;
            const float* gp = (u.pn < 8 ? qg : kg) + 64 * ah + fb;
            const f32x4 glo = *(const f32x4*)gp, ghi = *(const f32x4*)(gp + 32);
            const bool dorope = (rope_c != nullptr) && (u.pm < 128);
#pragma unroll
            for (int ai = 0; ai < 2; ++ai)
#pragma unroll
                for (int m = 0; m < 4; ++m) { const int rl = ai * HALF + wr * 64 + m * 16 + fr;
                    f32x4 cs = (f32x4){1.f, 1.f, 1.f, 1.f}, sn = (f32x4){0.f, 0.f, 0.f, 0.f};
                    if (dorope) { const int t = (u.pm * BM + rl) & 8191, pos = ah ? (t & 63) : (t >> 6); cs = *(const f32x4*)(rope_c + pos * 32 + fb); sn = *(const f32x4*)(rope_s + pos * 32 + fb); }
                    bf16_t* rowp = O + (size_t)(u.pm * BM + rl) * ldc + col0;
#pragma unroll
                    for (int bj = 0; bj < 2; ++bj) { const f32x4 pr = *(const PG8_LAS f32x4*)(xch + (rl * 2 + bj) * 4);
                        const float rs = __builtin_amdgcn_rsqf(((pr[0] + pr[1]) + (pr[2] + pr[3])) * (1.0f / 128.0f) + 1e-6f);
                        unsigned wq[4];
#pragma unroll
                        for (int n = 0; n < 2; ++n) { const f32x4 v = acc[ai][bj][m][n];
                            const float x1a = v[0] * rs * glo[2 * n], x2a = v[1] * rs * ghi[2 * n], x1b = v[2] * rs * glo[2 * n + 1], x2b = v[3] * rs * ghi[2 * n + 1];
                            wq[2 * n] = cvt_pk_bf16(x1a * cs[2 * n] - x2a * sn[2 * n], x2a * cs[2 * n] + x1a * sn[2 * n]);
                            wq[2 * n + 1] = cvt_pk_bf16(x1b * cs[2 * n + 1] - x2b * sn[2 * n + 1], x2b * cs[2 * n + 1] + x1b * sn[2 * n + 1]); }
                        *(u32x4*)(rowp + bj * HALF) = (u32x4){wq[0], wq[1], wq[2], wq[3]}; }
                    asm volatile("" ::: "memory"); }
            return;
        }
#pragma unroll
        for (int ai = 0; ai < 2; ++ai)
#pragma unroll
            for (int m = 0; m < 4; ++m) { bf16_t* rowp = O + (size_t)(row0 + ai * HALF + m * 16) * ldc + col0;
#pragma unroll
                for (int bj = 0; bj < 2; ++bj) { const f32x4 v0 = acc[ai][bj][m][0], v1 = acc[ai][bj][m][1];
                    u32x4 w; w.x = cvt_pk_bf16(v0[0], v0[1]); w.y = cvt_pk_bf16(v0[2], v0[3]); w.z = cvt_pk_bf16(v1[0], v1[1]); w.w = cvt_pk_bf16(v1[2], v1[3]);
                    *(u32x4*)(rowp + bj * HALF) = w; } }
    }
};
typedef _Float16 h16x4 __attribute__((ext_vector_type(4)));
__device__ __forceinline__ f32x4 h4_to_f4(unsigned a, unsigned b) { const u32x2 t = {a, b}; return __builtin_convertvector(__builtin_bit_cast(h16x4, t), f32x4); }
__device__ __forceinline__ u32x2 f4_to_h4(f32x4 v) { return __builtin_bit_cast(u32x2, __builtin_convertvector(v, h16x4)); }
template <bool BASE16, bool OUT16> struct EpiResidT {
    static constexpr bool PERM = true, AFTER_DRAIN = false;
    const void* base_lat; void* out_lat; float* part; const float* gate; int ld, gstride;
    __device__ __forceinline__ void operator()(f32x4 (&acc)[2][2][4][2], const Unit& u, int wr, int wc, int fr, int fq) const {
        const int rl = wr * 64 + fr, col0 = u.pn * BM + wc * 32 + 8 * fq;
        if (u.ks >= 0) {
            _Float16* ps = (_Float16*)part + ((size_t)u.ks * 1024 + (size_t)(u.pm - 128) * BM) * ld;
#pragma unroll
            for (int ai = 0; ai < 2; ++ai)
#pragma unroll
                for (int m = 0; m < 4; ++m)
#pragma unroll
                    for (int bj = 0; bj < 2; ++bj) { const u32x2 a = f4_to_h4(acc[ai][bj][m][0]), b = f4_to_h4(acc[ai][bj][m][1]);
                        *(u32x4*)(ps + (size_t)(rl + ai * HALF + m * 16) * ld + col0 + bj * HALF) = (u32x4){a.x, a.y, b.x, b.y}; }
            return;
        }
        const size_t roff = (size_t)u.pm * BM * ld;
        const float* gv = gate + (size_t)(u.pm >> 5) * gstride;
        f32x4 g[2][2];
#pragma unroll
        for (int bj = 0; bj < 2; ++bj)
#pragma unroll
            for (int n = 0; n < 2; ++n) g[bj][n] = *(const f32x4*)(gv + col0 + bj * HALF + 4 * n);
        if constexpr (BASE16) {
            const _Float16* bs = (const _Float16*)base_lat + roff; const unsigned vo = (unsigned)(rl * ld + col0) * 2u;
            u32x4 hb[2][2][4];
#pragma unroll
            for (int ai = 0; ai < 2; ++ai)
#pragma unroll
                for (int bj = 0; bj < 2; ++bj)
#pragma unroll
                    for (int m = 0; m < 4; ++m) hb[ai][bj][m] = *(const u32x4*)((const char*)(bs + (size_t)(ai * HALF + m * 16) * ld + bj * HALF) + vo);
#pragma unroll
            for (int ai = 0; ai < 2; ++ai)
#pragma unroll
                for (int bj = 0; bj < 2; ++bj)
#pragma unroll
                    for (int m = 0; m < 4; ++m) {
                        const f32x4 r0 = h4_to_f4(hb[ai][bj][m].x, hb[ai][bj][m].y) + g[bj][0] * acc[ai][bj][m][0], r1 = h4_to_f4(hb[ai][bj][m].z, hb[ai][bj][m].w) + g[bj][1] * acc[ai][bj][m][1];
                        const size_t eo = (size_t)(rl + ai * HALF + m * 16) * ld + col0 + bj * HALF;
                        if constexpr (OUT16) { const u32x2 a = f4_to_h4(r0), b = f4_to_h4(r1); *(u32x4*)((_Float16*)out_lat + roff + eo) = (u32x4){a.x, a.y, b.x, b.y}; }
                        else { float* op = (float*)out_lat + roff + eo; *(f32x4*)op = r0; *(f32x4*)(op + 4) = r1; } }
            return;
        }
#pragma unroll
        for (int ai = 0; ai < 2; ++ai) {
            if constexpr (BASE16) {
            } else {
                const float* bs = (const float*)base_lat + roff;
#pragma unroll
                for (int bj = 0; bj < 2; ++bj) {
                    f32x4 b[4][2];
#pragma unroll
                    for (int m = 0; m < 4; ++m)
#pragma unroll
                        for (int n = 0; n < 2; ++n) b[m][n] = *(const f32x4*)(bs + (size_t)(rl + ai * HALF + m * 16) * ld + col0 + bj * HALF + 4 * n);
#pragma unroll
                    for (int m = 0; m < 4; ++m) {
                        const f32x4 r0 = b[m][0] + g[bj][0] * acc[ai][bj][m][0], r1 = b[m][1] + g[bj][1] * acc[ai][bj][m][1];
                        const size_t eo = (size_t)(rl + ai * HALF + m * 16) * ld + col0 + bj * HALF;
                        if constexpr (OUT16) { const u32x2 a = f4_to_h4(r0), b2 = f4_to_h4(r1); *(u32x4*)((_Float16*)out_lat + roff + eo) = (u32x4){a.x, a.y, b2.x, b2.y}; }
                        else { float* op = (float*)out_lat + roff + eo; *(f32x4*)op = r0; *(f32x4*)(op + 4) = r1; } }
                    asm volatile("" ::: "memory"); }
            }
            asm volatile("" ::: "memory");
        }
    }
};
__device__ __forceinline__ float dpp_ror1(float v) { return __builtin_bit_cast(float, __builtin_amdgcn_update_dpp(0, __builtin_bit_cast(int, v), 0x121, 0xf, 0xf, false)); }
__device__ __forceinline__ float dpp_rol1(float v) { return __builtin_bit_cast(float, __builtin_amdgcn_update_dpp(0, __builtin_bit_cast(int, v), 0x12F, 0xf, 0xf, false)); }
__device__ __forceinline__ float gelu_tanh(float x) {
    const float t = x * (1.0f + 0.044715f * x * x);
    const float e = __builtin_amdgcn_exp2f(-2.302208198f * t);
    return x * __builtin_amdgcn_rcpf(1.0f + e);
}
struct EpiGlu {
    static constexpr bool PERM = true, AFTER_DRAIN = false;
    bf16_t* act; float* edge; const float* cw; const float* cb; PG8_LAS float* xb; int dff;
    __device__ __forceinline__ void operator()(f32x4 (&acc)[2][2][4][2], const Unit& u, int wr, int wc, int fr, int fq) const {
        const int cg = wc * 32 + 8 * fq, f0 = u.pn * 128 + cg;
        f32x4 w0[2], w1[2], w2[2], bb[2];
#pragma unroll
        for (int n = 0; n < 2; ++n) { w0[n] = *(const f32x4*)(cw + f0 + 4 * n); w1[n] = *(const f32x4*)(cw + dff + f0 + 4 * n); w2[n] = *(const f32x4*)(cw + 2 * dff + f0 + 4 * n); bb[n] = *(const f32x4*)(cb + f0 + 4 * n); }
#pragma unroll
        for (int ai = 0; ai < 2; ++ai) { const int b = 2 * ai + wr;
            if (fr == 0) {
#pragma unroll
                for (int n = 0; n < 2; ++n) *(PG8_LAS f32x4*)(xb + (b * 2 + 0) * 128 + cg + 4 * n) = acc[ai][0][0][n]; }
            if (fr == 15) {
#pragma unroll
                for (int n = 0; n < 2; ++n) *(PG8_LAS f32x4*)(xb + (b * 2 + 1) * 128 + cg + 4 * n) = acc[ai][0][3][n]; } }
        asm volatile("s_waitcnt lgkmcnt(0)" ::: "memory"); __builtin_amdgcn_s_barrier(); asm volatile("" ::: "memory");
#pragma unroll
        for (int ai = 0; ai < 2; ++ai) { const int b = 2 * ai + wr;
#pragma unroll
            for (int n = 0; n < 2; ++n) {
                const f32x4 ep = (b > 0) ? *(const PG8_LAS f32x4*)(xb + ((b - 1) * 2 + 1) * 128 + cg + 4 * n) : (f32x4){0.f, 0.f, 0.f, 0.f};
                const f32x4 en = (b < 3) ? *(const PG8_LAS f32x4*)(xb + ((b + 1) * 2 + 0) * 128 + cg + 4 * n) : (f32x4){0.f, 0.f, 0.f, 0.f};
                f32x4 R[4], L[4];
#pragma unroll
                for (int m = 0; m < 4; ++m)
#pragma unroll
                    for (int j = 0; j < 4; ++j) { R[m][j] = dpp_ror1(acc[ai][0][m][n][j]); L[m][j] = dpp_rol1(acc[ai][0][m][n][j]); }
#pragma unroll
                for (int m = 0; m < 4; ++m) {
                    const int rl = ai * HALF + wr * 64 + m * 16 + fr;
                    const f32x4 gp = (fr == 0) ? (m == 0 ? ep : R[m == 0 ? 0 : m - 1]) : R[m];
                    const f32x4 gn = (fr == 15) ? (m == 3 ? en : L[m == 3 ? 3 : m + 1]) : L[m];
                    const f32x4 g = acc[ai][0][m][n], uu = acc[ai][1][m][n];
                    const f32x4 gc = bb[n] + w0[n] * gp + w1[n] * g + w2[n] * gn;
                    if (rl == 0 || rl == 255) {
                        float* eb = edge + ((size_t)u.pm * 6 + (rl == 255 ? 3 : 0)) * dff + f0 + 4 * n;
                        *(f32x4*)eb = gc; *(f32x4*)(eb + dff) = uu; *(f32x4*)(eb + 2 * dff) = g;
                    } else {
                        u32x2 w; w.x = cvt_pk_bf16(gelu_tanh(gc[0]) * uu[0], gelu_tanh(gc[1]) * uu[1]); w.y = cvt_pk_bf16(gelu_tanh(gc[2]) * uu[2], gelu_tanh(gc[3]) * uu[3]);
                        *(u32x2*)(act + (size_t)(u.pm * BM + rl) * dff + f0 + 4 * n) = w;
                    }
                }
            }
        }
    }
};
template <class Epi, class Sched, bool ALIGN_EPI = false, bool SP2 = false>
__device__ __forceinline__ void gemm_phase(PG8_LAS unsigned char* lds, const Gemm g, const Sched& S, const Epi& E, int wave_id) {
    const int tid = opq(wave_id * 64 + lane_now()), wid = wave_id, lane = tid & 63, wr = wid >> 2, wc = wid & 3, fr = lane & 15, fq = lane >> 4;
    const int K = g.K;
    unsigned voffA[2], voffB[2];
#pragma unroll
    for (int i = 0; i < 2; ++i) { int R, C; stage_rc(tid * 16 + i * 8192, R, C); const int Rb = Epi::PERM ? ((R & ~31) + perm32(R & 31)) : R;
        voffA[i] = (unsigned)(R * K + C) * 2u; voffB[i] = (unsigned)(Rb * K + C) * 2u; }
    const size_t kstep = (size_t)(BK * 2);
    const size_t hstep = (size_t)HALF * K * 2;
    const size_t tstep = 2 * hstep;
    const unsigned ldsw = (unsigned)wid * 1024u;
    const int aoff = lds_byte(wr * 64 + fr, fq * 8), boff = lds_byte(wc * 32 + fr, fq * 8);
#define PG8_SA(b, h) (((b) * 2 + (h)) * HTB)
#define PG8_SB(b, h) ((4 + (b) * 2 + (h)) * HTB)
#define PG8_STAGE(bufoff, gbase, voff) do { _Pragma("unroll") for (int _i = 0; _i < 2; ++_i) \
        __builtin_amdgcn_global_load_lds((const unsigned*)((const char*)(gbase) + (voff)[_i]), (PG8_LAS unsigned*)(lds + (bufoff) + ldsw + _i * 8192), 16, 0, 0); } while (0)
#define PG8_LDA(dst, b, h) do { _Pragma("unroll") for (int m = 0; m < 4; ++m) _Pragma("unroll") for (int k = 0; k < 2; ++k) dst[m][k] = *(const PG8_LAS bf16x8*)(lds + PG8_SA(b, h) + aoff + m * 2048 + k * 1024); } while (0)
#define PG8_LDB(dst, b, h) do { _Pragma("unroll") for (int n = 0; n < 2; ++n) _Pragma("unroll") for (int k = 0; k < 2; ++k) dst[n][k] = *(const PG8_LAS bf16x8*)(lds + PG8_SB(b, h) + boff + n * 2048 + k * 1024); } while (0)
#define PG8_MMA(ai, bj, At, Bt) do { __builtin_amdgcn_s_setprio(1); _Pragma("unroll") for (int m = 0; m < 4; ++m) _Pragma("unroll") for (int n = 0; n < 2; ++n) _Pragma("unroll") for (int k = 0; k < 2; ++k) \
        acc[ai][bj][m][n] = __builtin_amdgcn_mfma_f32_16x16x32_bf16(Bt[n][k], At[m][k], acc[ai][bj][m][n], 0, 0, 0); __builtin_amdgcn_s_setprio(0); } while (0)
#define PG8_WAIT_V(n) asm volatile("s_waitcnt vmcnt(" #n ")" ::: "memory")
#define PG8_WAIT_L(n) asm volatile("s_waitcnt lgkmcnt(" #n ")" ::: "memory")
#define PG8_BAR __builtin_amdgcn_s_barrier()
#define PG8_SCHED __builtin_amdgcn_sched_barrier(0)
    Unit cur, nxt; int ui = 0;
    if (!S.next(0, cur)) return;
    f32x4 acc[2][2][4][2];
#pragma unroll
    for (int a = 0; a < 2; ++a)
#pragma unroll
        for (int b = 0; b < 2; ++b)
#pragma unroll
            for (int m = 0; m < 4; ++m)
#pragma unroll
                for (int n = 0; n < 2; ++n) acc[a][b][m][n] = (f32x4){0.f, 0.f, 0.f, 0.f};
    bf16x8 At[4][2], B0[2][2], B1[2][2];
    const char* cA = (const char*)g.A + (size_t)cur.pm * tstep + (size_t)cur.ko * 2; const char* cB = (const char*)g.Bt + (size_t)cur.pn * tstep + (size_t)cur.ko * 2;
    S.a_ready(cur);
    if constexpr (SP2) {
        PG8_STAGE(PG8_SB(0, 0), cB, voffB); PG8_STAGE(PG8_SB(0, 1), cB + hstep, voffB); PG8_STAGE(PG8_SA(0, 0), cA, voffA); PG8_STAGE(PG8_SA(0, 1), cA + hstep, voffA);
        if (wr == 1) PG8_BAR;
        PG8_WAIT_V(2); PG8_BAR;
        PG8_STAGE(PG8_SB(1, 0), cB + kstep, voffB); PG8_STAGE(PG8_SA(1, 0), cA + kstep, voffA); PG8_STAGE(PG8_SB(1, 1), cB + hstep + kstep, voffB);
        PG8_WAIT_V(6); PG8_BAR;
    } else {
        PG8_STAGE(PG8_SB(0, 0), cB, voffB); PG8_STAGE(PG8_SA(0, 0), cA, voffA); PG8_STAGE(PG8_SB(0, 1), cB + hstep, voffB); PG8_STAGE(PG8_SA(0, 1), cA + hstep, voffA);
        if (wr == 1) PG8_BAR;
        PG8_WAIT_V(4); PG8_BAR;
        PG8_STAGE(PG8_SB(1, 0), cB + kstep, voffB); PG8_STAGE(PG8_SA(1, 0), cA + kstep, voffA); PG8_STAGE(PG8_SB(1, 1), cB + hstep + kstep, voffB);
        PG8_WAIT_V(6); PG8_BAR;
    }
    for (;;) {
        const bool has_next = S.next(ui + 1, nxt);
        const char* nA = has_next ? (const char*)g.A + (size_t)nxt.pm * tstep + (size_t)nxt.ko * 2 : cA; const char* nB = has_next ? (const char*)g.Bt + (size_t)nxt.pn * tstep + (size_t)nxt.ko * 2 : cB;
        const int nt = cur.nt;
        for (int t = 0; t < nt; t += 2) {
            const bool last = (t == nt - 2);
            const char* a1 = cA + (size_t)(t + 1) * kstep;
            const char* a2 = last ? nA : cA + (size_t)(t + 2) * kstep; const char* b2 = last ? nB : cB + (size_t)(t + 2) * kstep;
            const char* a3 = a2 + kstep; const char* b3 = b2 + kstep;
            if (last && has_next) S.a_ready(nxt);
            if constexpr (SP2) {
            PG8_LDB(B0, 0, 0); PG8_LDB(B1, 0, 1); PG8_SCHED; PG8_LDA(At, 0, 0); PG8_STAGE(PG8_SA(1, 1), a1 + hstep, voffA);
            PG8_WAIT_V(8); PG8_WAIT_L(0); PG8_BAR; PG8_MMA(0, 0, At, B0); PG8_MMA(0, 1, At, B1); PG8_BAR; PG8_SCHED;
            PG8_LDA(At, 0, 1); PG8_STAGE(PG8_SB(0, 0), b2, voffB); PG8_STAGE(PG8_SB(0, 1), b2 + hstep, voffB); PG8_STAGE(PG8_SA(0, 0), a2, voffA);
            PG8_WAIT_V(8); PG8_WAIT_L(0); PG8_BAR; PG8_MMA(1, 0, At, B0); PG8_MMA(1, 1, At, B1); PG8_BAR; PG8_SCHED;
            PG8_LDB(B0, 1, 0); PG8_LDB(B1, 1, 1); PG8_SCHED; PG8_LDA(At, 1, 0); PG8_STAGE(PG8_SA(0, 1), a2 + hstep, voffA);
            PG8_WAIT_V(8); PG8_WAIT_L(0); PG8_BAR; PG8_MMA(0, 0, At, B0); PG8_MMA(0, 1, At, B1); PG8_BAR; PG8_SCHED;
            PG8_LDA(At, 1, 1); PG8_STAGE(PG8_SB(1, 0), b3, voffB); PG8_STAGE(PG8_SB(1, 1), b3 + hstep, voffB); PG8_STAGE(PG8_SA(1, 0), a3, voffA);
            PG8_WAIT_V(8); PG8_WAIT_L(0); PG8_BAR; PG8_MMA(1, 0, At, B0); PG8_MMA(1, 1, At, B1); PG8_BAR; PG8_SCHED;
            } else {
            PG8_LDB(B0, 0, 0); PG8_SCHED; PG8_LDA(At, 0, 0); PG8_STAGE(PG8_SA(1, 1), a1 + hstep, voffA);
            PG8_WAIT_L(8); PG8_BAR; PG8_WAIT_L(0); PG8_MMA(0, 0, At, B0); PG8_BAR; PG8_SCHED;
            PG8_LDB(B1, 0, 1); PG8_STAGE(PG8_SB(0, 0), b2, voffB);
            PG8_BAR; PG8_WAIT_L(0); PG8_MMA(0, 1, At, B1); PG8_BAR;
            PG8_LDA(At, 0, 1); PG8_STAGE(PG8_SA(0, 0), a2, voffA);
            PG8_BAR; PG8_WAIT_L(0); PG8_MMA(1, 0, At, B0); PG8_BAR; PG8_SCHED;
            PG8_STAGE(PG8_SB(0, 1), b2 + hstep, voffB);
            PG8_WAIT_V(6); PG8_BAR; PG8_MMA(1, 1, At, B1); PG8_BAR;
            PG8_LDB(B0, 1, 0); PG8_SCHED; PG8_LDA(At, 1, 0); PG8_STAGE(PG8_SA(0, 1), a2 + hstep, voffA);
            PG8_WAIT_L(8); PG8_BAR; PG8_WAIT_L(0); PG8_MMA(0, 0, At, B0); PG8_BAR; PG8_SCHED;
            PG8_LDB(B1, 1, 1); PG8_STAGE(PG8_SB(1, 0), b3, voffB);
            PG8_BAR; PG8_WAIT_L(0); PG8_MMA(0, 1, At, B1); PG8_BAR;
            PG8_LDA(At, 1, 1); PG8_STAGE(PG8_SA(1, 0), a3, voffA);
            PG8_BAR; PG8_WAIT_L(0); PG8_MMA(1, 0, At, B0); PG8_BAR; PG8_SCHED;
            PG8_STAGE(PG8_SB(1, 1), b3 + hstep, voffB);
            PG8_WAIT_V(6); PG8_BAR; PG8_MMA(1, 1, At, B1); PG8_BAR;
            }
        }
        if constexpr (ALIGN_EPI) { if (wr == 0) PG8_BAR; }
        if constexpr (!Epi::AFTER_DRAIN) { E(acc, cur, wr, wc, fr, fq); S.done(cur); }
        if (!has_next) break;
#pragma unroll
        for (int a = 0; a < 2; ++a)
#pragma unroll
            for (int b = 0; b < 2; ++b)
#pragma unroll
                for (int m = 0; m < 4; ++m)
#pragma unroll
                    for (int n = 0; n < 2; ++n) acc[a][b][m][n] = (f32x4){0.f, 0.f, 0.f, 0.f};
        cur = nxt; cA = nA; cB = nB; ++ui;
        if constexpr (ALIGN_EPI) { if (wr == 1) PG8_BAR; }
    }
    PG8_WAIT_V(0);
    if constexpr (!ALIGN_EPI) { if (wr == 0) PG8_BAR; }
    PG8_BAR;
    if constexpr (Epi::AFTER_DRAIN) { E.fused(acc, cur, wr, wc, fr, fq, lds, wid, lane); S.done(cur); }
#undef PG8_SA
#undef PG8_SB
#undef PG8_STAGE
#undef PG8_LDA
#undef PG8_LDB
#undef PG8_MMA
#undef PG8_WAIT_V
#undef PG8_WAIT_L
#undef PG8_BAR
#undef PG8_SCHED
}
}
#ifndef PG8_SP2
#define PG8_SP2 true
#endif
constexpr int NWAVES = 8;
constexpr int DM = 2048, NBATCH = 4, SEQ = 8192, CTXL = 256, GRIDW = 64;
constexpr int MLAT = NBATCH * SEQ, MCTX = NBATCH * CTXL, MT = MLAT + MCTX;
constexpr int DFF = 5632, NMOD = 6 * DM, HD = 128, NH = 16;
constexpr int ML_W = 6160;
constexpr float NORM_EPS = 1e-6f;
constexpr float ATT_SCALE = 0.088388347648318440f;

enum { I_X = 0, I_C, I_CTX, I_CCTX, I_ADAW, I_ADAB, I_N1G, I_N2G, I_FWIN, I_FCW, I_FCB, I_FWOUT, I_NAQKV, I_NAQG, I_NAKG, I_NARB, I_NAWO, I_SWQKV, I_SWQG, I_SWKG, I_SWSINK, I_SWWO,
       I_MLWIN, I_MLGB, I_MLHG, I_MLWO, I_GQQKV, I_GQQG, I_GQKG, I_GQWO, N_IN };

constexpr size_t MiB = 1u << 20;
constexpr size_t WS_CTL = 0, CTL_ZERO_BYTES = 1 * MiB;
constexpr size_t WS_ROPE = 1 * MiB;
constexpr size_t WS_MOD = 2 * MiB;
constexpr size_t WS_MODP = 3 * MiB;
constexpr size_t WS_XC = 12 * MiB;
constexpr size_t WS_GATES = 20 * MiB;
constexpr size_t WS_EDGE = 24 * MiB;
constexpr size_t WS_WQKV = 48 * MiB;
constexpr size_t WS_WO = WS_WQKV + 70 * MiB;
constexpr size_t WS_WIN = WS_WO + 32 * MiB;
constexpr size_t WS_WOUT = WS_WIN + 176 * MiB;
constexpr size_t WS_HX = 416 * MiB;
constexpr size_t WS_QKV = WS_HX + 132 * MiB;
constexpr size_t WS_AO = WS_QKV + 396 * MiB;
constexpr size_t WS_HB = WS_AO + 132 * MiB;
constexpr size_t WS_PART = WS_HB + 132 * MiB;
constexpr size_t WS_END = WS_PART + 64 * MiB;
static_assert(WS_WOUT + 88 * MiB <= WS_HX, "weights fit");
__host__ __device__ constexpr int nqkv_of(int L) { return L == 0 ? 6144 : (L == 1 ? 2560 : (L == 2 ? 6144 : 3072)); }
__host__ __device__ constexpr size_t wqkv_off(int L) { return (L == 0 ? 0 : (L == 1 ? 24 : (L == 2 ? 34 : 58))) * MiB; }

constexpr int CW_TMO = 0, CW_CODE = 1;
constexpr int CW_CHK = 16;
constexpr int CW_BAR = 4096;

constexpr int RING_OFF = 0, RING_BYTES = 131072;
constexpr int XB_OFF = RING_BYTES;
constexpr int LDSCTL_OFF = XB_OFF + 4096, MISC_OFF = LDSCTL_OFF + 320;
#ifndef QKF_MASK
#define QKF_MASK 0x0
#endif
constexpr int QKX_OFF = 136192;
constexpr int LDS_BYTES = 147456;
static_assert(MISC_OFF + 128 <= LDS_BYTES, "LDS map");

#define GAS __attribute__((address_space(1)))
#define LAS __attribute__((address_space(3)))
typedef unsigned short bf16;
typedef unsigned v4u __attribute__((ext_vector_type(4)));
typedef unsigned v2u __attribute__((ext_vector_type(2)));
typedef float f32x4 __attribute__((ext_vector_type(4)));
typedef float f32x16 __attribute__((ext_vector_type(16)));
typedef short bf16x8 __attribute__((ext_vector_type(8)));
typedef short s16x4 __attribute__((ext_vector_type(4)));
typedef GAS unsigned gu32;
#define RLX_AGENT __ATOMIC_RELAXED, __HIP_MEMORY_SCOPE_AGENT
#define LDS_WAIT() asm volatile("s_waitcnt lgkmcnt(0)" ::: "memory")
#define VM_WAIT() asm volatile("s_waitcnt vmcnt(0)" ::: "memory")
__device__ __forceinline__ unsigned f2bf(float f) { unsigned u = __builtin_bit_cast(unsigned, f); return (u + 0x7fffu + ((u >> 16) & 1u)) >> 16; }
__device__ __forceinline__ unsigned pk2(float lo, float hi) { unsigned r; asm("v_cvt_pk_bf16_f32 %0, %1, %2" : "=v"(r) : "v"(lo), "v"(hi)); return r; }
__device__ __forceinline__ float bf_lo(unsigned w) { return __builtin_bit_cast(float, w << 16); }
__device__ __forceinline__ float bf_hi(unsigned w) { return __builtin_bit_cast(float, w & 0xffff0000u); }
__device__ __forceinline__ float bf2f(bf16 b) { return __builtin_bit_cast(float, (unsigned)b << 16); }
#define XB_TMO      128
#define XB_XCNT(j)  (256  + 64 * (j))
#define XB_XSUB(j)  (1280 + 64 * (j))
#define XB_XGEN(j)  (2304 + 64 * (j))
#define XB_TOP      3328
#define XB_TOPGEN   3392
#define XCD_BAR_WORDS 3456
#define XB_SPIN_CAP (1u << 18)

__device__ __forceinline__ unsigned xb_ld(unsigned* p)              { return __hip_atomic_load(p, __ATOMIC_RELAXED, __HIP_MEMORY_SCOPE_AGENT); }
__device__ __forceinline__ unsigned xb_add(unsigned* p, unsigned v) { return __hip_atomic_fetch_add(p, v, __ATOMIC_RELAXED, __HIP_MEMORY_SCOPE_AGENT); }
__device__ __forceinline__ unsigned xb_xcc_id() { return (unsigned)__builtin_amdgcn_s_getreg((3 << 11) | 20) & 0xFu; }
#define XB_SPIN(cond, bar) do { unsigned _sp = 0; while (cond) { __builtin_amdgcn_s_sleep(1); \
    if ((++_sp & 255u) == 0u) { if (xb_ld(&(bar)[XB_TMO])) break; if (_sp > XB_SPIN_CAP) { atomicAdd(&(bar)[XB_TMO], 1u); break; } } } } while (0)

struct XcdBarrier {
    unsigned* bar; unsigned x; unsigned w0;
    volatile LAS unsigned* st;
};

__device__ __forceinline__ XcdBarrier xcd_barrier_post(unsigned* bar, volatile LAS unsigned* st) {
    XcdBarrier b; b.bar = bar; b.x = xb_xcc_id(); b.st = st; b.w0 = (__builtin_amdgcn_readfirstlane((int)threadIdx.x >> 6) == 0) ? 1u : 0u;
    if (threadIdx.x == 0) (void)xb_add(&bar[XB_XCNT(b.x)], 1u);
    return b;
}
__device__ __forceinline__ void xcd_barrier_complete(unsigned* bar, unsigned x, unsigned& nloc, unsigned& nx) {
    const unsigned G = gridDim.x * gridDim.y * gridDim.z;
    unsigned sum, cnt, mine, sp = 0u;
    for (;;) {
        sum = 0u; cnt = 0u; mine = 0u;
#pragma unroll
        for (unsigned j = 0; j < 16; ++j) { const unsigned c = xb_ld(&bar[XB_XCNT(j)]); sum += c; cnt += (c > 0u) ? 1u : 0u; mine = (j == x) ? c : mine; }
        if (sum == G) break;
        __builtin_amdgcn_s_sleep(1);
        if ((++sp & 255u) == 0u) { if (xb_ld(&bar[XB_TMO])) break; if (sp > XB_SPIN_CAP) { atomicAdd(&bar[XB_TMO], 1u); break; } }
    }
    nloc = mine > 0u ? mine : 1u; nx = cnt > 0u ? cnt : 1u;
}

__device__ __forceinline__ void xcd_barrier(const XcdBarrier& b) {
    asm volatile("s_waitcnt vmcnt(0)" ::: "memory");
    __syncthreads();
    if (b.w0 != 0u && lane_now() == 0) {
        unsigned* bar = b.bar;
        __builtin_amdgcn_s_waitcnt(0);
        unsigned nloc = b.st[0], nx = b.st[1];
        if (nloc == 0u) { xcd_barrier_complete(bar, b.x, nloc, nx); b.st[0] = nloc; b.st[1] = nx; }
        const unsigned old = xb_add(&bar[XB_XSUB(b.x)], 1u);
        const unsigned gen = old / nloc;
        if (old + 1u == (gen + 1u) * nloc) {
            __builtin_amdgcn_fence(__ATOMIC_RELEASE, "agent");
            asm volatile("s_waitcnt vmcnt(0)" ::: "memory");
            const unsigned og = xb_add(&bar[XB_TOP], 1u);
            const unsigned tg = og / nx;
            if (og + 1u == (tg + 1u) * nx) xb_add(&bar[XB_TOPGEN], 1u);
            else XB_SPIN(xb_ld(&bar[XB_TOPGEN]) == tg, bar);
            __builtin_amdgcn_fence(__ATOMIC_ACQUIRE, "agent");
            xb_add(&bar[XB_XGEN(b.x)], 1u);
            asm volatile("s_waitcnt vmcnt(0)" ::: "memory");
        } else {
            XB_SPIN(xb_ld(&bar[XB_XGEN(b.x)]) == gen, bar);
            __builtin_amdgcn_fence(__ATOMIC_ACQUIRE, "agent");
            asm volatile("s_waitcnt vmcnt(0)" ::: "memory");
        }
    }
    __syncthreads();
}

struct Args { const float* in[N_IN]; float* out; unsigned char* ws; int ph_lo, ph_hi; };
struct Frame {
    LAS unsigned char* lds; volatile LAS unsigned* MISC; gu32* ctl;
    int wave, vcu, G;
    __device__ __forceinline__ int wv() const { return (int)opq_u((unsigned)wave); }
    __device__ __forceinline__ int vc() const { return (int)opq_u((unsigned)vcu); }
    int bx;
    __device__ __forceinline__ int bx_() const { return (int)opq_u((unsigned)bx); }
    __device__ __forceinline__ int ng() const { return (int)opq_u((unsigned)G); }
    __device__ __forceinline__ int lane_id() const { return lane_now(); }
    __device__ __forceinline__ int tid_() const { return wv() * 64 + lane_now(); }
    __device__ __forceinline__ LAS unsigned char* ldsp() const { return (LAS unsigned char*)(uintptr_t)opq_u((unsigned)(uintptr_t)lds); }
};
__device__ __forceinline__ float fast_exp(float x) { return __builtin_amdgcn_exp2f(x * 1.4426950408889634f); }

__device__ __forceinline__ void transpose_item(const float* W, int ldw, int K, bf16* WT, int dst_row0, int k0, int n0, LAS float* scr, int lane, int dstep = 1) {
#pragma unroll 8
    for (int i = 0; i < 32; ++i) { const int kk = 2 * i + (lane >> 5); scr[kk * 33 + (lane & 31)] = W[(size_t)(k0 + kk) * ldw + n0 + (lane & 31)]; }
    LDS_WAIT(); asm volatile("" ::: "memory");
    const int c = lane & 7;
#pragma unroll
    for (int j = 0; j < 4; ++j) { const int n = (lane >> 3) + 8 * j; const LAS float* s = scr + (8 * c) * 33 + n;
        v4u o; o.x = pk2(s[0 * 33], s[1 * 33]); o.y = pk2(s[2 * 33], s[3 * 33]); o.z = pk2(s[4 * 33], s[5 * 33]); o.w = pk2(s[6 * 33], s[7 * 33]);
        *(GAS v4u*)(WT + (size_t)(dst_row0 + n * dstep) * K + k0 + 8 * c) = o; }
    LDS_WAIT(); asm volatile("" ::: "memory");
}
#ifndef PRO_ALL
#define PRO_ALL 0
#endif
#ifndef TAILFILL
#define TAILFILL 1
#endif
#ifndef CONV_NT
#define CONV_NT 0
#endif
#ifndef TAIL_OWN3
#define TAIL_OWN3 1
#endif
#ifndef TAIL1_PCT
#define TAIL1_PCT 50
#endif
#ifndef TAIL3_PCT
#define TAIL3_PCT 20
#endif
__host__ __device__ constexpr int conv_items(int L) { return nqkv_of(L) + 2048 + 11264 + 5632; }
template <int L> __device__ __forceinline__ void conv_decode(unsigned char* ws, int r, const float*& src, int& ldw, bf16*& dst, int& K, int& dstep) {
    constexpr int N = nqkv_of(L);
    if (r < N) {
        const int nblk = N / 32, kb = r / nblk, nb = r % nblk;
        const float* W = ldarg(L == 0 ? I_NAQKV : (L == 1 ? I_SWQKV : (L == 2 ? I_MLWIN : I_GQQKV)));
        const int n0 = nb * 32, nqk = (L == 2 || !((QKF_MASK >> L) & 1)) ? 0 : (NH + (L == 0 ? 16 : (L == 1 ? 2 : 4))) * HD;
        const bool perm = n0 < nqk; const int d0 = n0 & 127, drow = perm ? (n0 & ~127) + (d0 & 64) + ((d0 >> 5) & 1) : n0;
        ldw = L == 2 ? ML_W : N; K = DM; dstep = perm ? 2 : 1; src = W + (size_t)(kb * 64) * ldw + n0; dst = (bf16*)(ws + WS_WQKV + wqkv_off(L)) + (size_t)drow * DM + kb * 64; return; }
    r -= N;
    if (r < 2048) { const int kb = r >> 6, nb = r & 63;
        const float* W = ldarg(L == 0 ? I_NAWO : (L == 1 ? I_SWWO : (L == 2 ? I_MLWO : I_GQWO)));
        ldw = DM; K = DM; dstep = 1; src = W + (size_t)(kb * 64) * DM + nb * 32; dst = (bf16*)(ws + WS_WO) + (size_t)L * DM * DM + (size_t)(nb * 32) * DM + kb * 64; return; }
    r -= 2048;
    if (r < 11264) { const int kb = r / 352, nb = r % 352, n0 = nb * 32;
        const int f0 = n0 < DFF ? n0 : n0 - DFF; const int drow = 256 * (f0 >> 7) + (f0 & 127) + (n0 < DFF ? 0 : 128);
        ldw = 2 * DFF; K = DM; dstep = 1; src = ldarg(I_FWIN) + (size_t)L * DM * 2 * DFF + (size_t)(kb * 64) * (2 * DFF) + n0; dst = (bf16*)(ws + WS_WIN) + (size_t)L * 2 * DFF * DM + (size_t)drow * DM + kb * 64; return; }
    r -= 11264;
    { const int kb = r >> 6, nb = r & 63;
      ldw = DM; K = DFF; dstep = 1; src = ldarg(I_FWOUT) + (size_t)L * DFF * DM + (size_t)(kb * 64) * DM + nb * 32; dst = (bf16*)(ws + WS_WOUT) + (size_t)L * DM * DFF + (size_t)(nb * 32) * DFF + kb * 64; }
}
template <int L> __device__ __forceinline__ void convert_range(unsigned char* ws, int it0, int hi, int stride, LAS float* scr, int lane) {
    if (it0 >= hi) return;
    const float* src; int ldw; bf16* dst; int K, dstep;
    conv_decode<L>(ws, it0, src, ldw, dst, K, dstep);
    float v[32];
#pragma unroll
    for (int i = 0; i < 32; ++i) v[i] = CONV_NT ? __builtin_nontemporal_load(src + (size_t)(2 * i + (lane >> 5)) * ldw + (lane & 31)) : src[(size_t)(2 * i + (lane >> 5)) * ldw + (lane & 31)];
    for (int it = it0; it < hi; it += stride) {
#pragma unroll
        for (int i = 0; i < 32; ++i) scr[(2 * i + (lane >> 5)) * 33 + (lane & 31)] = v[i];
        bf16* cdst = dst; const int cK = K, cds = dstep;
        if (it + stride < hi) {
            conv_decode<L>(ws, it + stride, src, ldw, dst, K, dstep);
#pragma unroll
            for (int i = 0; i < 32; ++i) v[i] = CONV_NT ? __builtin_nontemporal_load(src + (size_t)(2 * i + (lane >> 5)) * ldw + (lane & 31)) : src[(size_t)(2 * i + (lane >> 5)) * ldw + (lane & 31)];
        }
        LDS_WAIT(); asm volatile("" ::: "memory");
        const int c = lane & 7;
#pragma unroll
        for (int j = 0; j < 4; ++j) { const int n = (lane >> 3) + 8 * j; const LAS float* s_ = scr + (8 * c) * 33 + n;
            v4u o; o.x = pk2(s_[0 * 33], s_[1 * 33]); o.y = pk2(s_[2 * 33], s_[3 * 33]); o.z = pk2(s_[4 * 33], s_[5 * 33]); o.w = pk2(s_[6 * 33], s_[7 * 33]);
            *(GAS v4u*)(cdst + (size_t)(n * cds) * cK + 8 * c) = o; }
        LDS_WAIT(); asm volatile("" ::: "memory");
    }
}
template <int L> __device__ __forceinline__ void convert_tail(Frame& F, const Args& A, int nwg, int lo, int hi) {
    const int G = F.ng(), rem = nwg % G, vc = F.vc();
    if (rem != 0 && vc < rem) return;
    const int first = rem, nidle = G - first, lane_ = opq(F.lane_id());
    unsigned char* ws = opq_ptr(A.ws); LAS float* scr = (LAS float*)(F.ldsp() + F.wv() * 8704);
    convert_range<L>(ws, lo + (vc - first) * NWAVES + F.wv(), hi, nidle * NWAVES, scr, lane_);
}
__device__ __forceinline__ void prologue_phase(Frame& F, const Args& A) {
    const int tid_ = opq(F.tid_()); const int lane_ = tid_ & 63;
    unsigned char* ws = opq_ptr(A.ws);
    const int gw = F.vc() * NWAVES + F.wv(), NGW = F.ng() * NWAVES;
    LAS float* sil = (LAS float*)(F.ldsp() + 71680);
    for (int i = tid_; i < 5 * DM; i += NWAVES * 64) { const float v = (i < 4 * DM) ? ldarg(I_C)[i] : ldarg(I_CCTX)[i - 4 * DM]; sil[i] = v / (1.0f + __expf(-v)); }
    __syncthreads();
    if (gw < 4 * 48 * 8) {
        const int l = gw / 384, rem = gw % 384, cb = rem >> 3, ks = rem & 7;
        const float* W = ldarg(I_ADAW) + ((size_t)l * DM + ks * 256) * NMOD + cb * 256 + 4 * lane_;
        f32x4 acc[5];
#pragma unroll
        for (int r = 0; r < 5; ++r) acc[r] = (f32x4){0.f, 0.f, 0.f, 0.f};
#pragma unroll 8
        for (int k = 0; k < 256; ++k) { const f32x4 w = *(const GAS f32x4*)(W + (size_t)k * NMOD);
#pragma unroll
            for (int r = 0; r < 5; ++r) acc[r] += w * sil[r * DM + ks * 256 + k]; }
        float* P = (float*)(ws + WS_MODP) + ((size_t)(ks * 4 + l) * 5) * NMOD + cb * 256 + 4 * lane_;
#pragma unroll
        for (int r = 0; r < 5; ++r) *(GAS f32x4*)(P + (size_t)r * NMOD) = acc[r];
    }
    { const int gt = F.vc() * (NWAVES * 64) + tid_;
      if (gt < 4096) { const int pos = gt >> 5, f = gt & 31; const float inv = powf(10000.0f, -(float)f / 32.0f); const float ang = (float)pos * inv; float sn, cs; sincosf(ang, &sn, &cs);
          float* R = (float*)(ws + WS_ROPE); R[gt] = cs; R[4096 + gt] = sn; } }
    { const GAS f32x4* s = (const GAS f32x4*)ldarg(I_CTX); GAS f32x4* d = (GAS f32x4*)(ws + WS_XC);
      for (int i = F.vc() * (NWAVES * 64) + tid_; i < MCTX * DM / 4; i += F.ng() * NWAVES * 64) d[i] = s[i]; }
    LAS float* scr = (LAS float*)(F.ldsp() + F.wv() * 8704);
    convert_range<0>(ws, gw, conv_items(0), NGW, scr, lane_);
    { constexpr int skip = (TAILFILL && !PRO_ALL) ? TAIL1_PCT + TAIL3_PCT : 0;
      if (skip < 100) { convert_range<1>(ws, conv_items(1) * skip / 100 + gw, conv_items(1), NGW, scr, lane_); convert_range<2>(ws, conv_items(2) * skip / 100 + gw, conv_items(2), NGW, scr, lane_);
                        if (!(TAILFILL && !PRO_ALL && TAIL_OWN3)) convert_range<3>(ws, conv_items(3) * skip / 100 + gw, conv_items(3), NGW, scr, lane_); } }
}
__device__ __forceinline__ void modred_phase(Frame& F, const Args& A) {
    const int tid_ = opq(F.tid_());
    const float* P = (const float*)(opq_ptr(A.ws) + WS_MODP); float* Mo = (float*)(opq_ptr(A.ws) + WS_MOD);
    for (int i = F.vc() * (NWAVES * 64) + tid_; i < 4 * 5 * NMOD / 4; i += F.ng() * NWAVES * 64) {
        const int l = i / (5 * NMOD / 4), col4 = i % (NMOD / 4);
        f32x4 s = *(const GAS f32x4*)(ldarg(I_ADAB) + (size_t)l * NMOD + 4 * col4);
#pragma unroll
        for (int ks = 0; ks < 8; ++ks) s += *(const GAS f32x4*)(P + (size_t)ks * 4 * 5 * NMOD + 4 * (size_t)i);
        *(GAS f32x4*)(Mo + 4 * (size_t)i) = s;
    }
}

__device__ __forceinline__ void norm_phase(Frame& F, const Args& A, const void* xlat, bool x16, const float* gain, const float* modl, int shift_chunk, bool with_ctx, bool do_gates, const float* pend_gate, bool down = false) {
    const int tid_ = opq(F.tid_());
    unsigned char* ws = opq_ptr(A.ws); bf16* HX = (bf16*)(ws + WS_HX);
    const int gw = F.vc() * NWAVES + F.wv(), NGW = F.ng() * NWAVES, lane_ = opq(F.lane_id());
    LAS float* Wg = (LAS float*)(F.ldsp());
    if (do_gates) {
        for (int idx = tid_; idx < DM * 4; idx += NWAVES * 64) { const int k = idx >> 2, part = idx & 3;
            const f32x4 w = *(const GAS f32x4*)(ldarg(I_MLWIN) + (size_t)k * ML_W + 6144 + 4 * part);
#pragma unroll
            for (int e = 0; e < 4; ++e) Wg[(4 * part + e) * DM + k] = w[e]; }
        __syncthreads();
    }
    for (int bi_ = 0; bi_ < (with_ctx ? 5 : 4); ++bi_) { const int bsel = down ? (with_ctx ? 4 : 3) - bi_ : bi_;
        const bool h16 = x16 && bsel < 4;
        const float* src = bsel < 4 ? (const float*)xlat + (size_t)bsel * SEQ * DM : (const float*)(ws + WS_XC);
        const _Float16* src16 = (const _Float16*)xlat + (size_t)bsel * SEQ * DM;
        const int nrows = bsel < 4 ? SEQ : MCTX, row0 = bsel < 4 ? bsel * SEQ : MLAT;
        const float* sh = modl + (size_t)bsel * NMOD + shift_chunk * DM; const float* sc = sh + DM;
        f32x4 a[8], bs[8];
#pragma unroll
        for (int j = 0; j < 8; ++j) { const int c = 4 * lane_ + 256 * j; const f32x4 g = *(const GAS f32x4*)(gain + c), s = *(const GAS f32x4*)(sc + c); a[j] = g * (1.0f + s); bs[j] = *(const GAS f32x4*)(sh + c); }
        f32x4 vn[8];
        v2u vh[8];
        if (!do_gates && gw < nrows) { const size_t r0_ = (size_t)(down ? nrows - 1 - gw : gw);
            if (h16) { const GAS v2u* xr = (const GAS v2u*)(src16 + r0_ * DM) + lane_;
#pragma unroll
                for (int j = 0; j < 8; ++j) vh[j] = xr[64 * j]; }
            else { const GAS f32x4* xr = (const GAS f32x4*)(src + r0_ * DM) + lane_;
#pragma unroll
                for (int j = 0; j < 8; ++j) vn[j] = xr[64 * j]; } }
        for (int i_ = gw; i_ < nrows; i_ += NGW) { const int i = down ? nrows - 1 - i_ : i_;
            const GAS f32x4* xr = (const GAS f32x4*)(src + (size_t)i * DM) + lane_;
            f32x4 v[8]; float ss = 0.f;
            if (do_gates) {
                if (h16) { const GAS v2u* xh = (const GAS v2u*)(src16 + (size_t)i * DM) + lane_;
#pragma unroll
                    for (int j = 0; j < 8; ++j) { const v2u t_ = xh[64 * j]; v[j] = pg8::h4_to_f4(t_.x, t_.y); } }
                else {
#pragma unroll
                    for (int j = 0; j < 8; ++j) v[j] = xr[64 * j]; }
            } else if (h16) {
#pragma unroll
                for (int j = 0; j < 8; ++j) v[j] = pg8::h4_to_f4(vh[j].x, vh[j].y);
                if (i_ + NGW < nrows) { const GAS v2u* xn = (const GAS v2u*)(src16 + (size_t)(down ? i - NGW : i + NGW) * DM) + lane_;
#pragma unroll
                    for (int j = 0; j < 8; ++j) vh[j] = xn[64 * j]; }
            } else {
#pragma unroll
                for (int j = 0; j < 8; ++j) v[j] = vn[j];
                if (i_ + NGW < nrows) { const GAS f32x4* xn = (const GAS f32x4*)(src + (size_t)(down ? i - NGW : i + NGW) * DM) + lane_;
#pragma unroll
                    for (int j = 0; j < 8; ++j) vn[j] = xn[64 * j]; }
            }
            if (bsel == 4 && pend_gate != nullptr) {
                const _Float16* pp = (const _Float16*)(ws + WS_PART) + (size_t)i * DM + 4 * lane_;
#pragma unroll
                for (int j = 0; j < 8; ++j) { v2u pr[8];
#pragma unroll
                    for (int ks = 0; ks < 8; ++ks) pr[ks] = *(const GAS v2u*)(pp + (size_t)ks * MCTX * DM + 256 * j);
                    f32x4 s = pg8::h4_to_f4(pr[0].x, pr[0].y);
#pragma unroll
                    for (int ks = 1; ks < 8; ++ks) s += pg8::h4_to_f4(pr[ks].x, pr[ks].y);
                    v[j] += *(const GAS f32x4*)(pend_gate + 4 * lane_ + 256 * j) * s;
                    ((GAS f32x4*)((float*)(ws + WS_XC) + (size_t)i * DM) + lane_)[64 * j] = v[j]; }
            }
#pragma unroll
            for (int j = 0; j < 8; ++j) ss += (v[j].x * v[j].x + v[j].y * v[j].y) + (v[j].z * v[j].z + v[j].w * v[j].w);
            const float rstd = 1.0f / sqrtf(wave_sum(ss) * (1.0f / DM) + NORM_EPS);
            GAS v2u* o8 = (GAS v2u*)(HX + (size_t)(row0 + i) * DM) + lane_;
#pragma unroll
            for (int j = 0; j < 8; ++j) { v[j] = (v[j] * rstd) * a[j] + bs[j]; v2u w; w.x = pk2(v[j].x, v[j].y); w.y = pk2(v[j].z, v[j].w); o8[64 * j] = w; }
            if (do_gates) {
                float mine = 0.f;
#pragma unroll
                for (int g = 0; g < 16; ++g) { float s = 0.f;
#pragma unroll
                    for (int j = 0; j < 8; ++j) { const f32x4 w = *(const LAS f32x4*)(Wg + g * DM + 4 * lane_ + 256 * j); s += (v[j].x * w.x + v[j].y * w.y) + (v[j].z * w.z + v[j].w * w.w); }
                    s = wave_sum(s); mine = (lane_ == g) ? s : mine; }
                if (lane_ < 16) ((float*)(ws + WS_GATES))[(size_t)(row0 + i) * 16 + lane_] = mine + ldarg(I_MLGB)[lane_];
            }
        }
    }
    if (do_gates) __syncthreads();
}

__device__ __forceinline__ void qkn_phase(Frame& F, const Args& A, int ld, int nh, const float* qg, const float* kg, bool rope, bool probe_scratch = false, int h0 = 0) {
    unsigned char* ws = opq_ptr(A.ws); bf16* QKV = (bf16*)(ws + WS_QKV); const float* RC = (const float*)(ws + WS_ROPE); const float* RS = RC + 4096;
    const int lane_ = opq(F.lane_id()); const int gw = F.vc() * NWAVES + F.wv(), NGW = F.ng() * NWAVES, i16 = lane_ & 15, sub = lane_ >> 4;
    const int nhe = nh - h0, nitems = MT * nhe;
    const f32x4 gq0 = *(const GAS f32x4*)(qg + 8 * i16), gq1 = *(const GAS f32x4*)(qg + 8 * i16 + 4), gk0 = *(const GAS f32x4*)(kg + 8 * i16), gk1 = *(const GAS f32x4*)(kg + 8 * i16 + 4);
    for (int p_ = gw; p_ * 16 < nitems; p_ += NGW) { const int p = nitems / 16 - 1 - p_;
        GAS v4u* ptr[4]; v4u raw[4]; int rowv[4], headv[4];
#pragma unroll
        for (int k = 0; k < 4; ++k) { const int item = p * 16 + k * 4 + sub; rowv[k] = item / nhe; headv[k] = h0 + item - rowv[k] * nhe;
            ptr[k] = (GAS v4u*)(QKV + (size_t)rowv[k] * ld + headv[k] * HD + 8 * i16); raw[k] = *ptr[k]; }
#pragma unroll
        for (int k = 0; k < 4; ++k) {
            const int row = rowv[k], head = headv[k];
            float x[8] = {bf_lo(raw[k].x), bf_hi(raw[k].x), bf_lo(raw[k].y), bf_hi(raw[k].y), bf_lo(raw[k].z), bf_hi(raw[k].z), bf_lo(raw[k].w), bf_hi(raw[k].w)};
            float ss = 0.f;
#pragma unroll
            for (int e = 0; e < 8; ++e) ss += x[e] * x[e];
            const float rstd = 1.0f / sqrtf(sum16(ss) * (1.0f / HD) + NORM_EPS);
            const f32x4 g0 = head < NH ? gq0 : gk0, g1 = head < NH ? gq1 : gk1;
#pragma unroll
            for (int e = 0; e < 8; ++e) x[e] = x[e] * rstd * (e < 4 ? g0[e] : g1[e - 4]);
            const bool dorope = rope && row < MLAT;
            float xp[8];
#pragma unroll
            for (int e = 0; e < 8; ++e) xp[e] = xor4_in16(x[e], i16);
            if (dorope) {
                const int t = row & (SEQ - 1), pos = (i16 >> 3) ? (t & (GRIDW - 1)) : (t >> 6), f0 = 8 * (i16 & 3);
                const f32x4 c0 = *(const GAS f32x4*)(RC + pos * 32 + f0), c1 = *(const GAS f32x4*)(RC + pos * 32 + f0 + 4), s0 = *(const GAS f32x4*)(RS + pos * 32 + f0), s1 = *(const GAS f32x4*)(RS + pos * 32 + f0 + 4);
                const float sg = (i16 & 4) ? 1.0f : -1.0f;
#pragma unroll
                for (int e = 0; e < 8; ++e) { const float c = e < 4 ? c0[e] : c1[e - 4], sn = e < 4 ? s0[e] : s1[e - 4]; x[e] = x[e] * c + sg * xp[e] * sn; }
            }
            v4u o; o.x = pk2(x[0], x[1]); o.y = pk2(x[2], x[3]); o.z = pk2(x[4], x[5]); o.w = pk2(x[6], x[7]);
            if (probe_scratch) *(GAS v4u*)((bf16*)(ws + WS_AO) + (size_t)row * (nh * HD) + head * HD + 8 * i16) = o; else *ptr[k] = o;
        }
    }
}

__device__ __forceinline__ void fix_phase(Frame& F, const Args& A, int L, int npanels) {
    const int tid_ = opq(F.tid_());
    unsigned char* ws = opq_ptr(A.ws); bf16* ACT = (bf16*)(ws + WS_QKV); const float* E = (const float*)(ws + WS_EDGE); const float* cw = ldarg(I_FCW) + (size_t)L * 3 * DFF;
    const int ntask = npanels * 2 * (DFF / 4);
    for (int i = F.vc() * (NWAVES * 64) + tid_; i < ntask; i += F.ng() * NWAVES * 64) {
        const int f = 4 * (i % (DFF / 4)), pe = i / (DFF / 4), pm = pe >> 1, e = pe & 1;
        const float* eb = E + ((size_t)pm * 6 + 3 * e) * DFF + f;
        f32x4 gc = *(const GAS f32x4*)eb; const f32x4 uu = *(const GAS f32x4*)(eb + DFF);
        const bool has = pm < 128 && (e ? (pm & 31) != 31 : (pm & 31) != 0);
        if (has) { const f32x4 w = *(const GAS f32x4*)(cw + (e ? 2 * DFF : 0) + f); const f32x4 gnb = *(const GAS f32x4*)(E + ((size_t)(e ? pm + 1 : pm - 1) * 6 + (e ? 2 : 5)) * DFF + f); gc += w * gnb; }
        v2u o; o.x = pk2(pg8::gelu_tanh(gc.x) * uu.x, pg8::gelu_tanh(gc.y) * uu.y); o.y = pk2(pg8::gelu_tanh(gc.z) * uu.z, pg8::gelu_tanh(gc.w) * uu.w);
        *(GAS v2u*)(ACT + (size_t)(pm * 256 + (e ? 255 : 0)) * DFF + f) = o;
    }
}

__device__ __forceinline__ void mlro_phase(Frame& F, const Args& A) {
    unsigned char* ws = opq_ptr(A.ws); const bf16* HF = (const bf16*)(ws + WS_AO); const bf16* HBk = (const bf16*)(ws + WS_HB); const bf16* QKV = (const bf16*)(ws + WS_QKV); bf16* HX = (bf16*)(ws + WS_HX);
    const int lane_ = opq(F.lane_id()); const int gw = F.vc() * NWAVES + F.wv(), NGW = F.ng() * NWAVES, c0 = lane_ * 8;
    const float* hg = ldarg(I_MLHG) + c0;
    for (int row = gw; row < MT; row += NGW) {
        const GAS v4u* pf = (const GAS v4u*)(HF + (size_t)row * DM + c0); const GAS v4u* pb = (const GAS v4u*)(HBk + (size_t)row * DM + c0); const GAS v4u* po = (const GAS v4u*)(QKV + (size_t)row * 6144 + 4096 + c0);
        float h[32]; v4u ov[4];
#pragma unroll
        for (int q = 0; q < 4; ++q) { const v4u a = pf[64 * q], b = pb[64 * q]; ov[q] = po[64 * q];
            h[8 * q + 0] = bf_lo(a.x) + bf_lo(b.x); h[8 * q + 1] = bf_hi(a.x) + bf_hi(b.x); h[8 * q + 2] = bf_lo(a.y) + bf_lo(b.y); h[8 * q + 3] = bf_hi(a.y) + bf_hi(b.y);
            h[8 * q + 4] = bf_lo(a.z) + bf_lo(b.z); h[8 * q + 5] = bf_hi(a.z) + bf_hi(b.z); h[8 * q + 6] = bf_lo(a.w) + bf_lo(b.w); h[8 * q + 7] = bf_hi(a.w) + bf_hi(b.w); }
        GAS v4u* px = (GAS v4u*)(HX + (size_t)row * DM + c0);
#pragma unroll
        for (int q = 0; q < 4; ++q) { float ss = 0.f;
#pragma unroll
            for (int e = 0; e < 8; ++e) ss += h[8 * q + e] * h[8 * q + e];
            const float rstd = 1.0f / sqrtf(wave_sum(ss) * (1.0f / 512.0f) + NORM_EPS);
            const f32x4 g0 = *(const GAS f32x4*)(hg + 512 * q), g1 = *(const GAS f32x4*)(hg + 512 * q + 4);
            const float o[8] = {bf_lo(ov[q].x), bf_hi(ov[q].x), bf_lo(ov[q].y), bf_hi(ov[q].y), bf_lo(ov[q].z), bf_hi(ov[q].z), bf_lo(ov[q].w), bf_hi(ov[q].w)};
            float r[8];
#pragma unroll
            for (int e = 0; e < 8; ++e) { const float sg = 1.0f / (1.0f + __expf(-o[e])); r[e] = sg * (h[8 * q + e] * rstd * (e < 4 ? g0[e] : g1[e - 4])); }
            v4u w; w.x = pk2(r[0], r[1]); w.y = pk2(r[2], r[3]); w.z = pk2(r[4], r[5]); w.w = pk2(r[6], r[7]); px[64 * q] = w; }
    }
}

#ifndef TILE_SKIP
#define TILE_SKIP 1
#endif
#ifndef PV_TWO
#define PV_TWO 1
#endif
namespace att {
constexpr int QBLK = 32, KVBLK = 64, D = 128;
constexpr float SCALE = ATT_SCALE, THR = 8.f;
constexpr int SHM_V = KVBLK * D * 2, SHM_K = KVBLK * D * 2;
constexpr int NB = 4, BUFB = SHM_V + SHM_K;
constexpr int OFF_WS = NB * BUFB, OFF_TAB = 139264, ATT_LDS = OFF_TAB + 15 * 128 * 4;
static_assert(OFF_WS + NWAVES * 256 <= 135168 && ATT_LDS <= 147456, "attention LDS map");
#define KSWZ(row, colB) ((row) * 256 + ((colB) ^ (((row) & 7) << 4)))
#define SBAR() __builtin_amdgcn_sched_barrier(0)
__device__ __forceinline__ int crow(int r, int hi) { return (r & 3) + 8 * (r >> 2) + 4 * hi; }
__device__ __forceinline__ unsigned cvtpk(float lo, float hi) { unsigned r; asm volatile("v_cvt_pk_bf16_f32 %0, %1, %2" : "=v"(r) : "v"(lo), "v"(hi)); return r; }
struct MaskInfo { int a, b, c, d; };
template <int MODE> __device__ __forceinline__ void apply_mask(f32x16& p0, f32x16& p1, int widx, int lo, int nwin, const MaskInfo& mi, int hi, const LAS float* tab) {
    if (MODE == 3 || widx < 0) return;
    if (MODE == 1) {
        const int d0 = 64 * (lo + widx) - mi.a + 128;
#pragma unroll
        for (int r = 0; r < 16; ++r) { const int kc = crow(r, hi);
            p0[r] = ((unsigned)(d0 + kc) <= 256u) ? p0[r] : -1e30f; p1[r] = ((unsigned)(d0 + kc + 32) <= 256u) ? p1[r] : -1e30f; }
    }
    if (MODE == 0) {
        const int kr = lo + widx;
        const bool rowok = widx < nwin && (unsigned)(kr - mi.d) < 8u;
        if (!rowok) {
#pragma unroll
            for (int r = 0; r < 16; ++r) { p0[r] = -1e30f; p1[r] = -1e30f; }
        } else {
            const LAS float* tb = tab + (kr - mi.a + 7) * 128 + 63 - mi.b;
#pragma unroll
            for (int r4 = 0; r4 < 16; r4 += 8) {
                float b0[8], b1[8];
#pragma unroll
                for (int i = 0; i < 8; ++i) { const int kc = crow(r4 + i, hi); b0[i] = tb[kc]; b1[i] = tb[kc + 32]; }
                asm volatile("s_waitcnt lgkmcnt(0)" ::: "memory");
#pragma unroll
                for (int i = 0; i < 8; ++i) { const int r = r4 + i, kc = crow(r, hi);
                    p0[r] = ((unsigned)(kc - mi.c) < 16u) ? p0[r] + b0[i] : -1e30f; p1[r] = ((unsigned)(kc + 32 - mi.c) < 16u) ? p1[r] + b1[i] : -1e30f; }
                SBAR();
            }
        }
    }
}
__device__ __forceinline__ void partialSM(f32x16& p0, f32x16& p1, float& m_reg, float& mn, float& alpha) {
    constexpr float C = SCALE * 1.4426950408889634f;
    float pmax = p0[0];
#pragma unroll
    for (int r = 1; r < 16; ++r) pmax = fmaxf(pmax, p0[r]);
#pragma unroll
    for (int r = 0; r < 16; ++r) pmax = fmaxf(pmax, p1[r]);
    { auto rr = __builtin_amdgcn_permlane32_swap(__float_as_uint(pmax), __float_as_uint(pmax), false, false);
      pmax = fmaxf(__uint_as_float(rr[0]), __uint_as_float(rr[1])); }
    if (__builtin_expect(__all(pmax - m_reg <= THR / SCALE), 1)) { mn = m_reg; alpha = 1.f; }
    else { mn = fmaxf(m_reg, pmax); alpha = __builtin_amdgcn_exp2f((m_reg - mn) * C); m_reg = mn; }
    const float mnC = -mn * C;
#pragma unroll
    for (int r = 0; r < 16; ++r) p0[r] = fmaf(p0[r], C, mnC);
#pragma unroll
    for (int r = 0; r < 16; ++r) p1[r] = fmaf(p1[r], C, mnC);
#pragma unroll
    for (int r = 0; r < 16; ++r) p0[r] = __builtin_amdgcn_exp2f(p0[r]);
}
__device__ __forceinline__ void finishSM(f32x16& p0, f32x16& p1, float alpha, float& l_reg, bf16x8& pa0, bf16x8& pa1, bf16x8& pa2, bf16x8& pa3) {
#pragma unroll
    for (int r = 0; r < 16; ++r) p1[r] = __builtin_amdgcn_exp2f(p1[r]);
    float ps = 0;
#pragma unroll
    for (int r = 0; r < 16; ++r) ps += p0[r];
#pragma unroll
    for (int r = 0; r < 16; ++r) ps += p1[r];
    { auto rr = __builtin_amdgcn_permlane32_swap(__float_as_uint(ps), __float_as_uint(ps), false, false);
      ps = __uint_as_float(rr[0]) + __uint_as_float(rr[1]); }
    l_reg = l_reg * alpha + ps;
#define PK4(P, BASE, OUT) do { unsigned a0 = cvtpk(P[BASE + 0], P[BASE + 1]), a1 = cvtpk(P[BASE + 2], P[BASE + 3]);   \
    unsigned b0 = cvtpk(P[BASE + 4], P[BASE + 5]), b1 = cvtpk(P[BASE + 6], P[BASE + 7]);                              \
    auto r0 = __builtin_amdgcn_permlane32_swap(a0, b0, false, false); auto r1 = __builtin_amdgcn_permlane32_swap(a1, b1, false, false); \
    v4u w = {r0[0], r1[0], r0[1], r1[1]}; OUT = __builtin_bit_cast(bf16x8, w); } while (0)
    PK4(p0, 0, pa0); PK4(p0, 8, pa1); PK4(p1, 0, pa2); PK4(p1, 8, pa3);
#undef PK4
}
__device__ __forceinline__ void qkt(f32x16& p0, f32x16& p1, const LAS char* Ks, const bf16x8* qr, int r32, int hi) {
    p0 = f32x16{}; p1 = f32x16{};
#pragma unroll
    for (int d0 = 0; d0 < 8; ++d0) { const int cb = (d0 * 16 + hi * 8) * 2;
        const bf16x8 b0 = *(const LAS bf16x8*)(Ks + KSWZ(r32, cb));
        const bf16x8 b1 = *(const LAS bf16x8*)(Ks + KSWZ(32 + r32, cb));
        p0 = __builtin_amdgcn_mfma_f32_32x32x16_bf16(b0, qr[d0], p0, 0, 0, 0);
        p1 = __builtin_amdgcn_mfma_f32_32x32x16_bf16(b1, qr[d0], p1, 0, 0, 0); }
}
__device__ __forceinline__ int v_st(int k, int c) { const int kk = (k & ~0xC) | ((k & 4) << 1) | ((k & 8) >> 1); return ((kk >> 3) * 4 + (c >> 5)) * 512 + ((kk & 7) * 32 + (c & 31)) * 2; }
__device__ __forceinline__ int v_rd_base(int lane) { return ((lane & 3) << 3) | (((lane >> 2) & 3) << 6) | (((lane >> 4) & 1) << 5) | (((lane >> 5) & 1) << 8); }
constexpr int v_rd_off(int d0, int ks, int half) { return d0 * 512 + ks * 4096 + half * 2048; }
template <int OFF> __device__ __forceinline__ s16x4 tr_read(int vb) {
    s16x4 r; asm volatile("ds_read_b64_tr_b16 %0, %1 offset:%2" : "=&v"(r) : "v"(vb), "i"(OFF) : "memory"); return r;
}
template <int D0> __device__ __forceinline__ void pv_one(f32x16& od, int vb, bf16x8 pa0, bf16x8 pa1, bf16x8 pa2, bf16x8 pa3) {
    const s16x4 l0 = tr_read<v_rd_off(D0, 0, 0)>(vb), h0 = tr_read<v_rd_off(D0, 0, 1)>(vb), l1 = tr_read<v_rd_off(D0, 1, 0)>(vb), h1 = tr_read<v_rd_off(D0, 1, 1)>(vb);
    const s16x4 l2 = tr_read<v_rd_off(D0, 2, 0)>(vb), h2 = tr_read<v_rd_off(D0, 2, 1)>(vb), l3 = tr_read<v_rd_off(D0, 3, 0)>(vb), h3 = tr_read<v_rd_off(D0, 3, 1)>(vb);
    asm volatile("s_waitcnt lgkmcnt(0)" ::: "memory"); SBAR();
#define PK(L, H) (bf16x8){L[0], L[1], L[2], L[3], H[0], H[1], H[2], H[3]}
    od = __builtin_amdgcn_mfma_f32_32x32x16_bf16(pa0, PK(l0, h0), od, 0, 0, 0);
    od = __builtin_amdgcn_mfma_f32_32x32x16_bf16(pa1, PK(l1, h1), od, 0, 0, 0);
    od = __builtin_amdgcn_mfma_f32_32x32x16_bf16(pa2, PK(l2, h2), od, 0, 0, 0);
    od = __builtin_amdgcn_mfma_f32_32x32x16_bf16(pa3, PK(l3, h3), od, 0, 0, 0);
#undef PK
}
template <int D0> __device__ __forceinline__ void pv_two(f32x16& oa, f32x16& ob, int vb, bf16x8 pa0, bf16x8 pa1, bf16x8 pa2, bf16x8 pa3) {
    const s16x4 l0 = tr_read<v_rd_off(D0, 0, 0)>(vb), h0 = tr_read<v_rd_off(D0, 0, 1)>(vb), l1 = tr_read<v_rd_off(D0, 1, 0)>(vb), h1 = tr_read<v_rd_off(D0, 1, 1)>(vb);
    const s16x4 l2 = tr_read<v_rd_off(D0, 2, 0)>(vb), h2 = tr_read<v_rd_off(D0, 2, 1)>(vb), l3 = tr_read<v_rd_off(D0, 3, 0)>(vb), h3 = tr_read<v_rd_off(D0, 3, 1)>(vb);
    const s16x4 m0 = tr_read<v_rd_off(D0 + 1, 0, 0)>(vb), n0 = tr_read<v_rd_off(D0 + 1, 0, 1)>(vb), m1 = tr_read<v_rd_off(D0 + 1, 1, 0)>(vb), n1 = tr_read<v_rd_off(D0 + 1, 1, 1)>(vb);
    const s16x4 m2 = tr_read<v_rd_off(D0 + 1, 2, 0)>(vb), n2 = tr_read<v_rd_off(D0 + 1, 2, 1)>(vb), m3 = tr_read<v_rd_off(D0 + 1, 3, 0)>(vb), n3 = tr_read<v_rd_off(D0 + 1, 3, 1)>(vb);
    asm volatile("s_waitcnt lgkmcnt(0)" ::: "memory"); SBAR();
#define PK(L, H) (bf16x8){L[0], L[1], L[2], L[3], H[0], H[1], H[2], H[3]}
    oa = __builtin_amdgcn_mfma_f32_32x32x16_bf16(pa0, PK(l0, h0), oa, 0, 0, 0); ob = __builtin_amdgcn_mfma_f32_32x32x16_bf16(pa0, PK(m0, n0), ob, 0, 0, 0);
    oa = __builtin_amdgcn_mfma_f32_32x32x16_bf16(pa1, PK(l1, h1), oa, 0, 0, 0); ob = __builtin_amdgcn_mfma_f32_32x32x16_bf16(pa1, PK(m1, n1), ob, 0, 0, 0);
    oa = __builtin_amdgcn_mfma_f32_32x32x16_bf16(pa2, PK(l2, h2), oa, 0, 0, 0); ob = __builtin_amdgcn_mfma_f32_32x32x16_bf16(pa2, PK(m2, n2), ob, 0, 0, 0);
    oa = __builtin_amdgcn_mfma_f32_32x32x16_bf16(pa3, PK(l3, h3), oa, 0, 0, 0); ob = __builtin_amdgcn_mfma_f32_32x32x16_bf16(pa3, PK(m3, n3), ob, 0, 0, 0);
#undef PK
}
__device__ __forceinline__ void pv_d0(f32x16* o, int vb, bf16x8 pa0, bf16x8 pa1, bf16x8 pa2, bf16x8 pa3) {
#if PV_TWO
    pv_two<0>(o[0], o[1], vb, pa0, pa1, pa2, pa3); pv_two<2>(o[2], o[3], vb, pa0, pa1, pa2, pa3);
#else
    pv_one<0>(o[0], vb, pa0, pa1, pa2, pa3); pv_one<1>(o[1], vb, pa0, pa1, pa2, pa3); pv_one<2>(o[2], vb, pa0, pa1, pa2, pa3); pv_one<3>(o[3], vb, pa0, pa1, pa2, pa3);
#endif
}

template <int MODE> __device__ __forceinline__ bool tile_active(int widx, int lo, int nwin, int qa, int md) {
    if (!TILE_SKIP || MODE == 3 || widx < 0) return true;
    bool a = true;
    if (MODE == 0) a = widx < nwin && (unsigned)(lo + widx - md) < 8u;
    if (MODE == 1) { const int k0 = 64 * (lo + widx); a = widx < nwin && k0 + 63 >= qa - 128 && k0 <= qa + 31 + 128; }
    return __builtin_amdgcn_readfirstlane(a ? 1 : 0) != 0;
}
template <int MODE>
__device__ __forceinline__ void attn_unit(const bf16* __restrict__ QKV, int ldq, int qcol, int kcol, int vcol, bf16* __restrict__ AO, int qrow0, int ctx0, int lat0, int lo, int nwin, int NT,
                                          MaskInfo mi, const float* extra, bool use_sink, LAS char* lds, int wave_id, const float* qg, const float* rope_c) {
    const int tid = opq(wave_id * 64 + lane_now()), wid = wave_id, lane = tid & 63, r32 = lane & 31, hi = lane >> 5;
    LAS float* wsx = (LAS float*)(lds + OFF_WS) + wid * 64; LAS float* li_l = wsx; LAS float* al_l = wsx + 32;
    LAS float* tab = (LAS float*)(lds + OFF_TAB);
    if (MODE == 0) {
        for (int idx = tid; idx < 15 * 128; idx += NWAVES * 64) { const int drow = idx >> 7, dcol = (idx & 127) - 48;
            tab[idx] = (extra != nullptr && dcol >= 0 && dcol < 31) ? extra[drow * 31 + dcol] * (1.0f / SCALE) : 0.f; }
    }
    float m_reg = -1e30f, l_reg = 0; f32x16 o[4] = {}; bf16x8 qr[8];
    const bf16* Qw = QKV + (size_t)(qrow0 + wid * QBLK + r32) * ldq + qcol + hi * 8;
#pragma unroll
    for (int d0 = 0; d0 < 8; ++d0) qr[d0] = *(const GAS bf16x8*)(Qw + d0 * 16);
    const int vb0 = (int)(uintptr_t)lds + v_rd_base(lane);
    unsigned goff[4];
#pragma unroll
    for (int i = 0; i < 4; ++i) { const int s_ = 512 * i + tid;
        if (i < 2) { const int ob = s_ * 16, sub = ob >> 9, kk = (sub >> 2) * 8 + ((ob & 511) >> 6), k = (kk & ~0xC) | ((kk & 4) << 1) | ((kk & 8) >> 1), c = (sub & 3) * 32 + ((ob & 63) >> 1); goff[i] = (unsigned)(k * ldq + vcol + c); }
        else { const int ob = (s_ - 1024) * 16, row = ob >> 8, cb = (ob & 255) ^ ((row & 7) << 4); goff[i] = (unsigned)(row * ldq + kcol + (cb >> 1)); } }
#define TROW(j) ((j) < 4 ? ctx0 + 64 * (j) : lat0 + 64 * (((j) - 4) < nwin ? ((j) - 4) : nwin - 1))
#define DMA(j) do { const GAS bf16* tb_ = (const GAS bf16*)QKV + (size_t)TROW(j) * ldq; LAS char* db_ = lds + ((j) & 3) * BUFB + wid * 1024; \
    _Pragma("unroll") for (int i_ = 0; i_ < 4; ++i_) __builtin_amdgcn_global_load_lds((const unsigned*)(const void*)(tb_ + goff[i_]), (LAS unsigned*)(db_ + i_ * 8192), 16, 0, 0); } while (0)
#define WAITV4() asm volatile("s_waitcnt vmcnt(4)" ::: "memory")
#define WAITV0() asm volatile("s_waitcnt vmcnt(0)" ::: "memory")
#define BAR() do { asm volatile("" ::: "memory"); __builtin_amdgcn_s_barrier(); asm volatile("" ::: "memory"); } while (0)
#define KBUF(j) (lds + ((j) & 3) * BUFB + SHM_V)
#define VBUF(j) (vb0 + ((j) & 3) * BUFB)
#define RESC(a) do { if (__any((a) < 1.f)) { if (hi == 0) al_l[r32] = (a); asm volatile("s_waitcnt lgkmcnt(0)" ::: "memory"); \
    _Pragma("unroll") for (int d = 0; d < 4; ++d) _Pragma("unroll") for (int r = 0; r < 16; ++r) o[d][r] *= al_l[crow(r, hi)]; } } while (0)
#define MASK(P0, P1, j) apply_mask<MODE>(P0, P1, (j) - 4, lo, nwin, mi, hi, tab)
    f32x16 pA0, pA1, pB0, pB1; float mnA, mnB, alA, alB; bf16x8 pa0, pa1, pa2, pa3;
    DMA(0); DMA(1);
    if (qg != nullptr) {
        float ss = 0.f;
#pragma unroll
        for (int d0 = 0; d0 < 8; ++d0)
#pragma unroll
            for (int e = 0; e < 8; ++e) { const float x = bf2f((bf16)qr[d0][e]); ss += x * x; }
        { auto rr = __builtin_amdgcn_permlane32_swap(__float_as_uint(ss), __float_as_uint(ss), false, false); ss = __uint_as_float(rr[0]) + __uint_as_float(rr[1]); }
        const float rstd = 1.0f / sqrtf(ss * (1.0f / HD) + NORM_EPS);
        const int t = (qrow0 + wid * QBLK + r32) & (SEQ - 1);
#pragma unroll
        for (int a = 0; a < 2; ++a)
#pragma unroll
            for (int dd = 0; dd < 2; ++dd) { const int d1 = 4 * a + dd, d2 = d1 + 2, c1 = d1 * 16 + hi * 8;
                const f32x4 g1a = *(const GAS f32x4*)(qg + c1), g1b = *(const GAS f32x4*)(qg + c1 + 4), g2a = *(const GAS f32x4*)(qg + c1 + 32), g2b = *(const GAS f32x4*)(qg + c1 + 36);
                float x1[8], x2[8];
#pragma unroll
                for (int e = 0; e < 8; ++e) { x1[e] = bf2f((bf16)qr[d1][e]) * rstd * (e < 4 ? g1a[e & 3] : g1b[e & 3]); x2[e] = bf2f((bf16)qr[d2][e]) * rstd * (e < 4 ? g2a[e & 3] : g2b[e & 3]); }
                if (rope_c != nullptr) { const int pos = a ? (t & (GRIDW - 1)) : (t >> 6), f0 = dd * 16 + hi * 8; const float* cp = rope_c + pos * 32 + f0;
                    const f32x4 ca = *(const GAS f32x4*)cp, cb = *(const GAS f32x4*)(cp + 4), sa = *(const GAS f32x4*)(cp + 4096), sb = *(const GAS f32x4*)(cp + 4100);
#pragma unroll
                    for (int e = 0; e < 8; ++e) { const float c = e < 4 ? ca[e & 3] : cb[e & 3], sn = e < 4 ? sa[e & 3] : sb[e & 3]; const float n1 = x1[e] * c - x2[e] * sn, n2 = x2[e] * c + x1[e] * sn; x1[e] = n1; x2[e] = n2; } }
                const v4u w1 = {cvtpk(x1[0], x1[1]), cvtpk(x1[2], x1[3]), cvtpk(x1[4], x1[5]), cvtpk(x1[6], x1[7])}, w2 = {cvtpk(x2[0], x2[1]), cvtpk(x2[2], x2[3]), cvtpk(x2[4], x2[5]), cvtpk(x2[6], x2[7])};
                qr[d1] = __builtin_bit_cast(bf16x8, w1); qr[d2] = __builtin_bit_cast(bf16x8, w2); }
    }
    WAITV4(); BAR();
    DMA(2);
    const int qa_u = __builtin_amdgcn_readfirstlane(mi.a), md_u = __builtin_amdgcn_readfirstlane(mi.d);
#define ACT(j) tile_active<MODE>((j) - 4, lo, nwin, qa_u, md_u)
    bool aA = true, aB = true;
    qkt(pA0, pA1, KBUF(0), qr, r32, hi); MASK(pA0, pA1, 0); partialSM(pA0, pA1, m_reg, mnA, alA);
    for (int j = 1; j + 1 < NT; j += 2) {
        WAITV4(); BAR();
        if (j + 2 < NT) DMA(j + 2);
        aB = ACT(j);
        SBAR(); if (aB) qkt(pB0, pB1, KBUF(j), qr, r32, hi);
        if (aA) { finishSM(pA0, pA1, alA, l_reg, pa0, pa1, pa2, pa3); SBAR();
                  pv_d0(o, VBUF(j - 1), pa0, pa1, pa2, pa3); }
        if (aB) { MASK(pB0, pB1, j); partialSM(pB0, pB1, m_reg, mnB, alB);
                  RESC(alB); }
        if (j + 2 < NT) WAITV4(); else WAITV0();
        BAR();
        if (j + 3 < NT) DMA(j + 3);
        aA = ACT(j + 1);
        SBAR(); if (aA) qkt(pA0, pA1, KBUF(j + 1), qr, r32, hi);
        if (aB) { finishSM(pB0, pB1, alB, l_reg, pa0, pa1, pa2, pa3); SBAR();
                  pv_d0(o, VBUF(j), pa0, pa1, pa2, pa3); }
        if (aA) { MASK(pA0, pA1, j + 1); partialSM(pA0, pA1, m_reg, mnA, alA);
                  RESC(alA); }
    }
    WAITV0(); BAR();
    aB = ACT(NT - 1);
    SBAR(); if (aB) qkt(pB0, pB1, KBUF(NT - 1), qr, r32, hi);
    if (aA) { finishSM(pA0, pA1, alA, l_reg, pa0, pa1, pa2, pa3); SBAR();
              pv_d0(o, VBUF(NT - 2), pa0, pa1, pa2, pa3); }
    if (aB) { MASK(pB0, pB1, NT - 1); partialSM(pB0, pB1, m_reg, mnB, alB);
              RESC(alB);
              finishSM(pB0, pB1, alB, l_reg, pa0, pa1, pa2, pa3); SBAR();
              pv_d0(o, VBUF(NT - 1), pa0, pa1, pa2, pa3); }
#undef ACT
    if (MODE == 1 && use_sink) l_reg += __builtin_amdgcn_exp2f(extra[0] * 1.4426950408889634f - m_reg * (SCALE * 1.4426950408889634f));
    if (hi == 0) li_l[r32] = l_reg; asm volatile("s_waitcnt lgkmcnt(0)" ::: "memory");
    float rli[16];
#pragma unroll
    for (int r = 0; r < 16; ++r) rli[r] = __builtin_amdgcn_rcpf(li_l[crow(r, hi)]);
    bf16* Ow = AO + (size_t)(qrow0 + wid * QBLK) * DM + qcol;
#pragma unroll
    for (int r = 0; r < 16; ++r) { const int orow = crow(r, hi);
#pragma unroll
        for (int d0 = 0; d0 < 4; ++d0) ((GAS bf16*)Ow)[(size_t)orow * DM + d0 * 32 + r32] = (bf16)(pk2(o[d0][r] * rli[r], 0.f) & 0xffffu); }
#undef TROW
#undef DMA
#undef WAITV4
#undef WAITV0
#undef BAR
#undef KBUF
#undef VBUF
#undef RESC
#undef MASK
}
#undef KSWZ

template <int MODE>
__device__ __forceinline__ void attn_phase(Frame& F, const Args& A, int ldq, int nkv, const float* extra, bool with_ctx, const float* qg, const float* rope_c) {
    const bf16* QKV = (const bf16*)(opq_ptr(A.ws) + WS_QKV); bf16* AO = (bf16*)(opq_ptr(A.ws) + WS_AO); LAS char* lds = (LAS char*)F.ldsp();
    const int G_ = NH / nkv, nunits = 2048 + (with_ctx ? 64 : 0);
    const int wid = F.wv(), r32 = opq(F.lane_id()) & 31;
    for (int u = F.vc(); u < nunits; u += F.ng()) {
        const bool cu = u >= 2048;
        const int b = cu ? (u - 2048) >> 4 : u >> 9, h = cu ? (u - 2048) & 15 : (u >> 5) & 15, qt = u & 31, kvh = h / G_;
        const int qcol = h * HD, kcol = DM + kvh * HD, vcol = DM + nkv * HD + kvh * HD, ctx0 = MLAT + b * CTXL;
        int qrow0, lat0 = 0, lo = 0, nwin = 0, NT = 4; MaskInfo mi{0, 0, 0, 0};
        if (cu) { qrow0 = ctx0; }
        else {
            qrow0 = b * SEQ + qt * 256;
            if (MODE == 3) { lo = 0; nwin = SEQ / 64; }
            if (MODE == 1) { lo = qt * 4 - 2 < 0 ? 0 : qt * 4 - 2; const int hiT = qt * 4 + 6 > SEQ / 64 ? SEQ / 64 : qt * 4 + 6; nwin = hiT - lo; mi.a = qt * 256 + wid * 32 + r32; }
            if (MODE == 0) { lo = qt * 4 - 4 < 0 ? 0 : qt * 4 - 4; const int hc_ = qt * 4 - 1 < 0 ? 0 : (qt * 4 - 1 > 120 ? 120 : qt * 4 - 1); const int hiR = hc_ + 7; nwin = hiR - lo + 1;
                const int qr_ = qt * 4 + (wid >> 1), qc = (wid & 1) * 32 + r32; mi.a = qr_; mi.b = qc; mi.c = qc - 8 < 0 ? 0 : (qc - 8 > 48 ? 48 : qc - 8); mi.d = qr_ - 4 < 0 ? 0 : (qr_ - 4 > 120 ? 120 : qr_ - 4); }
            lat0 = b * SEQ + lo * 64; NT = 4 + nwin; NT += NT & 1;
        }
        const float* ex = nullptr; bool sink = false;
        if (MODE == 0) ex = cu ? nullptr : extra + h * (15 * 31);
        if (MODE == 1) { ex = extra + h; sink = true; }
        attn_unit<MODE>(QKV, ldq, qcol, kcol, vcol, AO, qrow0, ctx0, lat0, lo, nwin, NT, mi, ex, sink, lds, F.wv(), qg, cu ? nullptr : rope_c);
        __syncthreads();
    }
}
}

namespace ml {
typedef short v4i16_t __attribute__((ext_vector_type(4)));
constexpr int NCH = 132;
constexpr size_t OFF_WB = 0, OFF_TAB = 40 * MiB, OFF_NLOC = 48 * MiB;
constexpr int TAB_P = 0, TAB_E = 64, TAB_DEN = 128, TAB_DECAY = 192, TAB_N = 320;
constexpr int QSTR = 528, VSTR = 144;
__device__ __forceinline__ bf16x8 trfrag(const LAS char* p0, const LAS char* p1) {
    const s16x4 a = __builtin_bit_cast(s16x4, __builtin_amdgcn_ds_read_tr16_b64_v4i16((LAS v4i16_t*)p0));
    const s16x4 b = __builtin_bit_cast(s16x4, __builtin_amdgcn_ds_read_tr16_b64_v4i16((LAS v4i16_t*)p1));
    return (bf16x8){a[0], a[1], a[2], a[3], b[0], b[1], b[2], b[3]};
}
__device__ __forceinline__ float rdlane(float v, int l) { return __builtin_bit_cast(float, __builtin_amdgcn_readlane(__builtin_bit_cast(int, v), l)); }
__device__ __forceinline__ float log_sigmoid(float g) { return fminf(g, 0.f) - log1pf(__expf(-fabsf(g))); }
__device__ __forceinline__ int chrow(int b, int dir, int c, int s) {
    return c < 4 ? (dir ? MLAT + b * CTXL + 255 - (64 * c + s) : MLAT + b * CTXL + 64 * c + s) : (dir ? b * SEQ + SEQ - 1 - (64 * (c - 4) + s) : b * SEQ + 64 * (c - 4) + s);
}

namespace pa { constexpr int QS = 0, KS = 33792, GI = 67584, GF = 67840, TAB = 68096  , DENP = 78336  , NP = 78848  , BL = 80896  , PM = 81424  ; }
__device__ __forceinline__ void mlstm_pre_a(Frame& F, const Args& A) {
    using namespace pa;
    unsigned char* ws = opq_ptr(A.ws); const bf16* QKV = (const bf16*)(ws + WS_QKV); const float* GT = (const float*)(ws + WS_GATES);
    bf16* WB = (bf16*)(ws + WS_PART + OFF_WB); float* TABG = (float*)(ws + WS_PART + OFF_TAB); float* NLOC = (float*)(ws + WS_PART + OFF_NLOC); bf16* KTW = (bf16*)(ws + WS_HX);
    LAS char* lds = (LAS char*)F.ldsp();
    const int tid = opq(F.tid_()), w = F.wv(), lane = tid & 63, r = lane & 15, q = lane >> 4;
    LAS float* tabA = (LAS float*)(lds + TAB + w * 1280); LAS float* tabM = tabA + 64; LAS float* tabP = tabA + 128; LAS float* tabE = tabA + 192; LAS float* tabW = tabA + 256;
    for (int u = F.vc(); u < 256; u += F.ng()) {
        const int seg = u & 7, chain = u >> 3, dir = chain & 1, h = (chain >> 1) & 3, b = chain >> 3;
        const int gi_idx = (dir ? 8 : 0) + h, gf_idx = (dir ? 12 : 4) + h, qcol = h * 256, kcol = 1024 + h * 256;
        const int c0 = seg * 17, c1 = c0 + 17 < NCH ? c0 + 17 : NCH;
        for (int cb = w; cb < c0; cb += 4 * NWAVES) {
            float gi4[4], gf4[4];
#pragma unroll
            for (int k = 0; k < 4; ++k) { const int c = cb + k * NWAVES; const float* gp = GT + (size_t)chrow(b, dir, c < c0 ? c : cb, lane) * 16; gi4[k] = gp[gi_idx]; gf4[k] = gp[gf_idx]; }
#pragma unroll
            for (int k = 0; k < 4; ++k) { const int c = cb + k * NWAVES;
                const float bs = scan_add(log_sigmoid(gf4[k]));
                const float pm = wave_max(gi4[k] - bs);
                if (lane == 63 && c < c0) { ((LAS float*)(lds + BL))[c] = bs; ((LAS float*)(lds + PM))[c] = pm; } } }
        __syncthreads();
        float m = 0.f;
        for (int c = 0; c < c0; ++c) m = ((LAS float*)(lds + BL))[c] + fmaxf(m, ((LAS float*)(lds + PM))[c]);
        v4u pq[4], pk[4]; float pgi = 0.f, pgf = 0.f;
#define PREFETCH(c) do { _Pragma("unroll") for (int i_ = 0; i_ < 4; ++i_) { const int pi_ = tid + 512 * i_, s_ = pi_ >> 5, cp_ = pi_ & 31; const bf16* rp_ = QKV + (size_t)chrow(b, dir, c, s_) * 6144 + 8 * cp_; \
            pq[i_] = *(const GAS v4u*)(rp_ + qcol); pk[i_] = *(const GAS v4u*)(rp_ + kcol); } \
        if (tid < 64) { const float* gp_ = GT + (size_t)chrow(b, dir, c, tid) * 16; pgi = gp_[gi_idx]; pgf = gp_[gf_idx]; } } while (0)
#define COMMIT() do { _Pragma("unroll") for (int i_ = 0; i_ < 4; ++i_) { const int pi_ = tid + 512 * i_, s_ = pi_ >> 5, cp_ = pi_ & 31; \
            *(LAS v4u*)(lds + QS + s_ * QSTR + cp_ * 16) = pq[i_]; *(LAS v4u*)(lds + KS + s_ * QSTR + cp_ * 16) = pk[i_]; } \
        if (tid < 64) { ((LAS float*)(lds + GI))[tid] = pgi; ((LAS float*)(lds + GF))[tid] = pgf; } } while (0)
        PREFETCH(c0); VM_WAIT(); COMMIT(); __syncthreads();
        for (int c = c0; c < c1; ++c) {
            if (c + 1 < c1) PREFETCH(c + 1);
            const size_t cc = (size_t)chain * NCH + c;
            float decay, m_next;
            { const float gi = ((LAS float*)(lds + GI))[lane], lf = log_sigmoid(((LAS float*)(lds + GF))[lane]);
              const float bsum = scan_add(lf);
              const float a = gi - bsum; const float pm = scan_max(a);
              const float M = fmaxf(m, pm), Ml = rdlane(M, 63), bl = rdlane(bsum, 63);
              tabA[lane] = a; tabM[lane] = M; tabP[lane] = fast_exp(m - M); tabE[lane] = fast_exp(-(bsum + M)); tabW[lane] = fast_exp(a - Ml) * 0.0625f;
              decay = fast_exp(m - Ml); m_next = bl + Ml; }
            LDS_WAIT();
            { const int tb = w >> 1, sbh = w & 1; float rs = 0.f;
              const float Mt = tabM[16 * tb + r];
#pragma unroll
              for (int sbi = 0; sbi < 2; ++sbi) { const int sb = 2 * sbh + sbi; f32x4 wv = (f32x4){0.f, 0.f, 0.f, 0.f};
                  if (sb <= tb) { f32x4 acc = (f32x4){0.f, 0.f, 0.f, 0.f};
#pragma unroll
                      for (int kk = 0; kk < 8; ++kk) { const bf16x8 ka = *(const LAS bf16x8*)(lds + KS + (16 * sb + r) * QSTR + (32 * kk + 8 * q) * 2); const bf16x8 qb = *(const LAS bf16x8*)(lds + QS + (16 * tb + r) * QSTR + (32 * kk + 8 * q) * 2);
                          acc = __builtin_amdgcn_mfma_f32_16x16x32_bf16(ka, qb, acc, 0, 0, 0); }
                      const f32x4 a4 = *(const LAS f32x4*)(tabA + 16 * sb + 4 * q);
#pragma unroll
                      for (int i = 0; i < 4; ++i) wv[i] = (16 * sb + 4 * q + i <= 16 * tb + r) ? fast_exp(a4[i] - Mt) * acc[i] * 0.0625f : 0.f; }
                  rs += (wv[0] + wv[1]) + (wv[2] + wv[3]);
                  v2u o; o.x = pk2(wv[0], wv[1]); o.y = pk2(wv[2], wv[3]);
                  *(GAS v2u*)(WB + cc * 4096 + (16 * tb + r) * 64 + 16 * sb + 4 * q) = o; }
              rs = sum_xor16_32(rs);
              if (q == 0) ((LAS float*)(lds + DENP))[sbh * 64 + 16 * tb + r] = rs; }
            { const int d = tid & 255, sh = tid >> 8; float ns = 0.f; unsigned pkd[16];
#pragma unroll
              for (int i = 0; i < 16; ++i) { const int s0 = 32 * sh + 2 * i; const float v0 = tabW[s0] * bf2f(*(const LAS bf16*)(lds + KS + s0 * QSTR + d * 2)), v1 = tabW[s0 + 1] * bf2f(*(const LAS bf16*)(lds + KS + (s0 + 1) * QSTR + d * 2));
                  ns += v0 + v1; pkd[i] = pk2(v0, v1); }
              GAS v4u* kp = (GAS v4u*)(KTW + cc * 16384 + d * 64 + 32 * sh);
#pragma unroll
              for (int i = 0; i < 4; ++i) kp[i] = (v4u){pkd[4 * i], pkd[4 * i + 1], pkd[4 * i + 2], pkd[4 * i + 3]};
              ((LAS float*)(lds + NP))[sh * 256 + d] = ns; }
            __syncthreads();
            if (tid < 64) { float* tg = TABG + cc * TAB_N; tg[TAB_P + tid] = tabP[tid]; tg[TAB_E + tid] = tabE[tid]; tg[TAB_DEN + tid] = ((LAS float*)(lds + DENP))[tid] + ((LAS float*)(lds + DENP))[64 + tid]; if (tid == 0) tg[TAB_DECAY] = decay; }
            if (tid < 256) NLOC[cc * 256 + tid] = ((LAS float*)(lds + NP))[tid] + ((LAS float*)(lds + NP))[256 + tid];
            m = m_next;
            if (c + 1 < c1) { COMMIT(); }
            __syncthreads();
        }
#undef PREFETCH
#undef COMMIT
    }
}

namespace pb_ { constexpr int NSL = 0  , QNP = 1024  ; }
__device__ __forceinline__ void mlstm_pre_b(Frame& F, const Args& A) {
    using namespace pb_;
    unsigned char* ws = opq_ptr(A.ws); const bf16* QKV = (const bf16*)(ws + WS_QKV);
    float* TABG = (float*)(ws + WS_PART + OFF_TAB); const float* NLOC = (const float*)(ws + WS_PART + OFF_NLOC);
    LAS char* lds = (LAS char*)F.ldsp();
    const int tid = opq(F.tid_()), w = F.wv(), lane = tid & 63;
    for (int u = F.vc(); u < 256; u += F.ng()) {
        const int seg = u & 7, chain = u >> 3, dir = chain & 1, h = (chain >> 1) & 3, b = chain >> 3, qcol = h * 256;
        const int c0 = seg * 17, c1 = c0 + 17 < NCH ? c0 + 17 : NCH;
        float n = 0.f;
        if (tid < 256) {
            int c = 0;
            for (; c + 8 <= c0; c += 8) { float dk[8], vk[8];
#pragma unroll
                for (int k = 0; k < 8; ++k) { const size_t cc = (size_t)chain * NCH + c + k; dk[k] = TABG[cc * TAB_N + TAB_DECAY]; vk[k] = NLOC[cc * 256 + tid]; }
#pragma unroll
                for (int k = 0; k < 8; ++k) n = dk[k] * n + vk[k]; }
            for (; c < c0; ++c) { const size_t cc = (size_t)chain * NCH + c; n = TABG[cc * TAB_N + TAB_DECAY] * n + NLOC[cc * 256 + tid]; } }
        v4u qn[4];
        { const bf16* qp = QKV + (size_t)chrow(b, dir, c0, lane) * 6144 + qcol + 32 * w;
#pragma unroll
          for (int i = 0; i < 4; ++i) qn[i] = *(const GAS v4u*)(qp + 8 * i); }
        for (int c = c0; c < c1; ++c) {
            const size_t cc = (size_t)chain * NCH + c;
            if (tid < 256) ((LAS float*)(lds + NSL))[tid] = n;
            v4u qv4[4];
#pragma unroll
            for (int i = 0; i < 4; ++i) qv4[i] = qn[i];
            if (c + 1 < c1) { const bf16* qp = QKV + (size_t)chrow(b, dir, c + 1, lane) * 6144 + qcol + 32 * w;
#pragma unroll
                for (int i = 0; i < 4; ++i) qn[i] = *(const GAS v4u*)(qp + 8 * i); }
            float dcy = 0.f, nlc = 0.f;
            if (tid < 256) { dcy = TABG[cc * TAB_N + TAB_DECAY]; nlc = NLOC[cc * 256 + tid]; }
            float dprev = 0.f, pprev = 0.f;
            if (tid < 64) { dprev = TABG[cc * TAB_N + TAB_DEN + tid]; pprev = TABG[cc * TAB_N + TAB_P + tid]; }
            __syncthreads();
            { float s = 0.f; const LAS float* ns = (const LAS float*)(lds + NSL) + 32 * w;
#pragma unroll
              for (int i = 0; i < 4; ++i) { const v4u qv = qv4[i]; const f32x4 n0 = *(const LAS f32x4*)(ns + 8 * i), n1 = *(const LAS f32x4*)(ns + 8 * i + 4);
                  s += bf_lo(qv.x) * n0.x + bf_hi(qv.x) * n0.y + bf_lo(qv.y) * n0.z + bf_hi(qv.y) * n0.w + bf_lo(qv.z) * n1.x + bf_hi(qv.z) * n1.y + bf_lo(qv.w) * n1.z + bf_hi(qv.w) * n1.w; }
              ((LAS float*)(lds + QNP))[w * 64 + lane] = s; }
            __syncthreads();
            if (tid < 64) { float qn_ = 0.f;
#pragma unroll
                for (int ww = 0; ww < 8; ++ww) qn_ += ((LAS float*)(lds + QNP))[ww * 64 + tid];
                TABG[cc * TAB_N + TAB_DEN + tid] = dprev + pprev * qn_; }
            if (tid < 256) n = dcy * n + nlc;
        }
        __syncthreads();
    }
}

namespace sc { constexpr int QS = 0, KT = 33792  , VS = 74752  , WS_ = 83968  , TABL = 94208  , KSTR = 160, CT = 95232  ; }
__device__ __forceinline__ void mlstm_scan(Frame& F, const Args& A) {
    using namespace sc;
    unsigned char* ws = opq_ptr(A.ws); const bf16* QKV = (const bf16*)(ws + WS_QKV);
    const bf16* WB = (const bf16*)(ws + WS_PART + OFF_WB); const float* TABG = (const float*)(ws + WS_PART + OFF_TAB); const bf16* KTW = (const bf16*)(ws + WS_HX);
    LAS char* lds = (LAS char*)F.ldsp();
    const int tid = opq(F.tid_()), w = F.wv(), lane = tid & 63, r = lane & 15, q = lane >> 4, nb = w & 3, th = w >> 2;
    for (int u = F.vc(); u < 256; u += F.ng()) {
        const int j = u & 7, chain = u >> 3, dir = chain & 1, h = (chain >> 1) & 3, b = chain >> 3;
        bf16* OUT = (bf16*)(ws + (dir ? WS_HB : WS_AO));
        const int qcol = h * 256, vcol = 2048 + h * 512 + j * 64, ocol = h * 512 + j * 64;
        f32x4 Cw[2][4];
#pragma unroll
        for (int rb = 0; rb < 2; ++rb)
#pragma unroll
            for (int cb = 0; cb < 4; ++cb) Cw[rb][cb] = (f32x4){0.f, 0.f, 0.f, 0.f};
        for (int i = tid; i < 64 * QSTR / 16; i += NWAVES * 64) *(LAS v4u*)(lds + CT + 16 * i) = (v4u){0u, 0u, 0u, 0u};
        v4u pq[4], pk[4], pv, pw; f32x4 pt = (f32x4){0.f, 0.f, 0.f, 0.f};
#define PREFETCH(c) do { const size_t cc_ = (size_t)chain * NCH + (c); \
        _Pragma("unroll") for (int i_ = 0; i_ < 4; ++i_) { const int pi_ = tid + 512 * i_; pq[i_] = *(const GAS v4u*)(QKV + (size_t)chrow(b, dir, c, pi_ >> 5) * 6144 + qcol + 8 * (pi_ & 31)); \
            pk[i_] = *(const GAS v4u*)(KTW + cc_ * 16384 + (size_t)pi_ * 8); } \
        pv = *(const GAS v4u*)(QKV + (size_t)chrow(b, dir, c, tid >> 3) * 6144 + vcol + 8 * (tid & 7)); pw = *(const GAS v4u*)(WB + cc_ * 4096 + (size_t)tid * 8); \
        if (tid < 49) pt = *(const GAS f32x4*)(TABG + cc_ * TAB_N + 4 * tid); } while (0)
#define COMMIT() do { _Pragma("unroll") for (int i_ = 0; i_ < 4; ++i_) { const int pi_ = tid + 512 * i_; *(LAS v4u*)(lds + QS + (pi_ >> 5) * QSTR + (pi_ & 31) * 16) = pq[i_]; \
            *(LAS v4u*)(lds + KT + (pi_ >> 3) * KSTR + (pi_ & 7) * 16) = pk[i_]; } \
        *(LAS v4u*)(lds + VS + (tid >> 3) * VSTR + (tid & 7) * 16) = pv; *(LAS v4u*)(lds + WS_ + (tid >> 3) * KSTR + (tid & 7) * 16) = pw; \
        if (tid < 49) *(LAS f32x4*)(lds + TABL + 16 * tid) = pt; } while (0)
#define WARM(c) do { const size_t cc_ = (size_t)chain * NCH + (c); \
        const bf16* b0_ = (w < 4) ? QKV : KTW; const unsigned o0_ = (w < 4) ? (unsigned)((chrow(b, dir, c, tid >> 2) * 6144 + qcol + 64 * (tid & 3)) * 2) : (unsigned)((cc_ * 16384 + (size_t)(tid - 256) * 64) * 2); \
        asm volatile("global_load_dword %0, %1, %2" : "+v"(wrm0) : "v"(o0_), "s"(b0_) : "memory"); } while (0)
        int wrm0 = 0;
        PREFETCH(0); VM_WAIT(); COMMIT(); __syncthreads();
        WARM(1);
        for (int c = 0; c < NCH; ++c) {
            if (c + 1 < NCH) PREFETCH(c + 1);
            if (c + 2 < NCH) WARM(c + 2);
            const LAS float* tl = (const LAS float*)(lds + TABL);
            unsigned hout[4];
            bf16x8 vb[2];
#pragma unroll
            for (int ks = 0; ks < 2; ++ks) { const LAS char* vp = lds + VS + (32 * ks + 8 * q + (r >> 2)) * VSTR + (16 * nb + 4 * (r & 3)) * 2; vb[ks] = trfrag(vp, vp + 4 * VSTR); }
            { f32x4 intra[2], inter[2];
#pragma unroll
              for (int tbi = 0; tbi < 2; ++tbi) { intra[tbi] = (f32x4){0.f, 0.f, 0.f, 0.f}; inter[tbi] = (f32x4){0.f, 0.f, 0.f, 0.f}; }
#pragma unroll
              for (int ks = 0; ks < 2; ++ks)
#pragma unroll
                  for (int tbi = 0; tbi < 2; ++tbi) { const bf16x8 wa = *(const LAS bf16x8*)(lds + WS_ + (16 * (2 * th + tbi) + r) * KSTR + (32 * ks + 8 * q) * 2);
                      intra[tbi] = __builtin_amdgcn_mfma_f32_16x16x32_bf16(wa, vb[ks], intra[tbi], 0, 0, 0); }
#pragma unroll
              for (int hk = 0; hk < 2; ++hk) {
                  v4u cfr[4], qar[4][2];
#pragma unroll
                  for (int k4 = 0; k4 < 4; ++k4) { const int kk = 4 * hk + k4;
                      const LAS char* cp = lds + CT + (16 * nb + r) * QSTR + (32 * kk + 4 * q) * 2;
                      const v2u clo = *(const LAS v2u*)cp, chi = *(const LAS v2u*)(cp + 32); cfr[k4] = (v4u){clo.x, clo.y, chi.x, chi.y};
#pragma unroll
                      for (int tbi = 0; tbi < 2; ++tbi) { const LAS char* qp = lds + QS + (16 * (2 * th + tbi) + r) * QSTR + (32 * kk + 4 * q) * 2;
                          const v2u lo = *(const LAS v2u*)qp, hi2 = *(const LAS v2u*)(qp + 32); qar[k4][tbi] = (v4u){lo.x, lo.y, hi2.x, hi2.y}; } }
#pragma unroll
                  for (int k4 = 0; k4 < 4; ++k4)
#pragma unroll
                      for (int tbi = 0; tbi < 2; ++tbi) inter[tbi] = __builtin_amdgcn_mfma_f32_16x16x32_bf16(__builtin_bit_cast(bf16x8, qar[k4][tbi]), __builtin_bit_cast(bf16x8, cfr[k4]), inter[tbi], 0, 0, 0);
                  __builtin_amdgcn_sched_barrier(0);
              }
#pragma unroll
              for (int tbi = 0; tbi < 2; ++tbi) { const int t0 = 16 * (2 * th + tbi) + 4 * q;
                  const f32x4 P4 = *(const LAS f32x4*)(tl + TAB_P + t0), E4 = *(const LAS f32x4*)(tl + TAB_E + t0), D4 = *(const LAS f32x4*)(tl + TAB_DEN + t0);
                  float hv[4];
#pragma unroll
                  for (int i = 0; i < 4; ++i) hv[i] = (intra[tbi][i] + P4[i] * inter[tbi][i]) / fmaxf(fabsf(D4[i]), E4[i]);
                  hout[2 * tbi] = pk2(hv[0], hv[1]); hout[2 * tbi + 1] = pk2(hv[2], hv[3]); } }
            __builtin_amdgcn_sched_barrier(0);
            { const float decay = tl[TAB_DECAY];
#pragma unroll
              for (int rb = 0; rb < 2; ++rb)
#pragma unroll
                  for (int cb = 0; cb < 4; ++cb) Cw[rb][cb] *= decay;
              bf16x8 ka[2][2];
#pragma unroll
              for (int rb = 0; rb < 2; ++rb)
#pragma unroll
                  for (int ks = 0; ks < 2; ++ks) ka[rb][ks] = *(const LAS bf16x8*)(lds + KT + (32 * w + 16 * rb + r) * KSTR + (32 * ks + 8 * q) * 2);
#pragma unroll
              for (int cb = 0; cb < 4; ++cb) { bf16x8 vx[2];
#pragma unroll
                  for (int ks = 0; ks < 2; ++ks) { const LAS char* vp = lds + VS + (32 * ks + 8 * q + (r >> 2)) * VSTR + (16 * cb + 4 * (r & 3)) * 2; vx[ks] = trfrag(vp, vp + 4 * VSTR); }
#pragma unroll
                  for (int rb = 0; rb < 2; ++rb)
#pragma unroll
                      for (int ks = 0; ks < 2; ++ks) Cw[rb][cb] = __builtin_amdgcn_mfma_f32_16x16x32_bf16(ka[rb][ks], vx[ks], Cw[rb][cb], 0, 0, 0); } }
            __syncthreads();
            if (c + 1 < NCH) { if (c + 2 < NCH) asm volatile("s_waitcnt vmcnt(1)" : "+v"(wrm0) :: "memory"); else asm volatile("s_waitcnt vmcnt(0)" : "+v"(wrm0) :: "memory"); COMMIT(); }
#pragma unroll
            for (int rb = 0; rb < 2; ++rb)
#pragma unroll
                for (int cb = 0; cb < 4; ++cb) { v2u cw; cw.x = pk2(Cw[rb][cb][0], Cw[rb][cb][1]); cw.y = pk2(Cw[rb][cb][2], Cw[rb][cb][3]);
                    *(LAS v2u*)(lds + CT + (16 * cb + r) * QSTR + (32 * w + 16 * rb + 4 * q) * 2) = cw; }
#pragma unroll
            for (int tbi = 0; tbi < 2; ++tbi)
#pragma unroll
                for (int i = 0; i < 4; ++i) ((GAS bf16*)OUT)[(size_t)chrow(b, dir, c, 16 * (2 * th + tbi) + 4 * q + i) * DM + ocol + 16 * nb + r] = (bf16)((hout[2 * tbi + (i >> 1)] >> (16 * (i & 1))) & 0xffffu);
            __syncthreads();
        }
#undef PREFETCH
#undef COMMIT
#undef WARM
    }
}
}

constexpr int NPH = 42;
#ifndef EN_ALL
#define EN_ALL 1
#endif
#ifndef EN_PRO
#define EN_PRO EN_ALL
#endif
#ifndef EN_NORM
#define EN_NORM EN_ALL
#endif
#ifndef EN_G1
#define EN_G1 EN_ALL
#endif
#ifndef EN_QKN
#define EN_QKN EN_ALL
#endif
#ifndef EN_A0
#define EN_A0 EN_ALL
#endif
#ifndef EN_A1
#define EN_A1 EN_ALL
#endif
#ifndef EN_ML
#define EN_ML EN_ALL
#endif
#ifndef EN_MLA
#define EN_MLA 1
#endif
#ifndef EN_MLB
#define EN_MLB 1
#endif
#ifndef EN_MLS
#define EN_MLS 1
#endif
#ifndef EN_A3
#define EN_A3 EN_ALL
#endif
#ifndef EN_RO
#define EN_RO EN_ALL
#endif
#ifndef EN_G2
#define EN_G2 EN_ALL
#endif
#ifndef EN_G3
#define EN_G3 EN_ALL
#endif
#ifndef EN_FIX
#define EN_FIX EN_ALL
#endif
#ifndef EN_G4
#define EN_G4 EN_ALL
#endif


#ifndef REP_PRO
#define REP_PRO 1
#endif
#ifndef REP_NORM
#define REP_NORM 1
#endif
#ifndef REP_G1
#define REP_G1 1
#endif
#ifndef REP_QKN
#define REP_QKN 1
#endif
#ifndef REP_A0
#define REP_A0 1
#endif
#ifndef REP_A1
#define REP_A1 1
#endif
#ifndef REP_ML
#define REP_ML 1
#endif
#ifndef REP_A3
#define REP_A3 1
#endif
#ifndef REP_RO
#define REP_RO 1
#endif
#ifndef REP_G3
#define REP_G3 1
#endif
#ifndef REP_FIX
#define REP_FIX 1
#endif
#ifndef REP_G2
#define REP_G2 1
#endif
#ifndef REP_G4
#define REP_G4 1
#endif
#ifndef REP_MLA
#define REP_MLA 1
#endif
#ifndef REP_MLS
#define REP_MLS 1
#endif
#ifndef WGM_G1
#define WGM_G1 4
#endif
#ifndef WGM_G2
#define WGM_G2 4
#endif
#ifndef WGM_G3
#define WGM_G3 4
#endif
#ifndef WGM_G4
#define WGM_G4 4
#endif
#ifndef ORD_G1
#define ORD_G1 1
#endif
#ifndef ORD_G2
#define ORD_G2 1
#endif
#ifndef ORD_G3
#define ORD_G3 1
#endif
#ifndef ORD_G4
#define ORD_G4 1
#endif
#ifndef DIR_N1
#define DIR_N1 1
#endif
#ifndef DIR_N2
#define DIR_N2 1
#endif
#ifndef QFUSE
#define QFUSE 1
#endif
#ifndef XBAR
#define XBAR 1
#endif
#ifndef MK_MODE
#define MK_MODE 0
#endif
__global__ void __launch_bounds__(NWAVES * 64, 2) fwd(Args args) {
    extern __shared__ __attribute__((aligned(16))) unsigned char lds[];
    Frame F;
    F.lds = (LAS unsigned char*)lds; F.MISC = (volatile LAS unsigned*)(F.lds + MISC_OFF);
    F.wave = __builtin_amdgcn_readfirstlane((int)threadIdx.x >> 6);
    F.G = gridDim.x; F.bx = blockIdx.x; { const int bx = blockIdx.x; F.vcu = (F.G % 8 == 0) ? (bx % 8) * (F.G / 8) + bx / 8 : bx; }
    unsigned char* ws = args.ws; F.ctl = (gu32*)(ws + WS_CTL);
    for (int u = threadIdx.x; u < (LDS_BYTES - LDSCTL_OFF) / 4; u += NWAVES * 64) ((LAS unsigned*)(F.lds + LDSCTL_OFF))[u] = 0u;
    __syncthreads();
    const int lo = args.ph_lo, hi = args.ph_hi;
    XcdBarrier bar = xcd_barrier_post((unsigned*)(F.ctl + CW_BAR) + lo * XCD_BAR_WORDS, F.MISC + 8);
#define RUN(k) (lo <= (k) && (k) < hi)
#define BAR_AFTER(k) do { if ((k) + 1 < hi) { xcd_barrier(bar); if (XBAR == 2) xcd_barrier(bar); } } while (0)
    float* const out = args.out;
#define WSP(off) (opq_ptr(args.ws) + (off))
#define HX ((bf16*)WSP(WS_HX))
#define QKVb ((bf16*)WSP(WS_QKV))
#define AOb ((bf16*)WSP(WS_AO))
#define ACT ((bf16*)WSP(WS_QKV))

    if (EN_PRO && RUN(0)) { for (int rep_ = 0; rep_ < REP_PRO; ++rep_) { if (rep_) __syncthreads(); prologue_phase(F, args); } BAR_AFTER(0); }
    if (RUN(1)) { modred_phase(F, args); BAR_AFTER(1); }

#define LAYER_BODY(L) { \
        const int pb = 2 + 10 * L; const bool last = (L == 3); \
        const float* modl = (const float*)WSP(WS_MOD) + (size_t)L * 5 * NMOD; \
        const int nq = nqkv_of(L), mrows = last ? MLAT : MT; \
        if (EN_NORM && RUN(pb + 0)) { for (int rep_ = 0; rep_ < REP_NORM; ++rep_) norm_phase(F, args, L == 0 ? (const void*)ldarg(I_X) : (const void*)out, (L) != 0, ldarg(I_N1G) + (size_t)L * DM, modl, 0, true, L == 2, L == 0 ? nullptr : modl - 5 * NMOD + 4 * NMOD + 5 * DM, DIR_N1 != 0); BAR_AFTER(pb + 0); } \
        if (EN_G1 && RUN(pb + 1)) { \
            pg8::Gemm g{HX, (const bf16*)WSP(WS_WQKV + wqkv_off(L)), MT, nq, DM}; pg8::StaticOrder S; S.init(MT, nq, F.ng(), F.bx_(), DM); S.wgm = WGM_G1; S.ord = ORD_G1; \
            if ((L) == 2 || !((QKF_MASK >> (L)) & 1)) { pg8::EpiStore E{QKVb, nq}; \
                for (int rep_ = 0; rep_ < REP_G1; ++rep_) pg8::gemm_phase<pg8::EpiStore, pg8::StaticOrder, true, PG8_SP2>(F.ldsp() + RING_OFF, g, S, E, F.wv()); } \
            else { pg8::EpiQK E{QKVb, nq, (NH + ((L) == 0 ? 16 : ((L) == 1 ? 2 : 4))) / 2, ldarg((L) == 0 ? I_NAQG : ((L) == 1 ? I_SWQG : I_GQQG)), ldarg((L) == 0 ? I_NAKG : ((L) == 1 ? I_SWKG : I_GQKG)), \
                    (L) == 0 ? (const float*)nullptr : (const float*)WSP(WS_ROPE), (L) == 0 ? (const float*)nullptr : (const float*)WSP(WS_ROPE) + 4096, (PG8_LAS float*)(F.ldsp() + QKX_OFF)}; \
                for (int rep_ = 0; rep_ < REP_G1; ++rep_) pg8::gemm_phase<pg8::EpiQK, pg8::StaticOrder, true, PG8_SP2>(F.ldsp() + RING_OFF, g, S, E, F.wv()); } \
            if (TAILFILL && TAIL_OWN3 && (L) == 3) convert_tail<3>(F, args, (MT / 256) * (nq / 256), conv_items(3) * (TAIL1_PCT + TAIL3_PCT) / 100, conv_items(3)); \
            if (TAILFILL && TAIL1_PCT > 0 && (L) < 3) convert_tail<((L) < 3 ? (L) + 1 : 3)>(F, args, (MT / 256) * (nq / 256), 0, conv_items((L) < 3 ? (L) + 1 : 3) * TAIL1_PCT / 100); \
            BAR_AFTER(pb + 1); } \
        if (EN_QKN && L != 2 && RUN(pb + 2)) { \
            const float* qg = ldarg(L == 0 ? I_NAQG : (L == 1 ? I_SWQG : I_GQQG)); const float* kg = ldarg(L == 0 ? I_NAKG : (L == 1 ? I_SWKG : I_GQKG)); \
            for (int rep_ = 0; rep_ < REP_QKN; ++rep_) qkn_phase(F, args, nq, NH + (L == 0 ? 16 : (L == 1 ? 2 : 4)), qg, kg, L != 0, rep_ > 0, QFUSE ? NH : 0); BAR_AFTER(pb + 2); } \
        if (RUN(pb + 3)) { \
            if (EN_A0 && L == 0) for (int rep_ = 0; rep_ < REP_A0; ++rep_) att::attn_phase<0>(F, args, nq, 16, ldarg(I_NARB), true, QFUSE ? ldarg(I_NAQG) : nullptr, nullptr); \
            else if (EN_A1 && L == 1) for (int rep_ = 0; rep_ < REP_A1; ++rep_) att::attn_phase<1>(F, args, nq, 2, ldarg(I_SWSINK), true, QFUSE ? ldarg(I_SWQG) : nullptr, (const float*)WSP(WS_ROPE)); \
            else if (EN_ML && L == 2) for (int rep_ = 0; rep_ < REP_ML; ++rep_) { if (rep_) xcd_barrier(bar); if (EN_MLA) ml::mlstm_pre_a(F, args); if (REP_MLA == 2) ml::mlstm_pre_a(F, args); xcd_barrier(bar); if (EN_MLB) ml::mlstm_pre_b(F, args); xcd_barrier(bar); if (EN_MLS) ml::mlstm_scan(F, args); if (REP_MLS == 2) ml::mlstm_scan(F, args); } \
            else if (EN_A3 && L == 3) for (int rep_ = 0; rep_ < REP_A3; ++rep_) att::attn_phase<3>(F, args, nq, 4, nullptr, false, QFUSE ? ldarg(I_GQQG) : nullptr, (const float*)WSP(WS_ROPE)); \
            BAR_AFTER(pb + 3); } \
        if (EN_RO && L == 2 && RUN(pb + 4)) { for (int rep_ = 0; rep_ < REP_RO; ++rep_) mlro_phase(F, args); BAR_AFTER(pb + 4); } \
        if (EN_G2 && RUN(pb + 5)) { \
            pg8::Gemm g{L == 2 ? HX : AOb, (const bf16*)WSP(WS_WO) + (size_t)L * DM * DM, MLAT, DM, DM}; pg8::StaticOrder S; S.init(MLAT, DM, F.ng(), F.bx_(), DM, last ? 0 : 8, 4); S.wgm = WGM_G2; S.ord = ORD_G2; \
            pg8::EpiResidT<(L) != 0, true> E{L == 0 ? (const void*)ldarg(I_X) : (const void*)out, last ? (void*)WSP(WS_HB) : (void*)out, (float*)WSP(WS_PART), modl + 2 * DM, DM, NMOD}; \
            for (int rep_ = 0; rep_ < REP_G2; ++rep_) { if (rep_) { E.out_lat = (void*)WSP(WS_QKV); } \
                pg8::gemm_phase<pg8::EpiResidT<(L) != 0, true>, pg8::StaticOrder, true, PG8_SP2>(F.ldsp() + RING_OFF, g, S, E, F.wv()); } \
            BAR_AFTER(pb + 5); } \
        if (EN_NORM && RUN(pb + 6)) { for (int rep_ = 0; rep_ < REP_NORM; ++rep_) norm_phase(F, args, last ? (const void*)WSP(WS_HB) : (const void*)out, true, ldarg(I_N2G) + (size_t)L * DM, modl, 3, !last, false, last ? nullptr : modl + 4 * NMOD + 2 * DM, DIR_N2 != 0); BAR_AFTER(pb + 6); } \
        if (EN_G3 && RUN(pb + 7)) { \
            pg8::Gemm g{HX, (const bf16*)WSP(WS_WIN) + (size_t)L * 2 * DFF * DM, mrows, 2 * DFF, DM}; pg8::StaticOrder S; S.init(mrows, 2 * DFF, F.ng(), F.bx_(), DM); S.wgm = WGM_G3; S.ord = ORD_G3; \
            pg8::EpiGlu E{ACT, (float*)WSP(WS_EDGE), ldarg(I_FCW) + (size_t)L * 3 * DFF, ldarg(I_FCB) + (size_t)L * DFF, (PG8_LAS float*)(F.ldsp() + XB_OFF), DFF}; \
            for (int rep_ = 0; rep_ < REP_G3; ++rep_) pg8::gemm_phase<pg8::EpiGlu, pg8::StaticOrder, true, PG8_SP2>(F.ldsp() + RING_OFF, g, S, E, F.wv()); \
            if (TAILFILL && TAIL3_PCT > 0 && (L) < 3) convert_tail<((L) < 3 ? (L) + 1 : 3)>(F, args, (mrows / 256) * (2 * DFF / 256), conv_items((L) < 3 ? (L) + 1 : 3) * TAIL1_PCT / 100, conv_items((L) < 3 ? (L) + 1 : 3) * (TAIL1_PCT + TAIL3_PCT) / 100); \
            BAR_AFTER(pb + 7); } \
        if (EN_FIX && RUN(pb + 8)) { for (int rep_ = 0; rep_ < REP_FIX; ++rep_) fix_phase(F, args, L, last ? 128 : 132); BAR_AFTER(pb + 8); } \
        if (EN_G4 && RUN(pb + 9)) { \
            pg8::Gemm g{ACT, (const bf16*)WSP(WS_WOUT) + (size_t)L * DM * DFF, MLAT, DM, DFF}; pg8::StaticOrder S; S.init(MLAT, DM, F.ng(), F.bx_(), DFF, last ? 0 : 8, 4); S.wgm = WGM_G4; S.ord = ORD_G4; \
            pg8::EpiResidT<true, (L) != 3> E{last ? (const void*)WSP(WS_HB) : (const void*)out, (void*)out, (float*)WSP(WS_PART), modl + 5 * DM, DM, NMOD}; \
            for (int rep_ = 0; rep_ < REP_G4; ++rep_) { if (rep_) { E.out_lat = (void*)WSP(WS_AO); } \
                pg8::gemm_phase<pg8::EpiResidT<true, (L) != 3>, pg8::StaticOrder, true, PG8_SP2>(F.ldsp() + RING_OFF, g, S, E, F.wv()); } \
            BAR_AFTER(pb + 9); } \
    }
    LAYER_BODY(0) LAYER_BODY(1) LAYER_BODY(2) LAYER_BODY(3)
#undef LAYER_BODY
#undef RUN
#undef WSP
#undef HX
#undef QKVb
#undef AOb
#undef ACT
#undef BAR_AFTER
}

static bool phase_exists(int ph) { if (ph < 2) return true; const int L = (ph - 2) / 10, k = (ph - 2) % 10; if (k == 2) return L != 2 && !((QKF_MASK >> L) & 1); if (k == 4) return L == 2; return true; }
extern "C" void kernel_launch(void* const* d_in, const int* in_sizes, int n_in, void* d_out, int out_size, void* d_ws, size_t ws_size, hipStream_t stream) {
    static int grid = 0;
    if (grid == 0) {
        if (n_in != N_IN || out_size != MLAT * DM || ws_size < WS_END) { fprintf(stderr, "kernel_launch: unexpected shapes: n_in %d out %d ws %zu (need %zu)\n", n_in, out_size, ws_size, (size_t)WS_END); grid = -1; return; }
        int dev = 0, cus = 0, per_cu = 0;
        if (hipGetDevice(&dev) != hipSuccess || hipDeviceGetAttribute(&cus, hipDeviceAttributeMultiprocessorCount, dev) != hipSuccess) { grid = -1; return; }
        if (hipFuncSetAttribute((const void*)fwd, hipFuncAttributeMaxDynamicSharedMemorySize, LDS_BYTES) != hipSuccess) { fprintf(stderr, "kernel_launch: hipFuncSetAttribute failed\n"); grid = -1; return; }
        if (hipOccupancyMaxActiveBlocksPerMultiprocessor(&per_cu, (const void*)fwd, NWAVES * 64, LDS_BYTES) != hipSuccess || per_cu < 1) fprintf(stderr, "kernel_launch: occupancy query reports %d\n", per_cu);
        (void)hipGetLastError();
        grid = cus;
    }
    if (grid < 0) return;
    (void)hipMemsetAsync((char*)d_ws + WS_CTL, 0, MK_MODE == 0 ? (size_t)(CW_BAR + XCD_BAR_WORDS) * 4 : CTL_ZERO_BYTES, stream);
    Args a{};
    for (int i = 0; i < N_IN; ++i) a.in[i] = (const float*)d_in[i];
    a.out = (float*)d_out; a.ws = (unsigned char*)d_ws;
#if MK_MODE == 0
    a.ph_lo = 0; a.ph_hi = NPH;
    hipLaunchKernelGGL(fwd, dim3(grid), dim3(NWAVES * 64), LDS_BYTES, stream, a);
#else
    for (int ph = 0; ph < NPH; ++ph) { if (!phase_exists(ph)) continue; a.ph_lo = ph; a.ph_hi = ph + 1;
        hipLaunchKernelGGL(fwd, dim3(grid), dim3(NWAVES * 64), LDS_BYTES, stream, a); }
#endif
    const hipError_t le = hipPeekAtLastError();
    if (le != hipSuccess) fprintf(stderr, "kernel_launch: launch failed: %s\n", hipGetErrorName(le));
}
```

```cpp
#include <hip/hip_runtime.h>
#include <cstdio>
#include <cstdint>
__device__ __forceinline__ int opq(int v) { asm volatile("" : "+v"(v)); return v; }
__device__ __forceinline__ const float* ldarg(int i) {
    const char __attribute__((address_space(4)))* ka = (const char __attribute__((address_space(4)))*)__builtin_amdgcn_kernarg_segment_ptr();
    int off = i * 8; asm volatile("" : "+s"(off)); off = __builtin_amdgcn_readfirstlane(off);
    return *(const float* const __attribute__((address_space(4)))*)(ka + off);
}
__device__ __forceinline__ unsigned char* opq_ptr(unsigned char* p) { unsigned long long v = (unsigned long long)p; asm volatile("" : "+s"(v));
    const unsigned lo = (unsigned)__builtin_amdgcn_readfirstlane((int)(unsigned)v), hi = (unsigned)__builtin_amdgcn_readfirstlane((int)(unsigned)(v >> 32)); return (unsigned char*)(((unsigned long long)hi << 32) | lo); }
template <int CTRL, int ROWMASK = 0xf, bool BOUND = false> __device__ __forceinline__ float dppf(float oldv, float v) {
    return __builtin_bit_cast(float, __builtin_amdgcn_update_dpp(__builtin_bit_cast(int, oldv), __builtin_bit_cast(int, v), CTRL, ROWMASK, 0xf, BOUND)); }
__device__ __forceinline__ float row_sum16(float v) {
    v += dppf<0x121>(0.f, v); v += dppf<0x122>(0.f, v); v += dppf<0x124>(0.f, v); v += dppf<0x128>(0.f, v); return v; }
__device__ __forceinline__ float row_max16(float v) {
    v = fmaxf(v, dppf<0x121>(v, v)); v = fmaxf(v, dppf<0x122>(v, v)); v = fmaxf(v, dppf<0x124>(v, v)); v = fmaxf(v, dppf<0x128>(v, v)); return v; }
__device__ __forceinline__ float rdl(float v, int l) { return __builtin_bit_cast(float, __builtin_amdgcn_readlane(__builtin_bit_cast(int, v), l)); }
__device__ __forceinline__ float wave_sum(float v) { v = row_sum16(v); return (rdl(v, 0) + rdl(v, 16)) + (rdl(v, 32) + rdl(v, 48)); }
__device__ __forceinline__ float wave_max(float v) { v = row_max16(v); return fmaxf(fmaxf(rdl(v, 0), rdl(v, 16)), fmaxf(rdl(v, 32), rdl(v, 48))); }
__device__ __forceinline__ float sum16(float v) { return row_sum16(v); }
__device__ __forceinline__ float scan_add(float v) {
    v += dppf<0x111, 0xf, true>(0.f, v); v += dppf<0x112, 0xf, true>(0.f, v); v += dppf<0x114, 0xf, true>(0.f, v); v += dppf<0x118, 0xf, true>(0.f, v);
    v += dppf<0x142, 0xa>(0.f, v); v += dppf<0x143, 0xc>(0.f, v); return v; }
__device__ __forceinline__ float scan_max(float v) {
    const float ninf = -3.0e38f;
    v = fmaxf(v, dppf<0x111>(ninf, v)); v = fmaxf(v, dppf<0x112>(ninf, v)); v = fmaxf(v, dppf<0x114>(ninf, v)); v = fmaxf(v, dppf<0x118>(ninf, v));
    v = fmaxf(v, dppf<0x142, 0xa>(ninf, v)); v = fmaxf(v, dppf<0x143, 0xc>(ninf, v)); return v; }
__device__ __forceinline__ float swz_xor16(float v) { return __builtin_bit_cast(float, __builtin_amdgcn_ds_swizzle(__builtin_bit_cast(int, v), 0x401F)); }
__device__ __forceinline__ float swap32(float v) { auto r = __builtin_amdgcn_permlane32_swap(__builtin_bit_cast(unsigned, v), __builtin_bit_cast(unsigned, v), false, false); return __builtin_bit_cast(float, (unsigned)r[0]) ; }
__device__ __forceinline__ float sum_xor16_32(float v) { v += swz_xor16(v); auto r = __builtin_amdgcn_permlane32_swap(__builtin_bit_cast(unsigned, v), __builtin_bit_cast(unsigned, v), false, false);
    return __builtin_bit_cast(float, (unsigned)r[0]) + __builtin_bit_cast(float, (unsigned)r[1]); }
__device__ __forceinline__ float xor4_in16(float v, int lane) { const float up = dppf<0x104>(v, v), dn = dppf<0x114>(v, v); return (lane & 4) ? dn : up; }
__device__ __forceinline__ int lane_now() { int l; asm volatile("v_mbcnt_lo_u32_b32 %0, -1, 0\n\tv_mbcnt_hi_u32_b32 %0, -1, %0" : "=v"(l)); return l; }
__device__ __forceinline__ unsigned opq_u(unsigned v) { asm volatile("" : "+s"(v)); return (unsigned)__builtin_amdgcn_readfirstlane((int)v); }
namespace pg8 {
#define PG8_LAS __attribute__((address_space(3)))
typedef unsigned short bf16_t;
typedef short bf16x8 __attribute__((ext_vector_type(8)));
typedef float f32x4 __attribute__((ext_vector_type(4)));
typedef unsigned u32x4 __attribute__((ext_vector_type(4)));
constexpr int BM = 256, BK = 64, HALF = 128, HTB = HALF * BK * 2  , STAGE_BYTES = 8 * HTB, NXCD = 8, WGM = 4;

__host__ __device__ __forceinline__ int lds_byte(int r, int c) { const int st = (r >> 4) * 2 + (c >> 5), rr = r & 15, cc = c & 31, ob = rr * 64 + cc * 2; return st * 1024 + (ob ^ (((ob >> 9) & 1) << 5)); }
__host__ __device__ __forceinline__ void stage_rc(int b, int& R, int& C) { const int st = b / 1024, sb = b % 1024, swz = sb ^ (((sb >> 9) & 1) << 5); R = (st >> 1) * 16 + swz / 64; C = (st & 1) * 32 + (swz % 64) / 2; }
__host__ __device__ __forceinline__ int perm32(int rho) { const int n = rho >> 4, i = rho & 15; return 8 * (i >> 2) + 4 * n + (i & 3); }

struct Unit { int pm, pn, ko, nt, ks; };
struct Gemm { const bf16_t* A; const bf16_t* Bt; int M, N, K; };

struct StaticOrder {
    int nM, nN, nwg, G, c; int ord = 0;
    int wgm = WGM;
    int ntf, nsplit, kblk, xM;
    __host__ __device__ void init(int M, int N, int G_, int c_, int K_ = 0, int nsplit_ = 0, int xM_ = 0) { nM = M / BM; nN = N / BM; nwg = nM * nN; G = G_; c = c_; ntf = K_ / BK; nsplit = nsplit_; kblk = K_ / 128; xM = xM_; }
    __host__ __device__ bool next(int i, Unit& u) const {
        const int P = G / NXCD, vc = (G % NXCD == 0) ? (c % NXCD) * P + c / NXCD : c;
        const long L = (long)i * G + (ord ? vc : c);
        const bool split = L >= nwg;
        if (split && (nsplit == 0 || L - nwg >= (long)nsplit * xM * nN)) return false;
        int wgid = split ? 0 : (int)L; { const int q = nwg / NXCD, r = nwg % NXCD, xcd = wgid % NXCD, off = wgid / NXCD; const int w0 = (xcd < r ? xcd * (q + 1) : r * (q + 1) + (xcd - r) * q) + off; wgid = ord == 0 ? w0 : (ord == 1 ? wgid : nwg - 1 - wgid); }
        const int nig = wgm * nN, gid = wgid / nig, fm = gid * wgm, gsz = (nM - fm) < wgm ? (nM - fm) : wgm;
        const int pm0 = fm + ((wgid % nig) % gsz), pn0 = (wgid % nig) / gsz;
        const int j = split ? (int)(L - nwg) : 0, per = xM * nN > 0 ? xM * nN : 1, ns = nsplit > 0 ? nsplit : 1;
        const int s = j / per, rem = j - s * per, q2 = kblk / ns, r2 = kblk % ns;
        const int pm1 = nM + rem / nN, pn1 = rem % nN, ko1 = 128 * (s * q2 + (s < r2 ? s : r2)), nt1 = 2 * (q2 + (s < r2 ? 1 : 0));
        u.pm = split ? pm1 : pm0; u.pn = split ? pn1 : pn0; u.ko = split ? ko1 : 0; u.nt = split ? nt1 : ntf; u.ks = split ? s : -1;
#if defined(__HIP_DEVICE_COMPILE__)
        u.pm = __builtin_amdgcn_readfirstlane(u.pm); u.pn = __builtin_amdgcn_readfirstlane(u.pn); u.ko = __builtin_amdgcn_readfirstlane(u.ko); u.nt = __builtin_amdgcn_readfirstlane(u.nt); u.ks = __builtin_amdgcn_readfirstlane(u.ks);
#endif
        return true;
    }
    __device__ __forceinline__ void a_ready(const Unit&) const {}
    __device__ __forceinline__ void done(const Unit&) const {}
};
__device__ __forceinline__ unsigned cvt_pk_bf16(float lo, float hi) { unsigned r; asm volatile("v_cvt_pk_bf16_f32 %0, %1, %2" : "=v"(r) : "v"(lo), "v"(hi)); return r; }
typedef float f32x2 __attribute__((ext_vector_type(2)));
typedef unsigned u32x2 __attribute__((ext_vector_type(2)));
struct EpiStore {
    static constexpr bool PERM = true, AFTER_DRAIN = false;
    bf16_t* O; int ldc;
    __device__ __forceinline__ void operator()(f32x4 (&acc)[2][2][4][2], const Unit& u, int wr, int wc, int fr, int fq) const {
        const int row0 = u.pm * BM + wr * 64 + fr, col0 = u.pn * BM + wc * 32 + 8 * fq;
#pragma unroll
        for (int ai = 0; ai < 2; ++ai)
#pragma unroll
            for (int m = 0; m < 4; ++m) { bf16_t* rowp = O + (size_t)(row0 + ai * HALF + m * 16) * ldc + col0;
#pragma unroll
                for (int bj = 0; bj < 2; ++bj) { const f32x4 v0 = acc[ai][bj][m][0], v1 = acc[ai][bj][m][1];
                    u32x4 w; w.x = cvt_pk_bf16(v0[0], v0[1]); w.y = cvt_pk_bf16(v0[2], v0[3]); w.z = cvt_pk_bf16(v1[0], v1[1]); w.w = cvt_pk_bf16(v1[2], v1[3]);
                    *(u32x4*)(rowp + bj * HALF) = w; } }
    }
};
struct EpiQK {
    static constexpr bool PERM = true, AFTER_DRAIN = false;
    bf16_t* O; int ldc; int nqk_tiles; const float* qg; const float* kg; const float* rope_c; const float* rope_s; PG8_LAS float* xch;
    __device__ __forceinline__ void operator()(f32x4 (&acc)[2][2][4][2], const Unit& u, int wr, int wc, int fr, int fq) const {
        const int row0 = u.pm * BM + wr * 64 + fr, col0 = u.pn * BM + wc * 32 + 8 * fq;
        if (u.pn < nqk_tiles) {
#pragma unroll
            for (int ai = 0; ai < 2; ++ai)
#pragma unroll
                for (int m = 0; m < 4; ++m)
#pragma unroll
                    for (int bj = 0; bj < 2; ++bj) { const f32x4 a = acc[ai][bj][m][0], b = acc[ai][bj][m][1];
                        float ss = (a[0] * a[0] + a[1] * a[1]) + (a[2] * a[2] + a[3] * a[3]) + (b[0] * b[0] + b[1] * b[1]) + (b[2] * b[2] + b[3] * b[3]);
                        ss = sum_xor16_32(ss);
                        if (fq == 0) xch[((ai * HALF + wr * 64 + m * 16 + fr) * 2 + bj) * 4 + wc] = ss; }
            asm volatile("s_waitcnt lgkmcnt(0)" ::: "memory"); __builtin_amdgcn_s_barrier(); asm volatile("" ::: "memory");
            const int ah = wc >> 1, fb = 16 * (wc & 1) + 4 * fq;
            const float* gp = (u.pn < 8 ? qg : kg) + 64 * ah + fb;
            const f32x4 glo = *(const f32x4*)gp, ghi = *(const f32x4*)(gp + 32);
            const bool dorope = (rope_c != nullptr) && (u.pm < 128);
#pragma unroll
            for (int ai = 0; ai < 2; ++ai)
#pragma unroll
                for (int m = 0; m < 4; ++m) { const int rl = ai * HALF + wr * 64 + m * 16 + fr;
                    f32x4 cs = (f32x4){1.f, 1.f, 1.f, 1.f}, sn = (f32x4){0.f, 0.f, 0.f, 0.f};
                    if (dorope) { const int t = (u.pm * BM + rl) & 8191, pos = ah ? (t & 63) : (t >> 6); cs = *(const f32x4*)(rope_c + pos * 32 + fb); sn = *(const f32x4*)(rope_s + pos * 32 + fb); }
                    bf16_t* rowp = O + (size_t)(u.pm * BM + rl) * ldc + col0;
#pragma unroll
                    for (int bj = 0; bj < 2; ++bj) { const f32x4 pr = *(const PG8_LAS f32x4*)(xch + (rl * 2 + bj) * 4);
                        const float rs = __builtin_amdgcn_rsqf(((pr[0] + pr[1]) + (pr[2] + pr[3])) * (1.0f / 128.0f) + 1e-6f);
                        unsigned wq[4];
#pragma unroll
                        for (int n = 0; n < 2; ++n) { const f32x4 v = acc[ai][bj][m][n];
                            const float x1a = v[0] * rs * glo[2 * n], x2a = v[1] * rs * ghi[2 * n], x1b = v[2] * rs * glo[2 * n + 1], x2b = v[3] * rs * ghi[2 * n + 1];
                            wq[2 * n] = cvt_pk_bf16(x1a * cs[2 * n] - x2a * sn[2 * n], x2a * cs[2 * n] + x1a * sn[2 * n]);
                            wq[2 * n + 1] = cvt_pk_bf16(x1b * cs[2 * n + 1] - x2b * sn[2 * n + 1], x2b * cs[2 * n + 1] + x1b * sn[2 * n + 1]); }
                        *(u32x4*)(rowp + bj * HALF) = (u32x4){wq[0], wq[1], wq[2], wq[3]}; }
                    asm volatile("" ::: "memory"); }
            return;
        }
#pragma unroll
        for (int ai = 0; ai < 2; ++ai)
#pragma unroll
            for (int m = 0; m < 4; ++m) { bf16_t* rowp = O + (size_t)(row0 + ai * HALF + m * 16) * ldc + col0;
#pragma unroll
                for (int bj = 0; bj < 2; ++bj) { const f32x4 v0 = acc[ai][bj][m][0], v1 = acc[ai][bj][m][1];
                    u32x4 w; w.x = cvt_pk_bf16(v0[0], v0[1]); w.y = cvt_pk_bf16(v0[2], v0[3]); w.z = cvt_pk_bf16(v1[0], v1[1]); w.w = cvt_pk_bf16(v1[2], v1[3]);
                    *(u32x4*)(rowp + bj * HALF) = w; } }
    }
};
typedef _Float16 h16x4 __attribute__((ext_vector_type(4)));
__device__ __forceinline__ f32x4 h4_to_f4(unsigned a, unsigned b) { const u32x2 t = {a, b}; return __builtin_convertvector(__builtin_bit_cast(h16x4, t), f32x4); }
__device__ __forceinline__ u32x2 f4_to_h4(f32x4 v) { return __builtin_bit_cast(u32x2, __builtin_convertvector(v, h16x4)); }
template <bool BASE16, bool OUT16> struct EpiResidT {
    static constexpr bool PERM = true, AFTER_DRAIN = false;
    const void* base_lat; void* out_lat; float* part; const float* gate; int ld, gstride;
    __device__ __forceinline__ void operator()(f32x4 (&acc)[2][2][4][2], const Unit& u, int wr, int wc, int fr, int fq) const {
        const int rl = wr * 64 + fr, col0 = u.pn * BM + wc * 32 + 8 * fq;
        if (u.ks >= 0) {
            _Float16* ps = (_Float16*)part + ((size_t)u.ks * 1024 + (size_t)(u.pm - 128) * BM) * ld;
#pragma unroll
            for (int ai = 0; ai < 2; ++ai)
#pragma unroll
                for (int m = 0; m < 4; ++m)
#pragma unroll
                    for (int bj = 0; bj < 2; ++bj) { const u32x2 a = f4_to_h4(acc[ai][bj][m][0]), b = f4_to_h4(acc[ai][bj][m][1]);
                        *(u32x4*)(ps + (size_t)(rl + ai * HALF + m * 16) * ld + col0 + bj * HALF) = (u32x4){a.x, a.y, b.x, b.y}; }
            return;
        }
        const size_t roff = (size_t)u.pm * BM * ld;
        const float* gv = gate + (size_t)(u.pm >> 5) * gstride;
        f32x4 g[2][2];
#pragma unroll
        for (int bj = 0; bj < 2; ++bj)
#pragma unroll
            for (int n = 0; n < 2; ++n) g[bj][n] = *(const f32x4*)(gv + col0 + bj * HALF + 4 * n);
        if constexpr (BASE16) {
            const _Float16* bs = (const _Float16*)base_lat + roff; const unsigned vo = (unsigned)(rl * ld + col0) * 2u;
            u32x4 hb[2][2][4];
#pragma unroll
            for (int ai = 0; ai < 2; ++ai)
#pragma unroll
                for (int bj = 0; bj < 2; ++bj)
#pragma unroll
                    for (int m = 0; m < 4; ++m) hb[ai][bj][m] = *(const u32x4*)((const char*)(bs + (size_t)(ai * HALF + m * 16) * ld + bj * HALF) + vo);
#pragma unroll
            for (int ai = 0; ai < 2; ++ai)
#pragma unroll
                for (int bj = 0; bj < 2; ++bj)
#pragma unroll
                    for (int m = 0; m < 4; ++m) {
                        const f32x4 r0 = h4_to_f4(hb[ai][bj][m].x, hb[ai][bj][m].y) + g[bj][0] * acc[ai][bj][m][0], r1 = h4_to_f4(hb[ai][bj][m].z, hb[ai][bj][m].w) + g[bj][1] * acc[ai][bj][m][1];
                        const size_t eo = (size_t)(rl + ai * HALF + m * 16) * ld + col0 + bj * HALF;
                        if constexpr (OUT16) { const u32x2 a = f4_to_h4(r0), b = f4_to_h4(r1); *(u32x4*)((_Float16*)out_lat + roff + eo) = (u32x4){a.x, a.y, b.x, b.y}; }
                        else { float* op = (float*)out_lat + roff + eo; *(f32x4*)op = r0; *(f32x4*)(op + 4) = r1; } }
            return;
        }
#pragma unroll
        for (int ai = 0; ai < 2; ++ai) {
            if constexpr (BASE16) {
            } else {
                const float* bs = (const float*)base_lat + roff;
#pragma unroll
                for (int bj = 0; bj < 2; ++bj) {
                    f32x4 b[4][2];
#pragma unroll
                    for (int m = 0; m < 4; ++m)
#pragma unroll
                        for (int n = 0; n < 2; ++n) b[m][n] = *(const f32x4*)(bs + (size_t)(rl + ai * HALF + m * 16) * ld + col0 + bj * HALF + 4 * n);
#pragma unroll
                    for (int m = 0; m < 4; ++m) {
                        const f32x4 r0 = b[m][0] + g[bj][0] * acc[ai][bj][m][0], r1 = b[m][1] + g[bj][1] * acc[ai][bj][m][1];
                        const size_t eo = (size_t)(rl + ai * HALF + m * 16) * ld + col0 + bj * HALF;
                        if constexpr (OUT16) { const u32x2 a = f4_to_h4(r0), b2 = f4_to_h4(r1); *(u32x4*)((_Float16*)out_lat + roff + eo) = (u32x4){a.x, a.y, b2.x, b2.y}; }
                        else { float* op = (float*)out_lat + roff + eo; *(f32x4*)op = r0; *(f32x4*)(op + 4) = r1; } }
                    asm volatile("" ::: "memory"); }
            }
            asm volatile("" ::: "memory");
        }
    }
};
__device__ __forceinline__ float dpp_ror1(float v) { return __builtin_bit_cast(float, __builtin_amdgcn_update_dpp(0, __builtin_bit_cast(int, v), 0x121, 0xf, 0xf, false)); }
__device__ __forceinline__ float dpp_rol1(float v) { return __builtin_bit_cast(float, __builtin_amdgcn_update_dpp(0, __builtin_bit_cast(int, v), 0x12F, 0xf, 0xf, false)); }
__device__ __forceinline__ float gelu_tanh(float x) {
    const float t = x * (1.0f + 0.044715f * x * x);
    const float e = __builtin_amdgcn_exp2f(-2.302208198f * t);
    return x * __builtin_amdgcn_rcpf(1.0f + e);
}
struct EpiGlu {
    static constexpr bool PERM = true, AFTER_DRAIN = false;
    bf16_t* act; float* edge; const float* cw; const float* cb; PG8_LAS float* xb; int dff;
    __device__ __forceinline__ void operator()(f32x4 (&acc)[2][2][4][2], const Unit& u, int wr, int wc, int fr, int fq) const {
        const int cg = wc * 32 + 8 * fq, f0 = u.pn * 128 + cg;
        f32x4 w0[2], w1[2], w2[2], bb[2];
#pragma unroll
        for (int n = 0; n < 2; ++n) { w0[n] = *(const f32x4*)(cw + f0 + 4 * n); w1[n] = *(const f32x4*)(cw + dff + f0 + 4 * n); w2[n] = *(const f32x4*)(cw + 2 * dff + f0 + 4 * n); bb[n] = *(const f32x4*)(cb + f0 + 4 * n); }
#pragma unroll
        for (int ai = 0; ai < 2; ++ai) { const int b = 2 * ai + wr;
            if (fr == 0) {
#pragma unroll
                for (int n = 0; n < 2; ++n) *(PG8_LAS f32x4*)(xb + (b * 2 + 0) * 128 + cg + 4 * n) = acc[ai][0][0][n]; }
            if (fr == 15) {
#pragma unroll
                for (int n = 0; n < 2; ++n) *(PG8_LAS f32x4*)(xb + (b * 2 + 1) * 128 + cg + 4 * n) = acc[ai][0][3][n]; } }
        asm volatile("s_waitcnt lgkmcnt(0)" ::: "memory"); __builtin_amdgcn_s_barrier(); asm volatile("" ::: "memory");
#pragma unroll
        for (int ai = 0; ai < 2; ++ai) { const int b = 2 * ai + wr;
#pragma unroll
            for (int n = 0; n < 2; ++n) {
                const f32x4 ep = (b > 0) ? *(const PG8_LAS f32x4*)(xb + ((b - 1) * 2 + 1) * 128 + cg + 4 * n) : (f32x4){0.f, 0.f, 0.f, 0.f};
                const f32x4 en = (b < 3) ? *(const PG8_LAS f32x4*)(xb + ((b + 1) * 2 + 0) * 128 + cg + 4 * n) : (f32x4){0.f, 0.f, 0.f, 0.f};
                f32x4 R[4], L[4];
#pragma unroll
                for (int m = 0; m < 4; ++m)
#pragma unroll
                    for (int j = 0; j < 4; ++j) { R[m][j] = dpp_ror1(acc[ai][0][m][n][j]); L[m][j] = dpp_rol1(acc[ai][0][m][n][j]); }
#pragma unroll
                for (int m = 0; m < 4; ++m) {
                    const int rl = ai * HALF + wr * 64 + m * 16 + fr;
                    const f32x4 gp = (fr == 0) ? (m == 0 ? ep : R[m == 0 ? 0 : m - 1]) : R[m];
                    const f32x4 gn = (fr == 15) ? (m == 3 ? en : L[m == 3 ? 3 : m + 1]) : L[m];
                    const f32x4 g = acc[ai][0][m][n], uu = acc[ai][1][m][n];
                    const f32x4 gc = bb[n] + w0[n] * gp + w1[n] * g + w2[n] * gn;
                    if (rl == 0 || rl == 255) {
                        float* eb = edge + ((size_t)u.pm * 6 + (rl == 255 ? 3 : 0)) * dff + f0 + 4 * n;
                        *(f32x4*)eb = gc; *(f32x4*)(eb + dff) = uu; *(f32x4*)(eb + 2 * dff) = g;
                    } else {
                        u32x2 w; w.x = cvt_pk_bf16(gelu_tanh(gc[0]) * uu[0], gelu_tanh(gc[1]) * uu[1]); w.y = cvt_pk_bf16(gelu_tanh(gc[2]) * uu[2], gelu_tanh(gc[3]) * uu[3]);
                        *(u32x2*)(act + (size_t)(u.pm * BM + rl) * dff + f0 + 4 * n) = w;
                    }
                }
            }
        }
    }
};
template <class Epi, class Sched, bool ALIGN_EPI = false, bool SP2 = false>
__device__ __forceinline__ void gemm_phase(PG8_LAS unsigned char* lds, const Gemm g, const Sched& S, const Epi& E, int wave_id) {
    const int tid = opq(wave_id * 64 + lane_now()), wid = wave_id, lane = tid & 63, wr = wid >> 2, wc = wid & 3, fr = lane & 15, fq = lane >> 4;
    const int K = g.K;
    unsigned voffA[2], voffB[2];
#pragma unroll
    for (int i = 0; i < 2; ++i) { int R, C; stage_rc(tid * 16 + i * 8192, R, C); const int Rb = Epi::PERM ? ((R & ~31) + perm32(R & 31)) : R;
        voffA[i] = (unsigned)(R * K + C) * 2u; voffB[i] = (unsigned)(Rb * K + C) * 2u; }
    const size_t kstep = (size_t)(BK * 2);
    const size_t hstep = (size_t)HALF * K * 2;
    const size_t tstep = 2 * hstep;
    const unsigned ldsw = (unsigned)wid * 1024u;
    const int aoff = lds_byte(wr * 64 + fr, fq * 8), boff = lds_byte(wc * 32 + fr, fq * 8);
#define PG8_SA(b, h) (((b) * 2 + (h)) * HTB)
#define PG8_SB(b, h) ((4 + (b) * 2 + (h)) * HTB)
#define PG8_STAGE(bufoff, gbase, voff) do { _Pragma("unroll") for (int _i = 0; _i < 2; ++_i) \
        __builtin_amdgcn_global_load_lds((const unsigned*)((const char*)(gbase) + (voff)[_i]), (PG8_LAS unsigned*)(lds + (bufoff) + ldsw + _i * 8192), 16, 0, 0); } while (0)
#define PG8_LDA(dst, b, h) do { _Pragma("unroll") for (int m = 0; m < 4; ++m) _Pragma("unroll") for (int k = 0; k < 2; ++k) dst[m][k] = *(const PG8_LAS bf16x8*)(lds + PG8_SA(b, h) + aoff + m * 2048 + k * 1024); } while (0)
#define PG8_LDB(dst, b, h) do { _Pragma("unroll") for (int n = 0; n < 2; ++n) _Pragma("unroll") for (int k = 0; k < 2; ++k) dst[n][k] = *(const PG8_LAS bf16x8*)(lds + PG8_SB(b, h) + boff + n * 2048 + k * 1024); } while (0)
#define PG8_MMA(ai, bj, At, Bt) do { __builtin_amdgcn_s_setprio(1); _Pragma("unroll") for (int m = 0; m < 4; ++m) _Pragma("unroll") for (int n = 0; n < 2; ++n) _Pragma("unroll") for (int k = 0; k < 2; ++k) \
        acc[ai][bj][m][n] = __builtin_amdgcn_mfma_f32_16x16x32_bf16(Bt[n][k], At[m][k], acc[ai][bj][m][n], 0, 0, 0); __builtin_amdgcn_s_setprio(0); } while (0)
#define PG8_WAIT_V(n) asm volatile("s_waitcnt vmcnt(" #n ")" ::: "memory")
#define PG8_WAIT_L(n) asm volatile("s_waitcnt lgkmcnt(" #n ")" ::: "memory")
#define PG8_BAR __builtin_amdgcn_s_barrier()
#define PG8_SCHED __builtin_amdgcn_sched_barrier(0)
    Unit cur, nxt; int ui = 0;
    if (!S.next(0, cur)) return;
    f32x4 acc[2][2][4][2];
#pragma unroll
    for (int a = 0; a < 2; ++a)
#pragma unroll
        for (int b = 0; b < 2; ++b)
#pragma unroll
            for (int m = 0; m < 4; ++m)
#pragma unroll
                for (int n = 0; n < 2; ++n) acc[a][b][m][n] = (f32x4){0.f, 0.f, 0.f, 0.f};
    bf16x8 At[4][2], B0[2][2], B1[2][2];
    const char* cA = (const char*)g.A + (size_t)cur.pm * tstep + (size_t)cur.ko * 2; const char* cB = (const char*)g.Bt + (size_t)cur.pn * tstep + (size_t)cur.ko * 2;
    S.a_ready(cur);
    if constexpr (SP2) {
        PG8_STAGE(PG8_SB(0, 0), cB, voffB); PG8_STAGE(PG8_SB(0, 1), cB + hstep, voffB); PG8_STAGE(PG8_SA(0, 0), cA, voffA); PG8_STAGE(PG8_SA(0, 1), cA + hstep, voffA);
        if (wr == 1) PG8_BAR;
        PG8_WAIT_V(2); PG8_BAR;
        PG8_STAGE(PG8_SB(1, 0), cB + kstep, voffB); PG8_STAGE(PG8_SA(1, 0), cA + kstep, voffA); PG8_STAGE(PG8_SB(1, 1), cB + hstep + kstep, voffB);
        PG8_WAIT_V(6); PG8_BAR;
    } else {
        PG8_STAGE(PG8_SB(0, 0), cB, voffB); PG8_STAGE(PG8_SA(0, 0), cA, voffA); PG8_STAGE(PG8_SB(0, 1), cB + hstep, voffB); PG8_STAGE(PG8_SA(0, 1), cA + hstep, voffA);
        if (wr == 1) PG8_BAR;
        PG8_WAIT_V(4); PG8_BAR;
        PG8_STAGE(PG8_SB(1, 0), cB + kstep, voffB); PG8_STAGE(PG8_SA(1, 0), cA + kstep, voffA); PG8_STAGE(PG8_SB(1, 1), cB + hstep + kstep, voffB);
        PG8_WAIT_V(6); PG8_BAR;
    }
    for (;;) {
        const bool has_next = S.next(ui + 1, nxt);
        const char* nA = has_next ? (const char*)g.A + (size_t)nxt.pm * tstep + (size_t)nxt.ko * 2 : cA; const char* nB = has_next ? (const char*)g.Bt + (size_t)nxt.pn * tstep + (size_t)nxt.ko * 2 : cB;
        const int nt = cur.nt;
        for (int t = 0; t < nt; t += 2) {
            const bool last = (t == nt - 2);
            const char* a1 = cA + (size_t)(t + 1) * kstep;
            const char* a2 = last ? nA : cA + (size_t)(t + 2) * kstep; const char* b2 = last ? nB : cB + (size_t)(t + 2) * kstep;
            const char* a3 = a2 + kstep; const char* b3 = b2 + kstep;
            if (last && has_next) S.a_ready(nxt);
            if constexpr (SP2) {
            PG8_LDB(B0, 0, 0); PG8_LDB(B1, 0, 1); PG8_SCHED; PG8_LDA(At, 0, 0); PG8_STAGE(PG8_SA(1, 1), a1 + hstep, voffA);
            PG8_WAIT_V(8); PG8_WAIT_L(0); PG8_BAR; PG8_MMA(0, 0, At, B0); PG8_MMA(0, 1, At, B1); PG8_BAR; PG8_SCHED;
            PG8_LDA(At, 0, 1); PG8_STAGE(PG8_SB(0, 0), b2, voffB); PG8_STAGE(PG8_SB(0, 1), b2 + hstep, voffB); PG8_STAGE(PG8_SA(0, 0), a2, voffA);
            PG8_WAIT_V(8); PG8_WAIT_L(0); PG8_BAR; PG8_MMA(1, 0, At, B0); PG8_MMA(1, 1, At, B1); PG8_BAR; PG8_SCHED;
            PG8_LDB(B0, 1, 0); PG8_LDB(B1, 1, 1); PG8_SCHED; PG8_LDA(At, 1, 0); PG8_STAGE(PG8_SA(0, 1), a2 + hstep, voffA);
            PG8_WAIT_V(8); PG8_WAIT_L(0); PG8_BAR; PG8_MMA(0, 0, At, B0); PG8_MMA(0, 1, At, B1); PG8_BAR; PG8_SCHED;
            PG8_LDA(At, 1, 1); PG8_STAGE(PG8_SB(1, 0), b3, voffB); PG8_STAGE(PG8_SB(1, 1), b3 + hstep, voffB); PG8_STAGE(PG8_SA(1, 0), a3, voffA);
            PG8_WAIT_V(8); PG8_WAIT_L(0); PG8_BAR; PG8_MMA(1, 0, At, B0); PG8_MMA(1, 1, At, B1); PG8_BAR; PG8_SCHED;
            } else {
            PG8_LDB(B0, 0, 0); PG8_SCHED; PG8_LDA(At, 0, 0); PG8_STAGE(PG8_SA(1, 1), a1 + hstep, voffA);
            PG8_WAIT_L(8); PG8_BAR; PG8_WAIT_L(0); PG8_MMA(0, 0, At, B0); PG8_BAR; PG8_SCHED;
            PG8_LDB(B1, 0, 1); PG8_STAGE(PG8_SB(0, 0), b2, voffB);
            PG8_BAR; PG8_WAIT_L(0); PG8_MMA(0, 1, At, B1); PG8_BAR;
            PG8_LDA(At, 0, 1); PG8_STAGE(PG8_SA(0, 0), a2, voffA);
            PG8_BAR; PG8_WAIT_L(0); PG8_MMA(1, 0, At, B0); PG8_BAR; PG8_SCHED;
            PG8_STAGE(PG8_SB(0, 1), b2 + hstep, voffB);
            PG8_WAIT_V(6); PG8_BAR; PG8_MMA(1, 1, At, B1); PG8_BAR;
            PG8_LDB(B0, 1, 0); PG8_SCHED; PG8_LDA(At, 1, 0); PG8_STAGE(PG8_SA(0, 1), a2 + hstep, voffA);
            PG8_WAIT_L(8); PG8_BAR; PG8_WAIT_L(0); PG8_MMA(0, 0, At, B0); PG8_BAR; PG8_SCHED;
            PG8_LDB(B1, 1, 1); PG8_STAGE(PG8_SB(1, 0), b3, voffB);
            PG8_BAR; PG8_WAIT_L(0); PG8_MMA(0, 1, At, B1); PG8_BAR;
            PG8_LDA(At, 1, 1); PG8_STAGE(PG8_SA(1, 0), a3, voffA);
            PG8_BAR; PG8_WAIT_L(0); PG8_MMA(1, 0, At, B0); PG8_BAR; PG8_SCHED;
            PG8_STAGE(PG8_SB(1, 1), b3 + hstep, voffB);
            PG8_WAIT_V(6); PG8_BAR; PG8_MMA(1, 1, At, B1); PG8_BAR;
            }
        }
        if constexpr (ALIGN_EPI) { if (wr == 0) PG8_BAR; }
        if constexpr (!Epi::AFTER_DRAIN) { E(acc, cur, wr, wc, fr, fq); S.done(cur); }
        if (!has_next) break;
#pragma unroll
        for (int a = 0; a < 2; ++a)
#pragma unroll
            for (int b = 0; b < 2; ++b)
#pragma unroll
                for (int m = 0; m < 4; ++m)
#pragma unroll
                    for (int n = 0; n < 2; ++n) acc[a][b][m][n] = (f32x4){0.f, 0.f, 0.f, 0.f};
        cur = nxt; cA = nA; cB = nB; ++ui;
        if constexpr (ALIGN_EPI) { if (wr == 1) PG8_BAR; }
    }
    PG8_WAIT_V(0);
    if constexpr (!ALIGN_EPI) { if (wr == 0) PG8_BAR; }
    PG8_BAR;
    if constexpr (Epi::AFTER_DRAIN) { E.fused(acc, cur, wr, wc, fr, fq, lds, wid, lane); S.done(cur); }
#undef PG8_SA
#undef PG8_SB
#undef PG8_STAGE
#undef PG8_LDA
#undef PG8_LDB
#undef PG8_MMA
#undef PG8_WAIT_V
#undef PG8_WAIT_L
#undef PG8_BAR
#undef PG8_SCHED
}
}
#ifndef PG8_SP2
#define PG8_SP2 true
#endif
constexpr int NWAVES = 8;
constexpr int DM = 2048, NBATCH = 4, SEQ = 8192, CTXL = 256, GRIDW = 64;
constexpr int MLAT = NBATCH * SEQ, MCTX = NBATCH * CTXL, MT = MLAT + MCTX;
constexpr int DFF = 5632, NMOD = 6 * DM, HD = 128, NH = 16;
constexpr int ML_W = 6160;
constexpr float NORM_EPS = 1e-6f;
constexpr float ATT_SCALE = 0.088388347648318440f;

enum { I_X = 0, I_C, I_CTX, I_CCTX, I_ADAW, I_ADAB, I_N1G, I_N2G, I_FWIN, I_FCW, I_FCB, I_FWOUT, I_NAQKV, I_NAQG, I_NAKG, I_NARB, I_NAWO, I_SWQKV, I_SWQG, I_SWKG, I_SWSINK, I_SWWO,
       I_MLWIN, I_MLGB, I_MLHG, I_MLWO, I_GQQKV, I_GQQG, I_GQKG, I_GQWO, N_IN };

constexpr size_t MiB = 1u << 20;
constexpr size_t WS_CTL = 0, CTL_ZERO_BYTES = 1 * MiB;
constexpr size_t WS_ROPE = 1 * MiB;
constexpr size_t WS_MOD = 2 * MiB;
constexpr size_t WS_MODP = 3 * MiB;
constexpr size_t WS_XC = 12 * MiB;
constexpr size_t WS_GATES = 20 * MiB;
constexpr size_t WS_EDGE = 24 * MiB;
constexpr size_t WS_WQKV = 48 * MiB;
constexpr size_t WS_WO = WS_WQKV + 70 * MiB;
constexpr size_t WS_WIN = WS_WO + 32 * MiB;
constexpr size_t WS_WOUT = WS_WIN + 176 * MiB;
constexpr size_t WS_HX = 416 * MiB;
constexpr size_t WS_QKV = WS_HX + 132 * MiB;
constexpr size_t WS_AO = WS_QKV + 396 * MiB;
constexpr size_t WS_HB = WS_AO + 132 * MiB;
constexpr size_t WS_PART = WS_HB + 132 * MiB;
constexpr size_t WS_END = WS_PART + 64 * MiB;
static_assert(WS_WOUT + 88 * MiB <= WS_HX, "weights fit");
__host__ __device__ constexpr int nqkv_of(int L) { return L == 0 ? 6144 : (L == 1 ? 2560 : (L == 2 ? 6144 : 3072)); }
__host__ __device__ constexpr size_t wqkv_off(int L) { return (L == 0 ? 0 : (L == 1 ? 24 : (L == 2 ? 34 : 58))) * MiB; }

constexpr int CW_TMO = 0, CW_CODE = 1;
constexpr int CW_CHK = 16;
constexpr int CW_BAR = 4096;

constexpr int RING_OFF = 0, RING_BYTES = 131072;
constexpr int XB_OFF = RING_BYTES;
constexpr int LDSCTL_OFF = XB_OFF + 4096, MISC_OFF = LDSCTL_OFF + 320;
#ifndef QKF_MASK
#define QKF_MASK 0x0
#endif
constexpr int QKX_OFF = 136192;
constexpr int LDS_BYTES = 147456;
static_assert(MISC_OFF + 128 <= LDS_BYTES, "LDS map");

#define GAS __attribute__((address_space(1)))
#define LAS __attribute__((address_space(3)))
typedef unsigned short bf16;
typedef unsigned v4u __attribute__((ext_vector_type(4)));
typedef unsigned v2u __attribute__((ext_vector_type(2)));
typedef float f32x4 __attribute__((ext_vector_type(4)));
typedef float f32x16 __attribute__((ext_vector_type(16)));
typedef short bf16x8 __attribute__((ext_vector_type(8)));
typedef short s16x4 __attribute__((ext_vector_type(4)));
typedef GAS unsigned gu32;
#define RLX_AGENT __ATOMIC_RELAXED, __HIP_MEMORY_SCOPE_AGENT
#define LDS_WAIT() asm volatile("s_waitcnt lgkmcnt(0)" ::: "memory")
#define VM_WAIT() asm volatile("s_waitcnt vmcnt(0)" ::: "memory")
__device__ __forceinline__ unsigned f2bf(float f) { unsigned u = __builtin_bit_cast(unsigned, f); return (u + 0x7fffu + ((u >> 16) & 1u)) >> 16; }
__device__ __forceinline__ unsigned pk2(float lo, float hi) { unsigned r; asm("v_cvt_pk_bf16_f32 %0, %1, %2" : "=v"(r) : "v"(lo), "v"(hi)); return r; }
__device__ __forceinline__ float bf_lo(unsigned w) { return __builtin_bit_cast(float, w << 16); }
__device__ __forceinline__ float bf_hi(unsigned w) { return __builtin_bit_cast(float, w & 0xffff0000u); }
__device__ __forceinline__ float bf2f(bf16 b) { return __builtin_bit_cast(float, (unsigned)b << 16); }
#define XB_TMO      128
#define XB_XCNT(j)  (256  + 64 * (j))
#define XB_XSUB(j)  (1280 + 64 * (j))
#define XB_XGEN(j)  (2304 + 64 * (j))
#define XB_TOP      3328
#define XB_TOPGEN   3392
#define XCD_BAR_WORDS 3456
#define XB_SPIN_CAP (1u << 18)

__device__ __forceinline__ unsigned xb_ld(unsigned* p)              { return __hip_atomic_load(p, __ATOMIC_RELAXED, __HIP_MEMORY_SCOPE_AGENT); }
__device__ __forceinline__ unsigned xb_add(unsigned* p, unsigned v) { return __hip_atomic_fetch_add(p, v, __ATOMIC_RELAXED, __HIP_MEMORY_SCOPE_AGENT); }
__device__ __forceinline__ unsigned xb_xcc_id() { return (unsigned)__builtin_amdgcn_s_getreg((3 << 11) | 20) & 0xFu; }
#define XB_SPIN(cond, bar) do { unsigned _sp = 0; while (cond) { __builtin_amdgcn_s_sleep(1); \
    if ((++_sp & 255u) == 0u) { if (xb_ld(&(bar)[XB_TMO])) break; if (_sp > XB_SPIN_CAP) { atomicAdd(&(bar)[XB_TMO], 1u); break; } } } } while (0)

struct XcdBarrier {
    unsigned* bar; unsigned x; unsigned w0;
    volatile LAS unsigned* st;
};

__device__ __forceinline__ XcdBarrier xcd_barrier_post(unsigned* bar, volatile LAS unsigned* st) {
    XcdBarrier b; b.bar = bar; b.x = xb_xcc_id(); b.st = st; b.w0 = (__builtin_amdgcn_readfirstlane((int)threadIdx.x >> 6) == 0) ? 1u : 0u;
    if (threadIdx.x == 0) (void)xb_add(&bar[XB_XCNT(b.x)], 1u);
    return b;
}
__device__ __forceinline__ void xcd_barrier_complete(unsigned* bar, unsigned x, unsigned& nloc, unsigned& nx) {
    const unsigned G = gridDim.x * gridDim.y * gridDim.z;
    unsigned sum, cnt, mine, sp = 0u;
    for (;;) {
        sum = 0u; cnt = 0u; mine = 0u;
#pragma unroll
        for (unsigned j = 0; j < 16; ++j) { const unsigned c = xb_ld(&bar[XB_XCNT(j)]); sum += c; cnt += (c > 0u) ? 1u : 0u; mine = (j == x) ? c : mine; }
        if (sum == G) break;
        __builtin_amdgcn_s_sleep(1);
        if ((++sp & 255u) == 0u) { if (xb_ld(&bar[XB_TMO])) break; if (sp > XB_SPIN_CAP) { atomicAdd(&bar[XB_TMO], 1u); break; } }
    }
    nloc = mine > 0u ? mine : 1u; nx = cnt > 0u ? cnt : 1u;
}

__device__ __forceinline__ void xcd_barrier(const XcdBarrier& b) {
    asm volatile("s_waitcnt vmcnt(0)" ::: "memory");
    __syncthreads();
    if (b.w0 != 0u && lane_now() == 0) {
        unsigned* bar = b.bar;
        __builtin_amdgcn_s_waitcnt(0);
        unsigned nloc = b.st[0], nx = b.st[1];
        if (nloc == 0u) { xcd_barrier_complete(bar, b.x, nloc, nx); b.st[0] = nloc; b.st[1] = nx; }
        const unsigned old = xb_add(&bar[XB_XSUB(b.x)], 1u);
        const unsigned gen = old / nloc;
        if (old + 1u == (gen + 1u) * nloc) {
            __builtin_amdgcn_fence(__ATOMIC_RELEASE, "agent");
            asm volatile("s_waitcnt vmcnt(0)" ::: "memory");
            const unsigned og = xb_add(&bar[XB_TOP], 1u);
            const unsigned tg = og / nx;
            if (og + 1u == (tg + 1u) * nx) xb_add(&bar[XB_TOPGEN], 1u);
            else XB_SPIN(xb_ld(&bar[XB_TOPGEN]) == tg, bar);
            __builtin_amdgcn_fence(__ATOMIC_ACQUIRE, "agent");
            xb_add(&bar[XB_XGEN(b.x)], 1u);
            asm volatile("s_waitcnt vmcnt(0)" ::: "memory");
        } else {
            XB_SPIN(xb_ld(&bar[XB_XGEN(b.x)]) == gen, bar);
            __builtin_amdgcn_fence(__ATOMIC_ACQUIRE, "agent");
            asm volatile("s_waitcnt vmcnt(0)" ::: "memory");
        }
    }
    __syncthreads();
}

struct Args { const float* in[N_IN]; float* out; unsigned char* ws; int ph_lo, ph_hi; };
struct Frame {
    LAS unsigned char* lds; volatile LAS unsigned* MISC; gu32* ctl;
    int wave, vcu, G;
    __device__ __forceinline__ int wv() const { return (int)opq_u((unsigned)wave); }
    __device__ __forceinline__ int vc() const { return (int)opq_u((unsigned)vcu); }
    int bx;
    __device__ __forceinline__ int bx_() const { return (int)opq_u((unsigned)bx); }
    __device__ __forceinline__ int ng() const { return (int)opq_u((unsigned)G); }
    __device__ __forceinline__ int lane_id() const { return lane_now(); }
    __device__ __forceinline__ int tid_() const { return wv() * 64 + lane_now(); }
    __device__ __forceinline__ LAS unsigned char* ldsp() const { return (LAS unsigned char*)(uintptr_t)opq_u((unsigned)(uintptr_t)lds); }
};
__device__ __forceinline__ float fast_exp(float x) { return __builtin_amdgcn_exp2f(x * 1.4426950408889634f); }

__device__ __forceinline__ void transpose_item(const float* W, int ldw, int K, bf16* WT, int dst_row0, int k0, int n0, LAS float* scr, int lane, int dstep = 1) {
#pragma unroll 8
    for (int i = 0; i < 32; ++i) { const int kk = 2 * i + (lane >> 5); scr[kk * 33 + (lane & 31)] = W[(size_t)(k0 + kk) * ldw + n0 + (lane & 31)]; }
    LDS_WAIT(); asm volatile("" ::: "memory");
    const int c = lane & 7;
#pragma unroll
    for (int j = 0; j < 4; ++j) { const int n = (lane >> 3) + 8 * j; const LAS float* s = scr + (8 * c) * 33 + n;
        v4u o; o.x = pk2(s[0 * 33], s[1 * 33]); o.y = pk2(s[2 * 33], s[3 * 33]); o.z = pk2(s[4 * 33], s[5 * 33]); o.w = pk2(s[6 * 33], s[7 * 33]);
        *(GAS v4u*)(WT + (size_t)(dst_row0 + n * dstep) * K + k0 + 8 * c) = o; }
    LDS_WAIT(); asm volatile("" ::: "memory");
}
#ifndef PRO_ALL
#define PRO_ALL 0
#endif
#ifndef TAILFILL
#define TAILFILL 1
#endif
#ifndef CONV_NT
#define CONV_NT 0
#endif
#ifndef TAIL_OWN3
#define TAIL_OWN3 1
#endif
#ifndef TAIL1_PCT
#define TAIL1_PCT 50
#endif
#ifndef TAIL3_PCT
#define TAIL3_PCT 20
#endif
static_assert(QKF_MASK == 0, "the 64 x 64 conversion items do not carry the q/k rope-pair row permutation of the fused q/k-norm epilogue");
__host__ __device__ constexpr int conv_items(int L) { return nqkv_of(L) / 2 + 1024 + 5632 + 2816; }
template <int L> __device__ __forceinline__ void conv_decode(unsigned char* ws, int r, const float*& src, int& ldw, bf16*& dst, int& K) {
    constexpr int N = nqkv_of(L);
    if (r < N / 2) {
        const int nblk = N / 64, kb = r / nblk, nb = r % nblk;
        const float* W = ldarg(L == 0 ? I_NAQKV : (L == 1 ? I_SWQKV : (L == 2 ? I_MLWIN : I_GQQKV)));
        ldw = L == 2 ? ML_W : N; K = DM; src = W + (size_t)(kb * 64) * ldw + nb * 64; dst = (bf16*)(ws + WS_WQKV + wqkv_off(L)) + (size_t)(nb * 64) * DM + kb * 64; return; }
    r -= N / 2;
    if (r < 1024) { const int kb = r >> 5, nb = r & 31;
        const float* W = ldarg(L == 0 ? I_NAWO : (L == 1 ? I_SWWO : (L == 2 ? I_MLWO : I_GQWO)));
        ldw = DM; K = DM; src = W + (size_t)(kb * 64) * DM + nb * 64; dst = (bf16*)(ws + WS_WO) + (size_t)L * DM * DM + (size_t)(nb * 64) * DM + kb * 64; return; }
    r -= 1024;
    if (r < 5632) { const int kb = r / 176, nb = r % 176, n0 = nb * 64;
        const int f0 = n0 < DFF ? n0 : n0 - DFF; const int drow = 256 * (f0 >> 7) + (f0 & 127) + (n0 < DFF ? 0 : 128);
        ldw = 2 * DFF; K = DM; src = ldarg(I_FWIN) + (size_t)L * DM * 2 * DFF + (size_t)(kb * 64) * (2 * DFF) + n0; dst = (bf16*)(ws + WS_WIN) + (size_t)L * 2 * DFF * DM + (size_t)drow * DM + kb * 64; return; }
    r -= 5632;
    { const int kb = r >> 5, nb = r & 31;
      ldw = DM; K = DFF; src = ldarg(I_FWOUT) + (size_t)L * DFF * DM + (size_t)(kb * 64) * DM + nb * 64; dst = (bf16*)(ws + WS_WOUT) + (size_t)L * DM * DFF + (size_t)(nb * 64) * DFF + kb * 64; }
}
constexpr int CONV_SCR = 64 * 65 * 4;
typedef float cf32x2 __attribute__((ext_vector_type(2)));
template <int L> __device__ __forceinline__ void convert_range(unsigned char* ws, int it0, int hi, int stride, LAS float* scr, int lane) {
    if (it0 >= hi) return;
    const float* src; int ldw; bf16* dst; int K;
    conv_decode<L>(ws, it0, src, ldw, dst, K);
    cf32x2 v[32];
#pragma unroll
    for (int i = 0; i < 32; ++i) v[i] = *(const GAS cf32x2*)(src + (size_t)(2 * i + (lane >> 5)) * ldw + 2 * (lane & 31));
    for (int it = it0; it < hi; it += stride) {
#pragma unroll
        for (int i = 0; i < 32; ++i) { LAS float* sp = scr + (2 * i + (lane >> 5)) * 65 + 2 * (lane & 31); sp[0] = v[i].x; sp[1] = v[i].y; }
        bf16* cdst = dst; const int cK = K;
        if (it + stride < hi) {
            conv_decode<L>(ws, it + stride, src, ldw, dst, K);
#pragma unroll
            for (int i = 0; i < 32; ++i) v[i] = *(const GAS cf32x2*)(src + (size_t)(2 * i + (lane >> 5)) * ldw + 2 * (lane & 31));
        }
        LDS_WAIT(); asm volatile("" ::: "memory");
        const int c = lane & 7;
#pragma unroll
        for (int j = 0; j < 8; ++j) { const int n = (lane >> 3) + 8 * j; const LAS float* s_ = scr + (8 * c) * 65 + n;
            v4u o; o.x = pk2(s_[0 * 65], s_[1 * 65]); o.y = pk2(s_[2 * 65], s_[3 * 65]); o.z = pk2(s_[4 * 65], s_[5 * 65]); o.w = pk2(s_[6 * 65], s_[7 * 65]);
            *(GAS v4u*)(cdst + (size_t)n * cK + 8 * c) = o; }
        LDS_WAIT(); asm volatile("" ::: "memory");
    }
}
template <int L> __device__ __forceinline__ void convert_tail(Frame& F, const Args& A, int nwg, int lo, int hi) {
    const int G = F.ng(), rem = nwg % G, vc = F.vc();
    if (rem != 0 && vc < rem) return;
    const int first = rem, nidle = G - first, lane_ = opq(F.lane_id());
    unsigned char* ws = opq_ptr(A.ws); LAS float* scr = (LAS float*)(F.ldsp() + F.wv() * CONV_SCR);
    convert_range<L>(ws, lo + (vc - first) * NWAVES + F.wv(), hi, nidle * NWAVES, scr, lane_);
}
__device__ __forceinline__ void prologue_phase(Frame& F, const Args& A) {
    const int tid_ = opq(F.tid_()); const int lane_ = tid_ & 63;
    unsigned char* ws = opq_ptr(A.ws);
    const int gw = F.vc() * NWAVES + F.wv(), NGW = F.ng() * NWAVES;
    LAS float* sil = (LAS float*)(F.ldsp() + 71680);
    for (int i = tid_; i < 5 * DM; i += NWAVES * 64) { const float v = (i < 4 * DM) ? ldarg(I_C)[i] : ldarg(I_CCTX)[i - 4 * DM]; sil[i] = v / (1.0f + __expf(-v)); }
    __syncthreads();
    if (gw < 4 * 48 * 8) {
        const int l = gw / 384, rem = gw % 384, cb = rem >> 3, ks = rem & 7;
        const float* W = ldarg(I_ADAW) + ((size_t)l * DM + ks * 256) * NMOD + cb * 256 + 4 * lane_;
        f32x4 acc[5];
#pragma unroll
        for (int r = 0; r < 5; ++r) acc[r] = (f32x4){0.f, 0.f, 0.f, 0.f};
#pragma unroll 8
        for (int k = 0; k < 256; ++k) { const f32x4 w = *(const GAS f32x4*)(W + (size_t)k * NMOD);
#pragma unroll
            for (int r = 0; r < 5; ++r) acc[r] += w * sil[r * DM + ks * 256 + k]; }
        float* P = (float*)(ws + WS_MODP) + ((size_t)(ks * 4 + l) * 5) * NMOD + cb * 256 + 4 * lane_;
#pragma unroll
        for (int r = 0; r < 5; ++r) *(GAS f32x4*)(P + (size_t)r * NMOD) = acc[r];
    }
    { const int gt = F.vc() * (NWAVES * 64) + tid_;
      if (gt < 4096) { const int pos = gt >> 5, f = gt & 31; const float inv = powf(10000.0f, -(float)f / 32.0f); const float ang = (float)pos * inv; float sn, cs; sincosf(ang, &sn, &cs);
          float* R = (float*)(ws + WS_ROPE); R[gt] = cs; R[4096 + gt] = sn; } }
    { const GAS f32x4* s = (const GAS f32x4*)ldarg(I_CTX); GAS f32x4* d = (GAS f32x4*)(ws + WS_XC);
      for (int i = F.vc() * (NWAVES * 64) + tid_; i < MCTX * DM / 4; i += F.ng() * NWAVES * 64) d[i] = s[i]; }
    __syncthreads();
    LAS float* scr = (LAS float*)(F.ldsp() + F.wv() * CONV_SCR);
    convert_range<0>(ws, gw, conv_items(0), NGW, scr, lane_);
    { constexpr int skip = (TAILFILL && !PRO_ALL) ? TAIL1_PCT + TAIL3_PCT : 0;
      if (skip < 100) { convert_range<1>(ws, conv_items(1) * skip / 100 + gw, conv_items(1), NGW, scr, lane_); convert_range<2>(ws, conv_items(2) * skip / 100 + gw, conv_items(2), NGW, scr, lane_);
                        if (!(TAILFILL && !PRO_ALL && TAIL_OWN3)) convert_range<3>(ws, conv_items(3) * skip / 100 + gw, conv_items(3), NGW, scr, lane_); } }
}
__device__ __forceinline__ void modred_phase(Frame& F, const Args& A) {
    const int tid_ = opq(F.tid_());
    const float* P = (const float*)(opq_ptr(A.ws) + WS_MODP); float* Mo = (float*)(opq_ptr(A.ws) + WS_MOD);
    for (int i = F.vc() * (NWAVES * 64) + tid_; i < 4 * 5 * NMOD / 4; i += F.ng() * NWAVES * 64) {
        const int l = i / (5 * NMOD / 4), col4 = i % (NMOD / 4);
        f32x4 s = *(const GAS f32x4*)(ldarg(I_ADAB) + (size_t)l * NMOD + 4 * col4);
#pragma unroll
        for (int ks = 0; ks < 8; ++ks) s += *(const GAS f32x4*)(P + (size_t)ks * 4 * 5 * NMOD + 4 * (size_t)i);
        *(GAS f32x4*)(Mo + 4 * (size_t)i) = s;
    }
}

__device__ __forceinline__ void norm_phase(Frame& F, const Args& A, const void* xlat, bool x16, const float* gain, const float* modl, int shift_chunk, bool with_ctx, bool do_gates, const float* pend_gate, bool down = false) {
    const int tid_ = opq(F.tid_());
    unsigned char* ws = opq_ptr(A.ws); bf16* HX = (bf16*)(ws + WS_HX);
    const int gw = F.vc() * NWAVES + F.wv(), NGW = F.ng() * NWAVES, lane_ = opq(F.lane_id());
    LAS float* Wg = (LAS float*)(F.ldsp());
    if (do_gates) {
        for (int idx = tid_; idx < DM * 4; idx += NWAVES * 64) { const int k = idx >> 2, part = idx & 3;
            const f32x4 w = *(const GAS f32x4*)(ldarg(I_MLWIN) + (size_t)k * ML_W + 6144 + 4 * part);
#pragma unroll
            for (int e = 0; e < 4; ++e) Wg[(4 * part + e) * DM + k] = w[e]; }
        __syncthreads();
    }
    for (int bi_ = 0; bi_ < (with_ctx ? 5 : 4); ++bi_) { const int bsel = down ? (with_ctx ? 4 : 3) - bi_ : bi_;
        const bool h16 = x16 && bsel < 4;
        const float* src = bsel < 4 ? (const float*)xlat + (size_t)bsel * SEQ * DM : (const float*)(ws + WS_XC);
        const _Float16* src16 = (const _Float16*)xlat + (size_t)bsel * SEQ * DM;
        const int nrows = bsel < 4 ? SEQ : MCTX, row0 = bsel < 4 ? bsel * SEQ : MLAT;
        const float* sh = modl + (size_t)bsel * NMOD + shift_chunk * DM; const float* sc = sh + DM;
        f32x4 a[8], bs[8];
#pragma unroll
        for (int j = 0; j < 8; ++j) { const int c = 4 * lane_ + 256 * j; const f32x4 g = *(const GAS f32x4*)(gain + c), s = *(const GAS f32x4*)(sc + c); a[j] = g * (1.0f + s); bs[j] = *(const GAS f32x4*)(sh + c); }
        f32x4 vn[8];
        v2u vh[8];
        if (!do_gates && gw < nrows) { const size_t r0_ = (size_t)(down ? nrows - 1 - gw : gw);
            if (h16) { const GAS v2u* xr = (const GAS v2u*)(src16 + r0_ * DM) + lane_;
#pragma unroll
                for (int j = 0; j < 8; ++j) vh[j] = xr[64 * j]; }
            else { const GAS f32x4* xr = (const GAS f32x4*)(src + r0_ * DM) + lane_;
#pragma unroll
                for (int j = 0; j < 8; ++j) vn[j] = xr[64 * j]; } }
        for (int i_ = gw; i_ < nrows; i_ += NGW) { const int i = down ? nrows - 1 - i_ : i_;
            const GAS f32x4* xr = (const GAS f32x4*)(src + (size_t)i * DM) + lane_;
            f32x4 v[8]; float ss = 0.f;
            if (do_gates) {
                if (h16) { const GAS v2u* xh = (const GAS v2u*)(src16 + (size_t)i * DM) + lane_;
#pragma unroll
                    for (int j = 0; j < 8; ++j) { const v2u t_ = xh[64 * j]; v[j] = pg8::h4_to_f4(t_.x, t_.y); } }
                else {
#pragma unroll
                    for (int j = 0; j < 8; ++j) v[j] = xr[64 * j]; }
            } else if (h16) {
#pragma unroll
                for (int j = 0; j < 8; ++j) v[j] = pg8::h4_to_f4(vh[j].x, vh[j].y);
                if (i_ + NGW < nrows) { const GAS v2u* xn = (const GAS v2u*)(src16 + (size_t)(down ? i - NGW : i + NGW) * DM) + lane_;
#pragma unroll
                    for (int j = 0; j < 8; ++j) vh[j] = xn[64 * j]; }
            } else {
#pragma unroll
                for (int j = 0; j < 8; ++j) v[j] = vn[j];
                if (i_ + NGW < nrows) { const GAS f32x4* xn = (const GAS f32x4*)(src + (size_t)(down ? i - NGW : i + NGW) * DM) + lane_;
#pragma unroll
                    for (int j = 0; j < 8; ++j) vn[j] = xn[64 * j]; }
            }
            if (bsel == 4 && pend_gate != nullptr) {
                const _Float16* pp = (const _Float16*)(ws + WS_PART) + (size_t)i * DM + 4 * lane_;
#pragma unroll
                for (int j = 0; j < 8; ++j) { v2u pr[8];
#pragma unroll
                    for (int ks = 0; ks < 8; ++ks) pr[ks] = *(const GAS v2u*)(pp + (size_t)ks * MCTX * DM + 256 * j);
                    f32x4 s = pg8::h4_to_f4(pr[0].x, pr[0].y);
#pragma unroll
                    for (int ks = 1; ks < 8; ++ks) s += pg8::h4_to_f4(pr[ks].x, pr[ks].y);
                    v[j] += *(const GAS f32x4*)(pend_gate + 4 * lane_ + 256 * j) * s;
                    ((GAS f32x4*)((float*)(ws + WS_XC) + (size_t)i * DM) + lane_)[64 * j] = v[j]; }
            }
#pragma unroll
            for (int j = 0; j < 8; ++j) ss += (v[j].x * v[j].x + v[j].y * v[j].y) + (v[j].z * v[j].z + v[j].w * v[j].w);
            const float rstd = 1.0f / sqrtf(wave_sum(ss) * (1.0f / DM) + NORM_EPS);
            GAS v2u* o8 = (GAS v2u*)(HX + (size_t)(row0 + i) * DM) + lane_;
#pragma unroll
            for (int j = 0; j < 8; ++j) { v[j] = (v[j] * rstd) * a[j] + bs[j]; v2u w; w.x = pk2(v[j].x, v[j].y); w.y = pk2(v[j].z, v[j].w); o8[64 * j] = w; }
            if (do_gates) {
                float mine = 0.f;
#pragma unroll
                for (int g = 0; g < 16; ++g) { float s = 0.f;
#pragma unroll
                    for (int j = 0; j < 8; ++j) { const f32x4 w = *(const LAS f32x4*)(Wg + g * DM + 4 * lane_ + 256 * j); s += (v[j].x * w.x + v[j].y * w.y) + (v[j].z * w.z + v[j].w * w.w); }
                    s = wave_sum(s); mine = (lane_ == g) ? s : mine; }
                if (lane_ < 16) ((float*)(ws + WS_GATES))[(size_t)(row0 + i) * 16 + lane_] = mine + ldarg(I_MLGB)[lane_];
            }
        }
    }
    if (do_gates) __syncthreads();
}

__device__ __forceinline__ void qkn_phase(Frame& F, const Args& A, int ld, int nh, const float* qg, const float* kg, bool rope, bool probe_scratch = false, int h0 = 0) {
    unsigned char* ws = opq_ptr(A.ws); bf16* QKV = (bf16*)(ws + WS_QKV); const float* RC = (const float*)(ws + WS_ROPE); const float* RS = RC + 4096;
    const int lane_ = opq(F.lane_id()); const int gw = F.vc() * NWAVES + F.wv(), NGW = F.ng() * NWAVES, i16 = lane_ & 15, sub = lane_ >> 4;
    const int nhe = nh - h0, nitems = MT * nhe;
    const f32x4 gq0 = *(const GAS f32x4*)(qg + 8 * i16), gq1 = *(const GAS f32x4*)(qg + 8 * i16 + 4), gk0 = *(const GAS f32x4*)(kg + 8 * i16), gk1 = *(const GAS f32x4*)(kg + 8 * i16 + 4);
    for (int p_ = gw; p_ * 16 < nitems; p_ += NGW) { const int p = nitems / 16 - 1 - p_;
        GAS v4u* ptr[4]; v4u raw[4]; int rowv[4], headv[4];
#pragma unroll
        for (int k = 0; k < 4; ++k) { const int item = p * 16 + k * 4 + sub; rowv[k] = item / nhe; headv[k] = h0 + item - rowv[k] * nhe;
            ptr[k] = (GAS v4u*)(QKV + (size_t)rowv[k] * ld + headv[k] * HD + 8 * i16); raw[k] = *ptr[k]; }
#pragma unroll
        for (int k = 0; k < 4; ++k) {
            const int row = rowv[k], head = headv[k];
            float x[8] = {bf_lo(raw[k].x), bf_hi(raw[k].x), bf_lo(raw[k].y), bf_hi(raw[k].y), bf_lo(raw[k].z), bf_hi(raw[k].z), bf_lo(raw[k].w), bf_hi(raw[k].w)};
            float ss = 0.f;
#pragma unroll
            for (int e = 0; e < 8; ++e) ss += x[e] * x[e];
            const float rstd = 1.0f / sqrtf(sum16(ss) * (1.0f / HD) + NORM_EPS);
            const f32x4 g0 = head < NH ? gq0 : gk0, g1 = head < NH ? gq1 : gk1;
#pragma unroll
            for (int e = 0; e < 8; ++e) x[e] = x[e] * rstd * (e < 4 ? g0[e] : g1[e - 4]);
            const bool dorope = rope && row < MLAT;
            float xp[8];
#pragma unroll
            for (int e = 0; e < 8; ++e) xp[e] = xor4_in16(x[e], i16);
            if (dorope) {
                const int t = row & (SEQ - 1), pos = (i16 >> 3) ? (t & (GRIDW - 1)) : (t >> 6), f0 = 8 * (i16 & 3);
                const f32x4 c0 = *(const GAS f32x4*)(RC + pos * 32 + f0), c1 = *(const GAS f32x4*)(RC + pos * 32 + f0 + 4), s0 = *(const GAS f32x4*)(RS + pos * 32 + f0), s1 = *(const GAS f32x4*)(RS + pos * 32 + f0 + 4);
                const float sg = (i16 & 4) ? 1.0f : -1.0f;
#pragma unroll
                for (int e = 0; e < 8; ++e) { const float c = e < 4 ? c0[e] : c1[e - 4], sn = e < 4 ? s0[e] : s1[e - 4]; x[e] = x[e] * c + sg * xp[e] * sn; }
            }
            v4u o; o.x = pk2(x[0], x[1]); o.y = pk2(x[2], x[3]); o.z = pk2(x[4], x[5]); o.w = pk2(x[6], x[7]);
            if (probe_scratch) *(GAS v4u*)((bf16*)(ws + WS_AO) + (size_t)row * (nh * HD) + head * HD + 8 * i16) = o; else *ptr[k] = o;
        }
    }
}

__device__ __forceinline__ void fix_phase(Frame& F, const Args& A, int L, int npanels) {
    const int tid_ = opq(F.tid_());
    unsigned char* ws = opq_ptr(A.ws); bf16* ACT = (bf16*)(ws + WS_QKV); const float* E = (const float*)(ws + WS_EDGE); const float* cw = ldarg(I_FCW) + (size_t)L * 3 * DFF;
    const int ntask = npanels * 2 * (DFF / 4);
    for (int i = F.vc() * (NWAVES * 64) + tid_; i < ntask; i += F.ng() * NWAVES * 64) {
        const int f = 4 * (i % (DFF / 4)), pe = i / (DFF / 4), pm = pe >> 1, e = pe & 1;
        const float* eb = E + ((size_t)pm * 6 + 3 * e) * DFF + f;
        f32x4 gc = *(const GAS f32x4*)eb; const f32x4 uu = *(const GAS f32x4*)(eb + DFF);
        const bool has = pm < 128 && (e ? (pm & 31) != 31 : (pm & 31) != 0);
        if (has) { const f32x4 w = *(const GAS f32x4*)(cw + (e ? 2 * DFF : 0) + f); const f32x4 gnb = *(const GAS f32x4*)(E + ((size_t)(e ? pm + 1 : pm - 1) * 6 + (e ? 2 : 5)) * DFF + f); gc += w * gnb; }
        v2u o; o.x = pk2(pg8::gelu_tanh(gc.x) * uu.x, pg8::gelu_tanh(gc.y) * uu.y); o.y = pk2(pg8::gelu_tanh(gc.z) * uu.z, pg8::gelu_tanh(gc.w) * uu.w);
        *(GAS v2u*)(ACT + (size_t)(pm * 256 + (e ? 255 : 0)) * DFF + f) = o;
    }
}

__device__ __forceinline__ void mlro_phase(Frame& F, const Args& A) {
    unsigned char* ws = opq_ptr(A.ws); const bf16* HF = (const bf16*)(ws + WS_AO); const bf16* HBk = (const bf16*)(ws + WS_HB); const bf16* QKV = (const bf16*)(ws + WS_QKV); bf16* HX = (bf16*)(ws + WS_HX);
    const int lane_ = opq(F.lane_id()); const int gw = F.vc() * NWAVES + F.wv(), NGW = F.ng() * NWAVES, c0 = lane_ * 8;
    const float* hg = ldarg(I_MLHG) + c0;
    for (int row = gw; row < MT; row += NGW) {
        const GAS v4u* pf = (const GAS v4u*)(HF + (size_t)row * DM + c0); const GAS v4u* pb = (const GAS v4u*)(HBk + (size_t)row * DM + c0); const GAS v4u* po = (const GAS v4u*)(QKV + (size_t)row * 6144 + 4096 + c0);
        float h[32]; v4u ov[4];
#pragma unroll
        for (int q = 0; q < 4; ++q) { const v4u a = pf[64 * q], b = pb[64 * q]; ov[q] = po[64 * q];
            h[8 * q + 0] = bf_lo(a.x) + bf_lo(b.x); h[8 * q + 1] = bf_hi(a.x) + bf_hi(b.x); h[8 * q + 2] = bf_lo(a.y) + bf_lo(b.y); h[8 * q + 3] = bf_hi(a.y) + bf_hi(b.y);
            h[8 * q + 4] = bf_lo(a.z) + bf_lo(b.z); h[8 * q + 5] = bf_hi(a.z) + bf_hi(b.z); h[8 * q + 6] = bf_lo(a.w) + bf_lo(b.w); h[8 * q + 7] = bf_hi(a.w) + bf_hi(b.w); }
        GAS v4u* px = (GAS v4u*)(HX + (size_t)row * DM + c0);
#pragma unroll
        for (int q = 0; q < 4; ++q) { float ss = 0.f;
#pragma unroll
            for (int e = 0; e < 8; ++e) ss += h[8 * q + e] * h[8 * q + e];
            const float rstd = 1.0f / sqrtf(wave_sum(ss) * (1.0f / 512.0f) + NORM_EPS);
            const f32x4 g0 = *(const GAS f32x4*)(hg + 512 * q), g1 = *(const GAS f32x4*)(hg + 512 * q + 4);
            const float o[8] = {bf_lo(ov[q].x), bf_hi(ov[q].x), bf_lo(ov[q].y), bf_hi(ov[q].y), bf_lo(ov[q].z), bf_hi(ov[q].z), bf_lo(ov[q].w), bf_hi(ov[q].w)};
            float r[8];
#pragma unroll
            for (int e = 0; e < 8; ++e) { const float sg = 1.0f / (1.0f + __expf(-o[e])); r[e] = sg * (h[8 * q + e] * rstd * (e < 4 ? g0[e] : g1[e - 4])); }
            v4u w; w.x = pk2(r[0], r[1]); w.y = pk2(r[2], r[3]); w.z = pk2(r[4], r[5]); w.w = pk2(r[6], r[7]); px[64 * q] = w; }
    }
}

#ifndef TILE_SKIP
#define TILE_SKIP 1
#endif
#ifndef PV_TWO
#define PV_TWO 1
#endif
namespace att {
constexpr int QBLK = 32, KVBLK = 64, D = 128;
constexpr float SCALE = ATT_SCALE, THR = 8.f;
constexpr int SHM_V = KVBLK * D * 2, SHM_K = KVBLK * D * 2;
constexpr int NB = 4, BUFB = SHM_V + SHM_K;
constexpr int OFF_WS = NB * BUFB, OFF_TAB = 139264, ATT_LDS = OFF_TAB + 15 * 128 * 4;
static_assert(OFF_WS + NWAVES * 256 <= 135168 && ATT_LDS <= 147456, "attention LDS map");
#define KSWZ(row, colB) ((row) * 256 + ((colB) ^ (((row) & 7) << 4)))
#define SBAR() __builtin_amdgcn_sched_barrier(0)
__device__ __forceinline__ int crow(int r, int hi) { return (r & 3) + 8 * (r >> 2) + 4 * hi; }
__device__ __forceinline__ unsigned cvtpk(float lo, float hi) { unsigned r; asm volatile("v_cvt_pk_bf16_f32 %0, %1, %2" : "=v"(r) : "v"(lo), "v"(hi)); return r; }
struct MaskInfo { int a, b, c, d; };
template <int MODE> __device__ __forceinline__ void apply_mask(f32x16& p0, f32x16& p1, int widx, int lo, int nwin, const MaskInfo& mi, int hi, const LAS float* tab) {
    if (MODE == 3 || widx < 0) return;
    if (MODE == 1) {
        const int d0 = 64 * (lo + widx) - mi.a + 128;
#pragma unroll
        for (int r = 0; r < 16; ++r) { const int kc = crow(r, hi);
            p0[r] = ((unsigned)(d0 + kc) <= 256u) ? p0[r] : -1e30f; p1[r] = ((unsigned)(d0 + kc + 32) <= 256u) ? p1[r] : -1e30f; }
    }
    if (MODE == 0) {
        const int kr = lo + widx;
        const bool rowok = widx < nwin && (unsigned)(kr - mi.d) < 8u;
        if (!rowok) {
#pragma unroll
            for (int r = 0; r < 16; ++r) { p0[r] = -1e30f; p1[r] = -1e30f; }
        } else {
            const LAS float* tb = tab + (kr - mi.a + 7) * 128 + 63 - mi.b;
#pragma unroll
            for (int r4 = 0; r4 < 16; r4 += 8) {
                float b0[8], b1[8];
#pragma unroll
                for (int i = 0; i < 8; ++i) { const int kc = crow(r4 + i, hi); b0[i] = tb[kc]; b1[i] = tb[kc + 32]; }
                asm volatile("s_waitcnt lgkmcnt(0)" ::: "memory");
#pragma unroll
                for (int i = 0; i < 8; ++i) { const int r = r4 + i, kc = crow(r, hi);
                    p0[r] = ((unsigned)(kc - mi.c) < 16u) ? p0[r] + b0[i] : -1e30f; p1[r] = ((unsigned)(kc + 32 - mi.c) < 16u) ? p1[r] + b1[i] : -1e30f; }
                SBAR();
            }
        }
    }
}
__device__ __forceinline__ void partialSM(f32x16& p0, f32x16& p1, float& m_reg, float& mn, float& alpha) {
    constexpr float C = SCALE * 1.4426950408889634f;
    float pmax = p0[0];
#pragma unroll
    for (int r = 1; r < 16; ++r) pmax = fmaxf(pmax, p0[r]);
#pragma unroll
    for (int r = 0; r < 16; ++r) pmax = fmaxf(pmax, p1[r]);
    { auto rr = __builtin_amdgcn_permlane32_swap(__float_as_uint(pmax), __float_as_uint(pmax), false, false);
      pmax = fmaxf(__uint_as_float(rr[0]), __uint_as_float(rr[1])); }
    if (__builtin_expect(__all(pmax - m_reg <= THR / SCALE), 1)) { mn = m_reg; alpha = 1.f; }
    else { mn = fmaxf(m_reg, pmax); alpha = __builtin_amdgcn_exp2f((m_reg - mn) * C); m_reg = mn; }
    const float mnC = -mn * C;
#pragma unroll
    for (int r = 0; r < 16; ++r) p0[r] = fmaf(p0[r], C, mnC);
#pragma unroll
    for (int r = 0; r < 16; ++r) p1[r] = fmaf(p1[r], C, mnC);
#pragma unroll
    for (int r = 0; r < 16; ++r) p0[r] = __builtin_amdgcn_exp2f(p0[r]);
}
__device__ __forceinline__ void finishSM(f32x16& p0, f32x16& p1, float alpha, float& l_reg, bf16x8& pa0, bf16x8& pa1, bf16x8& pa2, bf16x8& pa3) {
#pragma unroll
    for (int r = 0; r < 16; ++r) p1[r] = __builtin_amdgcn_exp2f(p1[r]);
    float ps = 0;
#pragma unroll
    for (int r = 0; r < 16; ++r) ps += p0[r];
#pragma unroll
    for (int r = 0; r < 16; ++r) ps += p1[r];
    { auto rr = __builtin_amdgcn_permlane32_swap(__float_as_uint(ps), __float_as_uint(ps), false, false);
      ps = __uint_as_float(rr[0]) + __uint_as_float(rr[1]); }
    l_reg = l_reg * alpha + ps;
#define PK4(P, BASE, OUT) do { unsigned a0 = cvtpk(P[BASE + 0], P[BASE + 1]), a1 = cvtpk(P[BASE + 2], P[BASE + 3]);   \
    unsigned b0 = cvtpk(P[BASE + 4], P[BASE + 5]), b1 = cvtpk(P[BASE + 6], P[BASE + 7]);                              \
    auto r0 = __builtin_amdgcn_permlane32_swap(a0, b0, false, false); auto r1 = __builtin_amdgcn_permlane32_swap(a1, b1, false, false); \
    v4u w = {r0[0], r1[0], r0[1], r1[1]}; OUT = __builtin_bit_cast(bf16x8, w); } while (0)
    PK4(p0, 0, pa0); PK4(p0, 8, pa1); PK4(p1, 0, pa2); PK4(p1, 8, pa3);
#undef PK4
}
__device__ __forceinline__ void qkt(f32x16& p0, f32x16& p1, const LAS char* Ks, const bf16x8* qr, int r32, int hi) {
    p0 = f32x16{}; p1 = f32x16{};
#pragma unroll
    for (int d0 = 0; d0 < 8; ++d0) { const int cb = (d0 * 16 + hi * 8) * 2;
        const bf16x8 b0 = *(const LAS bf16x8*)(Ks + KSWZ(r32, cb));
        const bf16x8 b1 = *(const LAS bf16x8*)(Ks + KSWZ(32 + r32, cb));
        p0 = __builtin_amdgcn_mfma_f32_32x32x16_bf16(b0, qr[d0], p0, 0, 0, 0);
        p1 = __builtin_amdgcn_mfma_f32_32x32x16_bf16(b1, qr[d0], p1, 0, 0, 0); }
}
__device__ __forceinline__ int v_st(int k, int c) { const int kk = (k & ~0xC) | ((k & 4) << 1) | ((k & 8) >> 1); return ((kk >> 3) * 4 + (c >> 5)) * 512 + ((kk & 7) * 32 + (c & 31)) * 2; }
__device__ __forceinline__ int v_rd_base(int lane) { return ((lane & 3) << 3) | (((lane >> 2) & 3) << 6) | (((lane >> 4) & 1) << 5) | (((lane >> 5) & 1) << 8); }
constexpr int v_rd_off(int d0, int ks, int half) { return d0 * 512 + ks * 4096 + half * 2048; }
template <int OFF> __device__ __forceinline__ s16x4 tr_read(int vb) {
    s16x4 r; asm volatile("ds_read_b64_tr_b16 %0, %1 offset:%2" : "=&v"(r) : "v"(vb), "i"(OFF) : "memory"); return r;
}
template <int D0> __device__ __forceinline__ void pv_one(f32x16& od, int vb, bf16x8 pa0, bf16x8 pa1, bf16x8 pa2, bf16x8 pa3) {
    const s16x4 l0 = tr_read<v_rd_off(D0, 0, 0)>(vb), h0 = tr_read<v_rd_off(D0, 0, 1)>(vb), l1 = tr_read<v_rd_off(D0, 1, 0)>(vb), h1 = tr_read<v_rd_off(D0, 1, 1)>(vb);
    const s16x4 l2 = tr_read<v_rd_off(D0, 2, 0)>(vb), h2 = tr_read<v_rd_off(D0, 2, 1)>(vb), l3 = tr_read<v_rd_off(D0, 3, 0)>(vb), h3 = tr_read<v_rd_off(D0, 3, 1)>(vb);
    asm volatile("s_waitcnt lgkmcnt(0)" ::: "memory"); SBAR();
#define PK(L, H) (bf16x8){L[0], L[1], L[2], L[3], H[0], H[1], H[2], H[3]}
    od = __builtin_amdgcn_mfma_f32_32x32x16_bf16(pa0, PK(l0, h0), od, 0, 0, 0);
    od = __builtin_amdgcn_mfma_f32_32x32x16_bf16(pa1, PK(l1, h1), od, 0, 0, 0);
    od = __builtin_amdgcn_mfma_f32_32x32x16_bf16(pa2, PK(l2, h2), od, 0, 0, 0);
    od = __builtin_amdgcn_mfma_f32_32x32x16_bf16(pa3, PK(l3, h3), od, 0, 0, 0);
#undef PK
}
template <int D0> __device__ __forceinline__ void pv_two(f32x16& oa, f32x16& ob, int vb, bf16x8 pa0, bf16x8 pa1, bf16x8 pa2, bf16x8 pa3) {
    const s16x4 l0 = tr_read<v_rd_off(D0, 0, 0)>(vb), h0 = tr_read<v_rd_off(D0, 0, 1)>(vb), l1 = tr_read<v_rd_off(D0, 1, 0)>(vb), h1 = tr_read<v_rd_off(D0, 1, 1)>(vb);
    const s16x4 l2 = tr_read<v_rd_off(D0, 2, 0)>(vb), h2 = tr_read<v_rd_off(D0, 2, 1)>(vb), l3 = tr_read<v_rd_off(D0, 3, 0)>(vb), h3 = tr_read<v_rd_off(D0, 3, 1)>(vb);
    const s16x4 m0 = tr_read<v_rd_off(D0 + 1, 0, 0)>(vb), n0 = tr_read<v_rd_off(D0 + 1, 0, 1)>(vb), m1 = tr_read<v_rd_off(D0 + 1, 1, 0)>(vb), n1 = tr_read<v_rd_off(D0 + 1, 1, 1)>(vb);
    const s16x4 m2 = tr_read<v_rd_off(D0 + 1, 2, 0)>(vb), n2 = tr_read<v_rd_off(D0 + 1, 2, 1)>(vb), m3 = tr_read<v_rd_off(D0 + 1, 3, 0)>(vb), n3 = tr_read<v_rd_off(D0 + 1, 3, 1)>(vb);
    asm volatile("s_waitcnt lgkmcnt(0)" ::: "memory"); SBAR();
#define PK(L, H) (bf16x8){L[0], L[1], L[2], L[3], H[0], H[1], H[2], H[3]}
    oa = __builtin_amdgcn_mfma_f32_32x32x16_bf16(pa0, PK(l0, h0), oa, 0, 0, 0); ob = __builtin_amdgcn_mfma_f32_32x32x16_bf16(pa0, PK(m0, n0), ob, 0, 0, 0);
    oa = __builtin_amdgcn_mfma_f32_32x32x16_bf16(pa1, PK(l1, h1), oa, 0, 0, 0); ob = __builtin_amdgcn_mfma_f32_32x32x16_bf16(pa1, PK(m1, n1), ob, 0, 0, 0);
    oa = __builtin_amdgcn_mfma_f32_32x32x16_bf16(pa2, PK(l2, h2), oa, 0, 0, 0); ob = __builtin_amdgcn_mfma_f32_32x32x16_bf16(pa2, PK(m2, n2), ob, 0, 0, 0);
    oa = __builtin_amdgcn_mfma_f32_32x32x16_bf16(pa3, PK(l3, h3), oa, 0, 0, 0); ob = __builtin_amdgcn_mfma_f32_32x32x16_bf16(pa3, PK(m3, n3), ob, 0, 0, 0);
#undef PK
}
__device__ __forceinline__ void pv_d0(f32x16* o, int vb, bf16x8 pa0, bf16x8 pa1, bf16x8 pa2, bf16x8 pa3) {
#if PV_TWO
    pv_two<0>(o[0], o[1], vb, pa0, pa1, pa2, pa3); pv_two<2>(o[2], o[3], vb, pa0, pa1, pa2, pa3);
#else
    pv_one<0>(o[0], vb, pa0, pa1, pa2, pa3); pv_one<1>(o[1], vb, pa0, pa1, pa2, pa3); pv_one<2>(o[2], vb, pa0, pa1, pa2, pa3); pv_one<3>(o[3], vb, pa0, pa1, pa2, pa3);
#endif
}

template <int MODE> __device__ __forceinline__ bool tile_active(int widx, int lo, int nwin, int qa, int md) {
    if (!TILE_SKIP || MODE == 3 || widx < 0) return true;
    bool a = true;
    if (MODE == 0) a = widx < nwin && (unsigned)(lo + widx - md) < 8u;
    if (MODE == 1) { const int k0 = 64 * (lo + widx); a = widx < nwin && k0 + 63 >= qa - 128 && k0 <= qa + 31 + 128; }
    return __builtin_amdgcn_readfirstlane(a ? 1 : 0) != 0;
}
template <int MODE>
__device__ __forceinline__ void attn_unit(const bf16* __restrict__ QKV, int ldq, int qcol, int kcol, int vcol, bf16* __restrict__ AO, int qrow0, int ctx0, int lat0, int lo, int nwin, int NT,
                                          MaskInfo mi, const float* extra, bool use_sink, LAS char* lds, int wave_id, const float* qg, const float* rope_c) {
    const int tid = opq(wave_id * 64 + lane_now()), wid = wave_id, lane = tid & 63, r32 = lane & 31, hi = lane >> 5;
    LAS float* wsx = (LAS float*)(lds + OFF_WS) + wid * 64; LAS float* li_l = wsx; LAS float* al_l = wsx + 32;
    LAS float* tab = (LAS float*)(lds + OFF_TAB);
    if (MODE == 0) {
        for (int idx = tid; idx < 15 * 128; idx += NWAVES * 64) { const int drow = idx >> 7, dcol = (idx & 127) - 48;
            tab[idx] = (extra != nullptr && dcol >= 0 && dcol < 31) ? extra[drow * 31 + dcol] * (1.0f / SCALE) : 0.f; }
    }
    float m_reg = -1e30f, l_reg = 0; f32x16 o[4] = {}; bf16x8 qr[8];
    const bf16* Qw = QKV + (size_t)(qrow0 + wid * QBLK + r32) * ldq + qcol + hi * 8;
#pragma unroll
    for (int d0 = 0; d0 < 8; ++d0) qr[d0] = *(const GAS bf16x8*)(Qw + d0 * 16);
    const int vb0 = (int)(uintptr_t)lds + v_rd_base(lane);
    unsigned goff[4];
#pragma unroll
    for (int i = 0; i < 4; ++i) { const int s_ = 512 * i + tid;
        if (i < 2) { const int ob = s_ * 16, sub = ob >> 9, kk = (sub >> 2) * 8 + ((ob & 511) >> 6), k = (kk & ~0xC) | ((kk & 4) << 1) | ((kk & 8) >> 1), c = (sub & 3) * 32 + ((ob & 63) >> 1); goff[i] = (unsigned)(k * ldq + vcol + c); }
        else { const int ob = (s_ - 1024) * 16, row = ob >> 8, cb = (ob & 255) ^ ((row & 7) << 4); goff[i] = (unsigned)(row * ldq + kcol + (cb >> 1)); } }
#define TROW(j) ((j) < 4 ? ctx0 + 64 * (j) : lat0 + 64 * (((j) - 4) < nwin ? ((j) - 4) : nwin - 1))
#define DMA(j) do { const GAS bf16* tb_ = (const GAS bf16*)QKV + (size_t)TROW(j) * ldq; LAS char* db_ = lds + ((j) & 3) * BUFB + wid * 1024; \
    _Pragma("unroll") for (int i_ = 0; i_ < 4; ++i_) __builtin_amdgcn_global_load_lds((const unsigned*)(const void*)(tb_ + goff[i_]), (LAS unsigned*)(db_ + i_ * 8192), 16, 0, 0); } while (0)
#define WAITV4() asm volatile("s_waitcnt vmcnt(4)" ::: "memory")
#define WAITV0() asm volatile("s_waitcnt vmcnt(0)" ::: "memory")
#define BAR() do { asm volatile("" ::: "memory"); __builtin_amdgcn_s_barrier(); asm volatile("" ::: "memory"); } while (0)
#define KBUF(j) (lds + ((j) & 3) * BUFB + SHM_V)
#define VBUF(j) (vb0 + ((j) & 3) * BUFB)
#define RESC(a) do { if (__any((a) < 1.f)) { if (hi == 0) al_l[r32] = (a); asm volatile("s_waitcnt lgkmcnt(0)" ::: "memory"); \
    _Pragma("unroll") for (int d = 0; d < 4; ++d) _Pragma("unroll") for (int r = 0; r < 16; ++r) o[d][r] *= al_l[crow(r, hi)]; } } while (0)
#define MASK(P0, P1, j) apply_mask<MODE>(P0, P1, (j) - 4, lo, nwin, mi, hi, tab)
    f32x16 pA0, pA1, pB0, pB1; float mnA, mnB, alA, alB; bf16x8 pa0, pa1, pa2, pa3;
    DMA(0); DMA(1);
    if (qg != nullptr) {
        float ss = 0.f;
#pragma unroll
        for (int d0 = 0; d0 < 8; ++d0)
#pragma unroll
            for (int e = 0; e < 8; ++e) { const float x = bf2f((bf16)qr[d0][e]); ss += x * x; }
        { auto rr = __builtin_amdgcn_permlane32_swap(__float_as_uint(ss), __float_as_uint(ss), false, false); ss = __uint_as_float(rr[0]) + __uint_as_float(rr[1]); }
        const float rstd = 1.0f / sqrtf(ss * (1.0f / HD) + NORM_EPS);
        const int t = (qrow0 + wid * QBLK + r32) & (SEQ - 1);
#pragma unroll
        for (int a = 0; a < 2; ++a)
#pragma unroll
            for (int dd = 0; dd < 2; ++dd) { const int d1 = 4 * a + dd, d2 = d1 + 2, c1 = d1 * 16 + hi * 8;
                const f32x4 g1a = *(const GAS f32x4*)(qg + c1), g1b = *(const GAS f32x4*)(qg + c1 + 4), g2a = *(const GAS f32x4*)(qg + c1 + 32), g2b = *(const GAS f32x4*)(qg + c1 + 36);
                float x1[8], x2[8];
#pragma unroll
                for (int e = 0; e < 8; ++e) { x1[e] = bf2f((bf16)qr[d1][e]) * rstd * (e < 4 ? g1a[e & 3] : g1b[e & 3]); x2[e] = bf2f((bf16)qr[d2][e]) * rstd * (e < 4 ? g2a[e & 3] : g2b[e & 3]); }
                if (rope_c != nullptr) { const int pos = a ? (t & (GRIDW - 1)) : (t >> 6), f0 = dd * 16 + hi * 8; const float* cp = rope_c + pos * 32 + f0;
                    const f32x4 ca = *(const GAS f32x4*)cp, cb = *(const GAS f32x4*)(cp + 4), sa = *(const GAS f32x4*)(cp + 4096), sb = *(const GAS f32x4*)(cp + 4100);
#pragma unroll
                    for (int e = 0; e < 8; ++e) { const float c = e < 4 ? ca[e & 3] : cb[e & 3], sn = e < 4 ? sa[e & 3] : sb[e & 3]; const float n1 = x1[e] * c - x2[e] * sn, n2 = x2[e] * c + x1[e] * sn; x1[e] = n1; x2[e] = n2; } }
                const v4u w1 = {cvtpk(x1[0], x1[1]), cvtpk(x1[2], x1[3]), cvtpk(x1[4], x1[5]), cvtpk(x1[6], x1[7])}, w2 = {cvtpk(x2[0], x2[1]), cvtpk(x2[2], x2[3]), cvtpk(x2[4], x2[5]), cvtpk(x2[6], x2[7])};
                qr[d1] = __builtin_bit_cast(bf16x8, w1); qr[d2] = __builtin_bit_cast(bf16x8, w2); }
    }
    WAITV4(); BAR();
    DMA(2);
    const int qa_u = __builtin_amdgcn_readfirstlane(mi.a), md_u = __builtin_amdgcn_readfirstlane(mi.d);
#define ACT(j) tile_active<MODE>((j) - 4, lo, nwin, qa_u, md_u)
    bool aA = true, aB = true;
    qkt(pA0, pA1, KBUF(0), qr, r32, hi); MASK(pA0, pA1, 0); partialSM(pA0, pA1, m_reg, mnA, alA);
    for (int j = 1; j + 1 < NT; j += 2) {
        WAITV4(); BAR();
        if (j + 2 < NT) DMA(j + 2);
        aB = ACT(j);
        SBAR(); if (aB) qkt(pB0, pB1, KBUF(j), qr, r32, hi);
        if (aA) { finishSM(pA0, pA1, alA, l_reg, pa0, pa1, pa2, pa3); SBAR();
                  pv_d0(o, VBUF(j - 1), pa0, pa1, pa2, pa3); }
        if (aB) { MASK(pB0, pB1, j); partialSM(pB0, pB1, m_reg, mnB, alB);
                  RESC(alB); }
        if (j + 2 < NT) WAITV4(); else WAITV0();
        BAR();
        if (j + 3 < NT) DMA(j + 3);
        aA = ACT(j + 1);
        SBAR(); if (aA) qkt(pA0, pA1, KBUF(j + 1), qr, r32, hi);
        if (aB) { finishSM(pB0, pB1, alB, l_reg, pa0, pa1, pa2, pa3); SBAR();
                  pv_d0(o, VBUF(j), pa0, pa1, pa2, pa3); }
        if (aA) { MASK(pA0, pA1, j + 1); partialSM(pA0, pA1, m_reg, mnA, alA);
                  RESC(alA); }
    }
    WAITV0(); BAR();
    aB = ACT(NT - 1);
    SBAR(); if (aB) qkt(pB0, pB1, KBUF(NT - 1), qr, r32, hi);
    if (aA) { finishSM(pA0, pA1, alA, l_reg, pa0, pa1, pa2, pa3); SBAR();
              pv_d0(o, VBUF(NT - 2), pa0, pa1, pa2, pa3); }
    if (aB) { MASK(pB0, pB1, NT - 1); partialSM(pB0, pB1, m_reg, mnB, alB);
              RESC(alB);
              finishSM(pB0, pB1, alB, l_reg, pa0, pa1, pa2, pa3); SBAR();
              pv_d0(o, VBUF(NT - 1), pa0, pa1, pa2, pa3); }
#undef ACT
    if (MODE == 1 && use_sink) l_reg += __builtin_amdgcn_exp2f(extra[0] * 1.4426950408889634f - m_reg * (SCALE * 1.4426950408889634f));
    if (hi == 0) li_l[r32] = l_reg; asm volatile("s_waitcnt lgkmcnt(0)" ::: "memory");
    float rli[16];
#pragma unroll
    for (int r = 0; r < 16; ++r) rli[r] = __builtin_amdgcn_rcpf(li_l[crow(r, hi)]);
    bf16* Ow = AO + (size_t)(qrow0 + wid * QBLK) * DM + qcol;
#pragma unroll
    for (int r = 0; r < 16; ++r) { const int orow = crow(r, hi);
#pragma unroll
        for (int d0 = 0; d0 < 4; ++d0) ((GAS bf16*)Ow)[(size_t)orow * DM + d0 * 32 + r32] = (bf16)(pk2(o[d0][r] * rli[r], 0.f) & 0xffffu); }
#undef TROW
#undef DMA
#undef WAITV4
#undef WAITV0
#undef BAR
#undef KBUF
#undef VBUF
#undef RESC
#undef MASK
}
#undef KSWZ

template <int MODE>
__device__ __forceinline__ void attn_phase(Frame& F, const Args& A, int ldq, int nkv, const float* extra, bool with_ctx, const float* qg, const float* rope_c) {
    const bf16* QKV = (const bf16*)(opq_ptr(A.ws) + WS_QKV); bf16* AO = (bf16*)(opq_ptr(A.ws) + WS_AO); LAS char* lds = (LAS char*)F.ldsp();
    const int G_ = NH / nkv, nunits = 2048 + (with_ctx ? 64 : 0);
    const int wid = F.wv(), r32 = opq(F.lane_id()) & 31;
    for (int u = F.vc(); u < nunits; u += F.ng()) {
        const bool cu = u >= 2048;
        const int b = cu ? (u - 2048) >> 4 : u >> 9, h = cu ? (u - 2048) & 15 : (u >> 5) & 15, qt = u & 31, kvh = h / G_;
        const int qcol = h * HD, kcol = DM + kvh * HD, vcol = DM + nkv * HD + kvh * HD, ctx0 = MLAT + b * CTXL;
        int qrow0, lat0 = 0, lo = 0, nwin = 0, NT = 4; MaskInfo mi{0, 0, 0, 0};
        if (cu) { qrow0 = ctx0; }
        else {
            qrow0 = b * SEQ + qt * 256;
            if (MODE == 3) { lo = 0; nwin = SEQ / 64; }
            if (MODE == 1) { lo = qt * 4 - 2 < 0 ? 0 : qt * 4 - 2; const int hiT = qt * 4 + 6 > SEQ / 64 ? SEQ / 64 : qt * 4 + 6; nwin = hiT - lo; mi.a = qt * 256 + wid * 32 + r32; }
            if (MODE == 0) { lo = qt * 4 - 4 < 0 ? 0 : qt * 4 - 4; const int hc_ = qt * 4 - 1 < 0 ? 0 : (qt * 4 - 1 > 120 ? 120 : qt * 4 - 1); const int hiR = hc_ + 7; nwin = hiR - lo + 1;
                const int qr_ = qt * 4 + (wid >> 1), qc = (wid & 1) * 32 + r32; mi.a = qr_; mi.b = qc; mi.c = qc - 8 < 0 ? 0 : (qc - 8 > 48 ? 48 : qc - 8); mi.d = qr_ - 4 < 0 ? 0 : (qr_ - 4 > 120 ? 120 : qr_ - 4); }
            lat0 = b * SEQ + lo * 64; NT = 4 + nwin; NT += NT & 1;
        }
        const float* ex = nullptr; bool sink = false;
        if (MODE == 0) ex = cu ? nullptr : extra + h * (15 * 31);
        if (MODE == 1) { ex = extra + h; sink = true; }
        attn_unit<MODE>(QKV, ldq, qcol, kcol, vcol, AO, qrow0, ctx0, lat0, lo, nwin, NT, mi, ex, sink, lds, F.wv(), qg, cu ? nullptr : rope_c);
        __syncthreads();
    }
}
}

namespace ml {
typedef short v4i16_t __attribute__((ext_vector_type(4)));
constexpr int NCH = 132;
constexpr size_t OFF_WB = 0, OFF_TAB = 40 * MiB, OFF_NLOC = 48 * MiB;
constexpr int TAB_P = 0, TAB_E = 64, TAB_DEN = 128, TAB_DECAY = 192, TAB_N = 320;
constexpr int QSTR = 528, VSTR = 144;
__device__ __forceinline__ bf16x8 trfrag(const LAS char* p0, const LAS char* p1) {
    const s16x4 a = __builtin_bit_cast(s16x4, __builtin_amdgcn_ds_read_tr16_b64_v4i16((LAS v4i16_t*)p0));
    const s16x4 b = __builtin_bit_cast(s16x4, __builtin_amdgcn_ds_read_tr16_b64_v4i16((LAS v4i16_t*)p1));
    return (bf16x8){a[0], a[1], a[2], a[3], b[0], b[1], b[2], b[3]};
}
__device__ __forceinline__ float rdlane(float v, int l) { return __builtin_bit_cast(float, __builtin_amdgcn_readlane(__builtin_bit_cast(int, v), l)); }
__device__ __forceinline__ float log_sigmoid(float g) { return fminf(g, 0.f) - log1pf(__expf(-fabsf(g))); }
__device__ __forceinline__ int chrow(int b, int dir, int c, int s) {
    return c < 4 ? (dir ? MLAT + b * CTXL + 255 - (64 * c + s) : MLAT + b * CTXL + 64 * c + s) : (dir ? b * SEQ + SEQ - 1 - (64 * (c - 4) + s) : b * SEQ + 64 * (c - 4) + s);
}

namespace pa { constexpr int QS = 0, KS = 33792, GI = 67584, GF = 67840, TAB = 68096  , DENP = 78336  , NP = 78848  , BL = 80896  , PM = 81424  ; }
__device__ __forceinline__ void mlstm_pre_a(Frame& F, const Args& A) {
    using namespace pa;
    unsigned char* ws = opq_ptr(A.ws); const bf16* QKV = (const bf16*)(ws + WS_QKV); const float* GT = (const float*)(ws + WS_GATES);
    bf16* WB = (bf16*)(ws + WS_PART + OFF_WB); float* TABG = (float*)(ws + WS_PART + OFF_TAB); float* NLOC = (float*)(ws + WS_PART + OFF_NLOC); bf16* KTW = (bf16*)(ws + WS_HX);
    LAS char* lds = (LAS char*)F.ldsp();
    const int tid = opq(F.tid_()), w = F.wv(), lane = tid & 63, r = lane & 15, q = lane >> 4;
    LAS float* tabA = (LAS float*)(lds + TAB + w * 1280); LAS float* tabM = tabA + 64; LAS float* tabP = tabA + 128; LAS float* tabE = tabA + 192; LAS float* tabW = tabA + 256;
    for (int u = F.vc(); u < 256; u += F.ng()) {
        const int seg = u & 7, chain = u >> 3, dir = chain & 1, h = (chain >> 1) & 3, b = chain >> 3;
        const int gi_idx = (dir ? 8 : 0) + h, gf_idx = (dir ? 12 : 4) + h, qcol = h * 256, kcol = 1024 + h * 256;
        const int c0 = seg * 17, c1 = c0 + 17 < NCH ? c0 + 17 : NCH;
        for (int cb = w; cb < c0; cb += 4 * NWAVES) {
            float gi4[4], gf4[4];
#pragma unroll
            for (int k = 0; k < 4; ++k) { const int c = cb + k * NWAVES; const float* gp = GT + (size_t)chrow(b, dir, c < c0 ? c : cb, lane) * 16; gi4[k] = gp[gi_idx]; gf4[k] = gp[gf_idx]; }
#pragma unroll
            for (int k = 0; k < 4; ++k) { const int c = cb + k * NWAVES;
                const float bs = scan_add(log_sigmoid(gf4[k]));
                const float pm = wave_max(gi4[k] - bs);
                if (lane == 63 && c < c0) { ((LAS float*)(lds + BL))[c] = bs; ((LAS float*)(lds + PM))[c] = pm; } } }
        __syncthreads();
        float m = 0.f;
        for (int c = 0; c < c0; ++c) m = ((LAS float*)(lds + BL))[c] + fmaxf(m, ((LAS float*)(lds + PM))[c]);
        v4u pq[4], pk[4]; float pgi = 0.f, pgf = 0.f;
#define PREFETCH(c) do { _Pragma("unroll") for (int i_ = 0; i_ < 4; ++i_) { const int pi_ = tid + 512 * i_, s_ = pi_ >> 5, cp_ = pi_ & 31; const bf16* rp_ = QKV + (size_t)chrow(b, dir, c, s_) * 6144 + 8 * cp_; \
            pq[i_] = *(const GAS v4u*)(rp_ + qcol); pk[i_] = *(const GAS v4u*)(rp_ + kcol); } \
        if (tid < 64) { const float* gp_ = GT + (size_t)chrow(b, dir, c, tid) * 16; pgi = gp_[gi_idx]; pgf = gp_[gf_idx]; } } while (0)
#define COMMIT() do { _Pragma("unroll") for (int i_ = 0; i_ < 4; ++i_) { const int pi_ = tid + 512 * i_, s_ = pi_ >> 5, cp_ = pi_ & 31; \
            *(LAS v4u*)(lds + QS + s_ * QSTR + cp_ * 16) = pq[i_]; *(LAS v4u*)(lds + KS + s_ * QSTR + cp_ * 16) = pk[i_]; } \
        if (tid < 64) { ((LAS float*)(lds + GI))[tid] = pgi; ((LAS float*)(lds + GF))[tid] = pgf; } } while (0)
        PREFETCH(c0); VM_WAIT(); COMMIT(); __syncthreads();
        for (int c = c0; c < c1; ++c) {
            if (c + 1 < c1) PREFETCH(c + 1);
            const size_t cc = (size_t)chain * NCH + c;
            float decay, m_next;
            { const float gi = ((LAS float*)(lds + GI))[lane], lf = log_sigmoid(((LAS float*)(lds + GF))[lane]);
              const float bsum = scan_add(lf);
              const float a = gi - bsum; const float pm = scan_max(a);
              const float M = fmaxf(m, pm), Ml = rdlane(M, 63), bl = rdlane(bsum, 63);
              tabA[lane] = a; tabM[lane] = M; tabP[lane] = fast_exp(m - M); tabE[lane] = fast_exp(-(bsum + M)); tabW[lane] = fast_exp(a - Ml) * 0.0625f;
              decay = fast_exp(m - Ml); m_next = bl + Ml; }
            LDS_WAIT();
            { const int tb = w >> 1, sbh = w & 1; float rs = 0.f;
              const float Mt = tabM[16 * tb + r];
#pragma unroll
              for (int sbi = 0; sbi < 2; ++sbi) { const int sb = 2 * sbh + sbi; f32x4 wv = (f32x4){0.f, 0.f, 0.f, 0.f};
                  if (sb <= tb) { f32x4 acc = (f32x4){0.f, 0.f, 0.f, 0.f};
#pragma unroll
                      for (int kk = 0; kk < 8; ++kk) { const bf16x8 ka = *(const LAS bf16x8*)(lds + KS + (16 * sb + r) * QSTR + (32 * kk + 8 * q) * 2); const bf16x8 qb = *(const LAS bf16x8*)(lds + QS + (16 * tb + r) * QSTR + (32 * kk + 8 * q) * 2);
                          acc = __builtin_amdgcn_mfma_f32_16x16x32_bf16(ka, qb, acc, 0, 0, 0); }
                      const f32x4 a4 = *(const LAS f32x4*)(tabA + 16 * sb + 4 * q);
#pragma unroll
                      for (int i = 0; i < 4; ++i) wv[i] = (16 * sb + 4 * q + i <= 16 * tb + r) ? fast_exp(a4[i] - Mt) * acc[i] * 0.0625f : 0.f; }
                  rs += (wv[0] + wv[1]) + (wv[2] + wv[3]);
                  v2u o; o.x = pk2(wv[0], wv[1]); o.y = pk2(wv[2], wv[3]);
                  *(GAS v2u*)(WB + cc * 4096 + (16 * tb + r) * 64 + 16 * sb + 4 * q) = o; }
              rs = sum_xor16_32(rs);
              if (q == 0) ((LAS float*)(lds + DENP))[sbh * 64 + 16 * tb + r] = rs; }
            { const int d = tid & 255, sh = tid >> 8; float ns = 0.f; unsigned pkd[16];
#pragma unroll
              for (int i = 0; i < 16; ++i) { const int s0 = 32 * sh + 2 * i; const float v0 = tabW[s0] * bf2f(*(const LAS bf16*)(lds + KS + s0 * QSTR + d * 2)), v1 = tabW[s0 + 1] * bf2f(*(const LAS bf16*)(lds + KS + (s0 + 1) * QSTR + d * 2));
                  ns += v0 + v1; pkd[i] = pk2(v0, v1); }
              GAS v4u* kp = (GAS v4u*)(KTW + cc * 16384 + d * 64 + 32 * sh);
#pragma unroll
              for (int i = 0; i < 4; ++i) kp[i] = (v4u){pkd[4 * i], pkd[4 * i + 1], pkd[4 * i + 2], pkd[4 * i + 3]};
              ((LAS float*)(lds + NP))[sh * 256 + d] = ns; }
            __syncthreads();
            if (tid < 64) { float* tg = TABG + cc * TAB_N; tg[TAB_P + tid] = tabP[tid]; tg[TAB_E + tid] = tabE[tid]; tg[TAB_DEN + tid] = ((LAS float*)(lds + DENP))[tid] + ((LAS float*)(lds + DENP))[64 + tid]; if (tid == 0) tg[TAB_DECAY] = decay; }
            if (tid < 256) NLOC[cc * 256 + tid] = ((LAS float*)(lds + NP))[tid] + ((LAS float*)(lds + NP))[256 + tid];
            m = m_next;
            if (c + 1 < c1) { COMMIT(); }
            __syncthreads();
        }
#undef PREFETCH
#undef COMMIT
    }
}

namespace pb_ { constexpr int NSL = 0  , QNP = 1024  ; }
__device__ __forceinline__ void mlstm_pre_b(Frame& F, const Args& A) {
    using namespace pb_;
    unsigned char* ws = opq_ptr(A.ws); const bf16* QKV = (const bf16*)(ws + WS_QKV);
    float* TABG = (float*)(ws + WS_PART + OFF_TAB); const float* NLOC = (const float*)(ws + WS_PART + OFF_NLOC);
    LAS char* lds = (LAS char*)F.ldsp();
    const int tid = opq(F.tid_()), w = F.wv(), lane = tid & 63;
    for (int u = F.vc(); u < 256; u += F.ng()) {
        const int seg = u & 7, chain = u >> 3, dir = chain & 1, h = (chain >> 1) & 3, b = chain >> 3, qcol = h * 256;
        const int c0 = seg * 17, c1 = c0 + 17 < NCH ? c0 + 17 : NCH;
        float n = 0.f;
        if (tid < 256) {
            int c = 0;
            for (; c + 8 <= c0; c += 8) { float dk[8], vk[8];
#pragma unroll
                for (int k = 0; k < 8; ++k) { const size_t cc = (size_t)chain * NCH + c + k; dk[k] = TABG[cc * TAB_N + TAB_DECAY]; vk[k] = NLOC[cc * 256 + tid]; }
#pragma unroll
                for (int k = 0; k < 8; ++k) n = dk[k] * n + vk[k]; }
            for (; c < c0; ++c) { const size_t cc = (size_t)chain * NCH + c; n = TABG[cc * TAB_N + TAB_DECAY] * n + NLOC[cc * 256 + tid]; } }
        v4u qn[4];
        { const bf16* qp = QKV + (size_t)chrow(b, dir, c0, lane) * 6144 + qcol + 32 * w;
#pragma unroll
          for (int i = 0; i < 4; ++i) qn[i] = *(const GAS v4u*)(qp + 8 * i); }
        for (int c = c0; c < c1; ++c) {
            const size_t cc = (size_t)chain * NCH + c;
            if (tid < 256) ((LAS float*)(lds + NSL))[tid] = n;
            v4u qv4[4];
#pragma unroll
            for (int i = 0; i < 4; ++i) qv4[i] = qn[i];
            if (c + 1 < c1) { const bf16* qp = QKV + (size_t)chrow(b, dir, c + 1, lane) * 6144 + qcol + 32 * w;
#pragma unroll
                for (int i = 0; i < 4; ++i) qn[i] = *(const GAS v4u*)(qp + 8 * i); }
            float dcy = 0.f, nlc = 0.f;
            if (tid < 256) { dcy = TABG[cc * TAB_N + TAB_DECAY]; nlc = NLOC[cc * 256 + tid]; }
            __syncthreads();
            { float s = 0.f; const LAS float* ns = (const LAS float*)(lds + NSL) + 32 * w;
#pragma unroll
              for (int i = 0; i < 4; ++i) { const v4u qv = qv4[i]; const f32x4 n0 = *(const LAS f32x4*)(ns + 8 * i), n1 = *(const LAS f32x4*)(ns + 8 * i + 4);
                  s += bf_lo(qv.x) * n0.x + bf_hi(qv.x) * n0.y + bf_lo(qv.y) * n0.z + bf_hi(qv.y) * n0.w + bf_lo(qv.z) * n1.x + bf_hi(qv.z) * n1.y + bf_lo(qv.w) * n1.z + bf_hi(qv.w) * n1.w; }
              ((LAS float*)(lds + QNP))[w * 64 + lane] = s; }
            __syncthreads();
            if (tid < 64) { float qn_ = 0.f;
#pragma unroll
                for (int ww = 0; ww < 8; ++ww) qn_ += ((LAS float*)(lds + QNP))[ww * 64 + tid];
                float* tg = TABG + cc * TAB_N; tg[TAB_DEN + tid] += tg[TAB_P + tid] * qn_; }
            if (tid < 256) n = dcy * n + nlc;
        }
        __syncthreads();
    }
}

namespace sc { constexpr int QS = 0, KT = 33792  , VS = 74752  , WS_ = 83968  , TABL = 94208  , KSTR = 160, CT = 95232  ; }
__device__ __forceinline__ void mlstm_scan(Frame& F, const Args& A) {
    using namespace sc;
    unsigned char* ws = opq_ptr(A.ws); const bf16* QKV = (const bf16*)(ws + WS_QKV);
    const bf16* WB = (const bf16*)(ws + WS_PART + OFF_WB); const float* TABG = (const float*)(ws + WS_PART + OFF_TAB); const bf16* KTW = (const bf16*)(ws + WS_HX);
    LAS char* lds = (LAS char*)F.ldsp();
    const int tid = opq(F.tid_()), w = F.wv(), lane = tid & 63, r = lane & 15, q = lane >> 4, nb = w & 3, th = w >> 2;
    for (int u = F.vc(); u < 256; u += F.ng()) {
        const int j = u & 7, chain = u >> 3, dir = chain & 1, h = (chain >> 1) & 3, b = chain >> 3;
        bf16* OUT = (bf16*)(ws + (dir ? WS_HB : WS_AO));
        const int qcol = h * 256, vcol = 2048 + h * 512 + j * 64, ocol = h * 512 + j * 64;
        f32x4 Cw[2][4];
#pragma unroll
        for (int rb = 0; rb < 2; ++rb)
#pragma unroll
            for (int cb = 0; cb < 4; ++cb) Cw[rb][cb] = (f32x4){0.f, 0.f, 0.f, 0.f};
        for (int i = tid; i < 64 * QSTR / 16; i += NWAVES * 64) *(LAS v4u*)(lds + CT + 16 * i) = (v4u){0u, 0u, 0u, 0u};
        v4u pq[4], pk[4], pv, pw; f32x4 pt = (f32x4){0.f, 0.f, 0.f, 0.f};
#define PREFETCH(c) do { const size_t cc_ = (size_t)chain * NCH + (c); \
        _Pragma("unroll") for (int i_ = 0; i_ < 4; ++i_) { const int pi_ = tid + 512 * i_; pq[i_] = *(const GAS v4u*)(QKV + (size_t)chrow(b, dir, c, pi_ >> 5) * 6144 + qcol + 8 * (pi_ & 31)); \
            pk[i_] = *(const GAS v4u*)(KTW + cc_ * 16384 + (size_t)pi_ * 8); } \
        pv = *(const GAS v4u*)(QKV + (size_t)chrow(b, dir, c, tid >> 3) * 6144 + vcol + 8 * (tid & 7)); pw = *(const GAS v4u*)(WB + cc_ * 4096 + (size_t)tid * 8); \
        if (tid < 49) pt = *(const GAS f32x4*)(TABG + cc_ * TAB_N + 4 * tid); } while (0)
#define COMMIT() do { _Pragma("unroll") for (int i_ = 0; i_ < 4; ++i_) { const int pi_ = tid + 512 * i_; *(LAS v4u*)(lds + QS + (pi_ >> 5) * QSTR + (pi_ & 31) * 16) = pq[i_]; \
            *(LAS v4u*)(lds + KT + (pi_ >> 3) * KSTR + (pi_ & 7) * 16) = pk[i_]; } \
        *(LAS v4u*)(lds + VS + (tid >> 3) * VSTR + (tid & 7) * 16) = pv; *(LAS v4u*)(lds + WS_ + (tid >> 3) * KSTR + (tid & 7) * 16) = pw; \
        if (tid < 49) *(LAS f32x4*)(lds + TABL + 16 * tid) = pt; } while (0)
#define WARM(c) do { const size_t cc_ = (size_t)chain * NCH + (c); \
        const bf16* b0_ = (w < 4) ? QKV : KTW; const unsigned o0_ = (w < 4) ? (unsigned)((chrow(b, dir, c, tid >> 2) * 6144 + qcol + 64 * (tid & 3)) * 2) : (unsigned)((cc_ * 16384 + (size_t)(tid - 256) * 64) * 2); \
        asm volatile("global_load_dword %0, %1, %2" : "+v"(wrm0) : "v"(o0_), "s"(b0_) : "memory"); } while (0)
        int wrm0 = 0;
        PREFETCH(0); VM_WAIT(); COMMIT(); __syncthreads();
        WARM(1);
        for (int c = 0; c < NCH; ++c) {
            if (c + 1 < NCH) PREFETCH(c + 1);
            if (c + 2 < NCH) WARM(c + 2);
            const LAS float* tl = (const LAS float*)(lds + TABL);
            unsigned hout[4];
            bf16x8 vb[2];
#pragma unroll
            for (int ks = 0; ks < 2; ++ks) { const LAS char* vp = lds + VS + (32 * ks + 8 * q + (r >> 2)) * VSTR + (16 * nb + 4 * (r & 3)) * 2; vb[ks] = trfrag(vp, vp + 4 * VSTR); }
            { f32x4 intra[2], inter[2];
#pragma unroll
              for (int tbi = 0; tbi < 2; ++tbi) { intra[tbi] = (f32x4){0.f, 0.f, 0.f, 0.f}; inter[tbi] = (f32x4){0.f, 0.f, 0.f, 0.f}; }
#pragma unroll
              for (int ks = 0; ks < 2; ++ks)
#pragma unroll
                  for (int tbi = 0; tbi < 2; ++tbi) { const bf16x8 wa = *(const LAS bf16x8*)(lds + WS_ + (16 * (2 * th + tbi) + r) * KSTR + (32 * ks + 8 * q) * 2);
                      intra[tbi] = __builtin_amdgcn_mfma_f32_16x16x32_bf16(wa, vb[ks], intra[tbi], 0, 0, 0); }
#pragma unroll
              for (int hk = 0; hk < 2; ++hk) {
                  v4u cfr[4], qar[4][2];
#pragma unroll
                  for (int k4 = 0; k4 < 4; ++k4) { const int kk = 4 * hk + k4;
                      const LAS char* cp = lds + CT + (16 * nb + r) * QSTR + (32 * kk + 4 * q) * 2;
                      const v2u clo = *(const LAS v2u*)cp, chi = *(const LAS v2u*)(cp + 32); cfr[k4] = (v4u){clo.x, clo.y, chi.x, chi.y};
#pragma unroll
                      for (int tbi = 0; tbi < 2; ++tbi) { const LAS char* qp = lds + QS + (16 * (2 * th + tbi) + r) * QSTR + (32 * kk + 4 * q) * 2;
                          const v2u lo = *(const LAS v2u*)qp, hi2 = *(const LAS v2u*)(qp + 32); qar[k4][tbi] = (v4u){lo.x, lo.y, hi2.x, hi2.y}; } }
#pragma unroll
                  for (int k4 = 0; k4 < 4; ++k4)
#pragma unroll
                      for (int tbi = 0; tbi < 2; ++tbi) inter[tbi] = __builtin_amdgcn_mfma_f32_16x16x32_bf16(__builtin_bit_cast(bf16x8, qar[k4][tbi]), __builtin_bit_cast(bf16x8, cfr[k4]), inter[tbi], 0, 0, 0);
                  __builtin_amdgcn_sched_barrier(0);
              }
#pragma unroll
              for (int tbi = 0; tbi < 2; ++tbi) { const int t0 = 16 * (2 * th + tbi) + 4 * q;
                  const f32x4 P4 = *(const LAS f32x4*)(tl + TAB_P + t0), E4 = *(const LAS f32x4*)(tl + TAB_E + t0), D4 = *(const LAS f32x4*)(tl + TAB_DEN + t0);
                  float hv[4];
#pragma unroll
                  for (int i = 0; i < 4; ++i) hv[i] = (intra[tbi][i] + P4[i] * inter[tbi][i]) / fmaxf(fabsf(D4[i]), E4[i]);
                  hout[2 * tbi] = pk2(hv[0], hv[1]); hout[2 * tbi + 1] = pk2(hv[2], hv[3]); } }
            __builtin_amdgcn_sched_barrier(0);
            { const float decay = tl[TAB_DECAY];
#pragma unroll
              for (int rb = 0; rb < 2; ++rb)
#pragma unroll
                  for (int cb = 0; cb < 4; ++cb) Cw[rb][cb] *= decay;
              bf16x8 ka[2][2];
#pragma unroll
              for (int rb = 0; rb < 2; ++rb)
#pragma unroll
                  for (int ks = 0; ks < 2; ++ks) ka[rb][ks] = *(const LAS bf16x8*)(lds + KT + (32 * w + 16 * rb + r) * KSTR + (32 * ks + 8 * q) * 2);
#pragma unroll
              for (int cb = 0; cb < 4; ++cb) { bf16x8 vx[2];
#pragma unroll
                  for (int ks = 0; ks < 2; ++ks) { const LAS char* vp = lds + VS + (32 * ks + 8 * q + (r >> 2)) * VSTR + (16 * cb + 4 * (r & 3)) * 2; vx[ks] = trfrag(vp, vp + 4 * VSTR); }
#pragma unroll
                  for (int rb = 0; rb < 2; ++rb)
#pragma unroll
                      for (int ks = 0; ks < 2; ++ks) Cw[rb][cb] = __builtin_amdgcn_mfma_f32_16x16x32_bf16(ka[rb][ks], vx[ks], Cw[rb][cb], 0, 0, 0); } }
            __syncthreads();
            if (c + 1 < NCH) { if (c + 2 < NCH) asm volatile("s_waitcnt vmcnt(1)" : "+v"(wrm0) :: "memory"); else asm volatile("s_waitcnt vmcnt(0)" : "+v"(wrm0) :: "memory"); COMMIT(); }
#pragma unroll
            for (int rb = 0; rb < 2; ++rb)
#pragma unroll
                for (int cb = 0; cb < 4; ++cb) { v2u cw; cw.x = pk2(Cw[rb][cb][0], Cw[rb][cb][1]); cw.y = pk2(Cw[rb][cb][2], Cw[rb][cb][3]);
                    *(LAS v2u*)(lds + CT + (16 * cb + r) * QSTR + (32 * w + 16 * rb + 4 * q) * 2) = cw; }
#pragma unroll
            for (int tbi = 0; tbi < 2; ++tbi)
#pragma unroll
                for (int i = 0; i < 4; ++i) ((GAS bf16*)OUT)[(size_t)chrow(b, dir, c, 16 * (2 * th + tbi) + 4 * q + i) * DM + ocol + 16 * nb + r] = (bf16)((hout[2 * tbi + (i >> 1)] >> (16 * (i & 1))) & 0xffffu);
            __syncthreads();
        }
#undef PREFETCH
#undef COMMIT
#undef WARM
    }
}
}

constexpr int NPH = 42;
#ifndef EN_ALL
#define EN_ALL 1
#endif
#ifndef EN_PRO
#define EN_PRO EN_ALL
#endif
#ifndef EN_NORM
#define EN_NORM EN_ALL
#endif
#ifndef EN_G1
#define EN_G1 EN_ALL
#endif
#ifndef EN_QKN
#define EN_QKN EN_ALL
#endif
#ifndef EN_A0
#define EN_A0 EN_ALL
#endif
#ifndef EN_A1
#define EN_A1 EN_ALL
#endif
#ifndef EN_ML
#define EN_ML EN_ALL
#endif
#ifndef EN_MLA
#define EN_MLA 1
#endif
#ifndef EN_MLB
#define EN_MLB 1
#endif
#ifndef EN_MLS
#define EN_MLS 1
#endif
#ifndef EN_A3
#define EN_A3 EN_ALL
#endif
#ifndef EN_RO
#define EN_RO EN_ALL
#endif
#ifndef EN_G2
#define EN_G2 EN_ALL
#endif
#ifndef EN_G3
#define EN_G3 EN_ALL
#endif
#ifndef EN_FIX
#define EN_FIX EN_ALL
#endif
#ifndef EN_G4
#define EN_G4 EN_ALL
#endif


#ifndef REP_PRO
#define REP_PRO 1
#endif
#ifndef REP_NORM
#define REP_NORM 1
#endif
#ifndef REP_G1
#define REP_G1 1
#endif
#ifndef REP_QKN
#define REP_QKN 1
#endif
#ifndef REP_A0
#define REP_A0 1
#endif
#ifndef REP_A1
#define REP_A1 1
#endif
#ifndef REP_ML
#define REP_ML 1
#endif
#ifndef REP_A3
#define REP_A3 1
#endif
#ifndef REP_RO
#define REP_RO 1
#endif
#ifndef REP_G3
#define REP_G3 1
#endif
#ifndef REP_FIX
#define REP_FIX 1
#endif
#ifndef REP_G2
#define REP_G2 1
#endif
#ifndef REP_G4
#define REP_G4 1
#endif
#ifndef REP_MLA
#define REP_MLA 1
#endif
#ifndef REP_MLS
#define REP_MLS 1
#endif
#ifndef WGM_G1
#define WGM_G1 4
#endif
#ifndef WGM_G2
#define WGM_G2 4
#endif
#ifndef WGM_G3
#define WGM_G3 4
#endif
#ifndef WGM_G4
#define WGM_G4 4
#endif
#ifndef ORD_G1
#define ORD_G1 1
#endif
#ifndef ORD_G2
#define ORD_G2 1
#endif
#ifndef ORD_G3
#define ORD_G3 1
#endif
#ifndef ORD_G4
#define ORD_G4 1
#endif
#ifndef DIR_N1
#define DIR_N1 1
#endif
#ifndef DIR_N2
#define DIR_N2 1
#endif
#ifndef QFUSE
#define QFUSE 1
#endif
#ifndef XBAR
#define XBAR 1
#endif
#ifndef MK_MODE
#define MK_MODE 0
#endif
__global__ void __launch_bounds__(NWAVES * 64, 2) fwd(Args args) {
    extern __shared__ __attribute__((aligned(16))) unsigned char lds[];
    Frame F;
    F.lds = (LAS unsigned char*)lds; F.MISC = (volatile LAS unsigned*)(F.lds + MISC_OFF);
    F.wave = __builtin_amdgcn_readfirstlane((int)threadIdx.x >> 6);
    F.G = gridDim.x; F.bx = blockIdx.x; { const int bx = blockIdx.x; F.vcu = (F.G % 8 == 0) ? (bx % 8) * (F.G / 8) + bx / 8 : bx; }
    unsigned char* ws = args.ws; F.ctl = (gu32*)(ws + WS_CTL);
    for (int u = threadIdx.x; u < (LDS_BYTES - LDSCTL_OFF) / 4; u += NWAVES * 64) ((LAS unsigned*)(F.lds + LDSCTL_OFF))[u] = 0u;
    __syncthreads();
    const int lo = args.ph_lo, hi = args.ph_hi;
    XcdBarrier bar = xcd_barrier_post((unsigned*)(F.ctl + CW_BAR) + lo * XCD_BAR_WORDS, F.MISC + 8);
#define RUN(k) (lo <= (k) && (k) < hi)
#define BAR_AFTER(k) do { if ((k) + 1 < hi) { xcd_barrier(bar); if (XBAR == 2) xcd_barrier(bar); } } while (0)
    float* const out = args.out;
#define WSP(off) (opq_ptr(args.ws) + (off))
#define HX ((bf16*)WSP(WS_HX))
#define QKVb ((bf16*)WSP(WS_QKV))
#define AOb ((bf16*)WSP(WS_AO))
#define ACT ((bf16*)WSP(WS_QKV))

    if (EN_PRO && RUN(0)) { for (int rep_ = 0; rep_ < REP_PRO; ++rep_) { if (rep_) __syncthreads(); prologue_phase(F, args); } BAR_AFTER(0); }
    if (RUN(1)) { modred_phase(F, args); BAR_AFTER(1); }

#define LAYER_BODY(L) { \
        const int pb = 2 + 10 * L; const bool last = (L == 3); \
        const float* modl = (const float*)WSP(WS_MOD) + (size_t)L * 5 * NMOD; \
        const int nq = nqkv_of(L), mrows = last ? MLAT : MT; \
        if (EN_NORM && RUN(pb + 0)) { for (int rep_ = 0; rep_ < REP_NORM; ++rep_) norm_phase(F, args, L == 0 ? (const void*)ldarg(I_X) : (const void*)out, (L) != 0, ldarg(I_N1G) + (size_t)L * DM, modl, 0, true, L == 2, L == 0 ? nullptr : modl - 5 * NMOD + 4 * NMOD + 5 * DM, DIR_N1 != 0); BAR_AFTER(pb + 0); } \
        if (EN_G1 && RUN(pb + 1)) { \
            pg8::Gemm g{HX, (const bf16*)WSP(WS_WQKV + wqkv_off(L)), MT, nq, DM}; pg8::StaticOrder S; S.init(MT, nq, F.ng(), F.bx_(), DM); S.wgm = WGM_G1; S.ord = ORD_G1; \
            if ((L) == 2 || !((QKF_MASK >> (L)) & 1)) { pg8::EpiStore E{QKVb, nq}; \
                for (int rep_ = 0; rep_ < REP_G1; ++rep_) pg8::gemm_phase<pg8::EpiStore, pg8::StaticOrder, true, PG8_SP2>(F.ldsp() + RING_OFF, g, S, E, F.wv()); } \
            else { pg8::EpiQK E{QKVb, nq, (NH + ((L) == 0 ? 16 : ((L) == 1 ? 2 : 4))) / 2, ldarg((L) == 0 ? I_NAQG : ((L) == 1 ? I_SWQG : I_GQQG)), ldarg((L) == 0 ? I_NAKG : ((L) == 1 ? I_SWKG : I_GQKG)), \
                    (L) == 0 ? (const float*)nullptr : (const float*)WSP(WS_ROPE), (L) == 0 ? (const float*)nullptr : (const float*)WSP(WS_ROPE) + 4096, (PG8_LAS float*)(F.ldsp() + QKX_OFF)}; \
                for (int rep_ = 0; rep_ < REP_G1; ++rep_) pg8::gemm_phase<pg8::EpiQK, pg8::StaticOrder, true, PG8_SP2>(F.ldsp() + RING_OFF, g, S, E, F.wv()); } \
            if (TAILFILL && TAIL_OWN3 && (L) == 3) convert_tail<3>(F, args, (MT / 256) * (nq / 256), conv_items(3) * (TAIL1_PCT + TAIL3_PCT) / 100, conv_items(3)); \
            if (TAILFILL && TAIL1_PCT > 0 && (L) < 3) convert_tail<((L) < 3 ? (L) + 1 : 3)>(F, args, (MT / 256) * (nq / 256), 0, conv_items((L) < 3 ? (L) + 1 : 3) * TAIL1_PCT / 100); \
            BAR_AFTER(pb + 1); } \
        if (EN_QKN && L != 2 && RUN(pb + 2)) { \
            const float* qg = ldarg(L == 0 ? I_NAQG : (L == 1 ? I_SWQG : I_GQQG)); const float* kg = ldarg(L == 0 ? I_NAKG : (L == 1 ? I_SWKG : I_GQKG)); \
            for (int rep_ = 0; rep_ < REP_QKN; ++rep_) qkn_phase(F, args, nq, NH + (L == 0 ? 16 : (L == 1 ? 2 : 4)), qg, kg, L != 0, rep_ > 0, QFUSE ? NH : 0); BAR_AFTER(pb + 2); } \
        if (RUN(pb + 3)) { \
            if (EN_A0 && L == 0) for (int rep_ = 0; rep_ < REP_A0; ++rep_) att::attn_phase<0>(F, args, nq, 16, ldarg(I_NARB), true, QFUSE ? ldarg(I_NAQG) : nullptr, nullptr); \
            else if (EN_A1 && L == 1) for (int rep_ = 0; rep_ < REP_A1; ++rep_) att::attn_phase<1>(F, args, nq, 2, ldarg(I_SWSINK), true, QFUSE ? ldarg(I_SWQG) : nullptr, (const float*)WSP(WS_ROPE)); \
            else if (EN_ML && L == 2) for (int rep_ = 0; rep_ < REP_ML; ++rep_) { if (rep_) xcd_barrier(bar); if (EN_MLA) ml::mlstm_pre_a(F, args); if (REP_MLA == 2) ml::mlstm_pre_a(F, args); xcd_barrier(bar); if (EN_MLB) ml::mlstm_pre_b(F, args); xcd_barrier(bar); if (EN_MLS) ml::mlstm_scan(F, args); if (REP_MLS == 2) ml::mlstm_scan(F, args); } \
            else if (EN_A3 && L == 3) for (int rep_ = 0; rep_ < REP_A3; ++rep_) att::attn_phase<3>(F, args, nq, 4, nullptr, false, QFUSE ? ldarg(I_GQQG) : nullptr, (const float*)WSP(WS_ROPE)); \
            BAR_AFTER(pb + 3); } \
        if (EN_RO && L == 2 && RUN(pb + 4)) { for (int rep_ = 0; rep_ < REP_RO; ++rep_) mlro_phase(F, args); BAR_AFTER(pb + 4); } \
        if (EN_G2 && RUN(pb + 5)) { \
            pg8::Gemm g{L == 2 ? HX : AOb, (const bf16*)WSP(WS_WO) + (size_t)L * DM * DM, MLAT, DM, DM}; pg8::StaticOrder S; S.init(MLAT, DM, F.ng(), F.bx_(), DM, last ? 0 : 8, 4); S.wgm = WGM_G2; S.ord = ORD_G2; \
            pg8::EpiResidT<(L) != 0, true> E{L == 0 ? (const void*)ldarg(I_X) : (const void*)out, last ? (void*)WSP(WS_HB) : (void*)out, (float*)WSP(WS_PART), modl + 2 * DM, DM, NMOD}; \
            for (int rep_ = 0; rep_ < REP_G2; ++rep_) { if (rep_) { E.out_lat = (void*)WSP(WS_QKV); } \
                pg8::gemm_phase<pg8::EpiResidT<(L) != 0, true>, pg8::StaticOrder, true, PG8_SP2>(F.ldsp() + RING_OFF, g, S, E, F.wv()); } \
            BAR_AFTER(pb + 5); } \
        if (EN_NORM && RUN(pb + 6)) { for (int rep_ = 0; rep_ < REP_NORM; ++rep_) norm_phase(F, args, last ? (const void*)WSP(WS_HB) : (const void*)out, true, ldarg(I_N2G) + (size_t)L * DM, modl, 3, !last, false, last ? nullptr : modl + 4 * NMOD + 2 * DM, DIR_N2 != 0); BAR_AFTER(pb + 6); } \
        if (EN_G3 && RUN(pb + 7)) { \
            pg8::Gemm g{HX, (const bf16*)WSP(WS_WIN) + (size_t)L * 2 * DFF * DM, mrows, 2 * DFF, DM}; pg8::StaticOrder S; S.init(mrows, 2 * DFF, F.ng(), F.bx_(), DM); S.wgm = WGM_G3; S.ord = ORD_G3; \
            pg8::EpiGlu E{ACT, (float*)WSP(WS_EDGE), ldarg(I_FCW) + (size_t)L * 3 * DFF, ldarg(I_FCB) + (size_t)L * DFF, (PG8_LAS float*)(F.ldsp() + XB_OFF), DFF}; \
            for (int rep_ = 0; rep_ < REP_G3; ++rep_) pg8::gemm_phase<pg8::EpiGlu, pg8::StaticOrder, true, PG8_SP2>(F.ldsp() + RING_OFF, g, S, E, F.wv()); \
            if (TAILFILL && TAIL3_PCT > 0 && (L) < 3) convert_tail<((L) < 3 ? (L) + 1 : 3)>(F, args, (mrows / 256) * (2 * DFF / 256), conv_items((L) < 3 ? (L) + 1 : 3) * TAIL1_PCT / 100, conv_items((L) < 3 ? (L) + 1 : 3) * (TAIL1_PCT + TAIL3_PCT) / 100); \
            BAR_AFTER(pb + 7); } \
        if (EN_FIX && RUN(pb + 8)) { for (int rep_ = 0; rep_ < REP_FIX; ++rep_) fix_phase(F, args, L, last ? 128 : 132); BAR_AFTER(pb + 8); } \
        if (EN_G4 && RUN(pb + 9)) { \
            pg8::Gemm g{ACT, (const bf16*)WSP(WS_WOUT) + (size_t)L * DM * DFF, MLAT, DM, DFF}; pg8::StaticOrder S; S.init(MLAT, DM, F.ng(), F.bx_(), DFF, last ? 0 : 8, 4); S.wgm = WGM_G4; S.ord = ORD_G4; \
            pg8::EpiResidT<true, (L) != 3> E{last ? (const void*)WSP(WS_HB) : (const void*)out, (void*)out, (float*)WSP(WS_PART), modl + 5 * DM, DM, NMOD}; \
            for (int rep_ = 0; rep_ < REP_G4; ++rep_) { if (rep_) { E.out_lat = (void*)WSP(WS_AO); } \
                pg8::gemm_phase<pg8::EpiResidT<true, (L) != 3>, pg8::StaticOrder, true, PG8_SP2>(F.ldsp() + RING_OFF, g, S, E, F.wv()); } \
            BAR_AFTER(pb + 9); } \
    }
    LAYER_BODY(0) LAYER_BODY(1) LAYER_BODY(2) LAYER_BODY(3)
#undef LAYER_BODY
#undef RUN
#undef WSP
#undef HX
#undef QKVb
#undef AOb
#undef ACT
#undef BAR_AFTER
}

static bool phase_exists(int ph) { if (ph < 2) return true; const int L = (ph - 2) / 10, k = (ph - 2) % 10; if (k == 2) return L != 2 && !((QKF_MASK >> L) & 1); if (k == 4) return L == 2; return true; }
extern "C" void kernel_launch(void* const* d_in, const int* in_sizes, int n_in, void* d_out, int out_size, void* d_ws, size_t ws_size, hipStream_t stream) {
    static int grid = 0;
    if (grid == 0) {
        if (n_in != N_IN || out_size != MLAT * DM || ws_size < WS_END) { fprintf(stderr, "kernel_launch: unexpected shapes: n_in %d out %d ws %zu (need %zu)\n", n_in, out_size, ws_size, (size_t)WS_END); grid = -1; return; }
        int dev = 0, cus = 0, per_cu = 0;
        if (hipGetDevice(&dev) != hipSuccess || hipDeviceGetAttribute(&cus, hipDeviceAttributeMultiprocessorCount, dev) != hipSuccess) { grid = -1; return; }
        if (hipFuncSetAttribute((const void*)fwd, hipFuncAttributeMaxDynamicSharedMemorySize, LDS_BYTES) != hipSuccess) { fprintf(stderr, "kernel_launch: hipFuncSetAttribute failed\n"); grid = -1; return; }
        if (hipOccupancyMaxActiveBlocksPerMultiprocessor(&per_cu, (const void*)fwd, NWAVES * 64, LDS_BYTES) != hipSuccess || per_cu < 1) fprintf(stderr, "kernel_launch: occupancy query reports %d\n", per_cu);
        (void)hipGetLastError();
        grid = cus;
    }
    if (grid < 0) return;
    (void)hipMemsetAsync((char*)d_ws + WS_CTL, 0, MK_MODE == 0 ? (size_t)(CW_BAR + XCD_BAR_WORDS) * 4 : CTL_ZERO_BYTES, stream);
    Args a{};
    for (int i = 0; i < N_IN; ++i) a.in[i] = (const float*)d_in[i];
    a.out = (float*)d_out; a.ws = (unsigned char*)d_ws;
#if MK_MODE == 0
    a.ph_lo = 0; a.ph_hi = NPH;
    hipLaunchKernelGGL(fwd, dim3(grid), dim3(NWAVES * 64), LDS_BYTES, stream, a);
#else
    for (int ph = 0; ph < NPH; ++ph) { if (!phase_exists(ph)) continue; a.ph_lo = ph; a.ph_hi = ph + 1;
        hipLaunchKernelGGL(fwd, dim3(grid), dim3(NWAVES * 64), LDS_BYTES, stream, a); }
#endif
    const hipError_t le = hipPeekAtLastError();
    if (le != hipSuccess) fprintf(stderr, "kernel_launch: launch failed: %s\n", hipGetErrorName(le));
}
```

```cpp
#include <hip/hip_runtime.h>
#include <cstdio>
#include <cstdint>
__device__ __forceinline__ int opq(int v) { asm volatile("" : "+v"(v)); return v; }
__device__ __forceinline__ const float* ldarg(int i) {
    const char __attribute__((address_space(4)))* ka = (const char __attribute__((address_space(4)))*)__builtin_amdgcn_kernarg_segment_ptr();
    int off = i * 8; asm volatile("" : "+s"(off)); off = __builtin_amdgcn_readfirstlane(off);
    return *(const float* const __attribute__((address_space(4)))*)(ka + off);
}
__device__ __forceinline__ unsigned char* opq_ptr(unsigned char* p) { unsigned long long v = (unsigned long long)p; asm volatile("" : "+s"(v));
    const unsigned lo = (unsigned)__builtin_amdgcn_readfirstlane((int)(unsigned)v), hi = (unsigned)__builtin_amdgcn_readfirstlane((int)(unsigned)(v >> 32)); return (unsigned char*)(((unsigned long long)hi << 32) | lo); }
template <int CTRL, int ROWMASK = 0xf, bool BOUND = false> __device__ __forceinline__ float dppf(float oldv, float v) {
    return __builtin_bit_cast(float, __builtin_amdgcn_update_dpp(__builtin_bit_cast(int, oldv), __builtin_bit_cast(int, v), CTRL, ROWMASK, 0xf, BOUND)); }
__device__ __forceinline__ float row_sum16(float v) {
    v += dppf<0x121>(0.f, v); v += dppf<0x122>(0.f, v); v += dppf<0x124>(0.f, v); v += dppf<0x128>(0.f, v); return v; }
__device__ __forceinline__ float row_max16(float v) {
    v = fmaxf(v, dppf<0x121>(v, v)); v = fmaxf(v, dppf<0x122>(v, v)); v = fmaxf(v, dppf<0x124>(v, v)); v = fmaxf(v, dppf<0x128>(v, v)); return v; }
__device__ __forceinline__ float rdl(float v, int l) { return __builtin_bit_cast(float, __builtin_amdgcn_readlane(__builtin_bit_cast(int, v), l)); }
__device__ __forceinline__ float wave_sum(float v) { v = row_sum16(v); return (rdl(v, 0) + rdl(v, 16)) + (rdl(v, 32) + rdl(v, 48)); }
__device__ __forceinline__ float wave_max(float v) { v = row_max16(v); return fmaxf(fmaxf(rdl(v, 0), rdl(v, 16)), fmaxf(rdl(v, 32), rdl(v, 48))); }
__device__ __forceinline__ float sum16(float v) { return row_sum16(v); }
__device__ __forceinline__ float scan_add(float v) {
    v += dppf<0x111, 0xf, true>(0.f, v); v += dppf<0x112, 0xf, true>(0.f, v); v += dppf<0x114, 0xf, true>(0.f, v); v += dppf<0x118, 0xf, true>(0.f, v);
    v += dppf<0x142, 0xa>(0.f, v); v += dppf<0x143, 0xc>(0.f, v); return v; }
__device__ __forceinline__ float scan_max(float v) {
    const float ninf = -3.0e38f;
    v = fmaxf(v, dppf<0x111>(ninf, v)); v = fmaxf(v, dppf<0x112>(ninf, v)); v = fmaxf(v, dppf<0x114>(ninf, v)); v = fmaxf(v, dppf<0x118>(ninf, v));
    v = fmaxf(v, dppf<0x142, 0xa>(ninf, v)); v = fmaxf(v, dppf<0x143, 0xc>(ninf, v)); return v; }
__device__ __forceinline__ float swz_xor16(float v) { return __builtin_bit_cast(float, __builtin_amdgcn_ds_swizzle(__builtin_bit_cast(int, v), 0x401F)); }
__device__ __forceinline__ float swap32(float v) { auto r = __builtin_amdgcn_permlane32_swap(__builtin_bit_cast(unsigned, v), __builtin_bit_cast(unsigned, v), false, false); return __builtin_bit_cast(float, (unsigned)r[0]) ; }
__device__ __forceinline__ float sum_xor16_32(float v) { v += swz_xor16(v); auto r = __builtin_amdgcn_permlane32_swap(__builtin_bit_cast(unsigned, v), __builtin_bit_cast(unsigned, v), false, false);
    return __builtin_bit_cast(float, (unsigned)r[0]) + __builtin_bit_cast(float, (unsigned)r[1]); }
__device__ __forceinline__ float xor4_in16(float v, int lane) { const float up = dppf<0x104>(v, v), dn = dppf<0x114>(v, v); return (lane & 4) ? dn : up; }
__device__ __forceinline__ int lane_now() { int l; asm volatile("v_mbcnt_lo_u32_b32 %0, -1, 0\n\tv_mbcnt_hi_u32_b32 %0, -1, %0" : "=v"(l)); return l; }
__device__ __forceinline__ unsigned opq_u(unsigned v) { asm volatile("" : "+s"(v)); return (unsigned)__builtin_amdgcn_readfirstlane((int)v); }
namespace pg8 {
#define PG8_LAS __attribute__((address_space(3)))
typedef unsigned short bf16_t;
typedef short bf16x8 __attribute__((ext_vector_type(8)));
typedef float f32x4 __attribute__((ext_vector_type(4)));
typedef unsigned u32x4 __attribute__((ext_vector_type(4)));
constexpr int BM = 256, BK = 64, HALF = 128, HTB = HALF * BK * 2  , STAGE_BYTES = 8 * HTB, NXCD = 8, WGM = 4;

__host__ __device__ __forceinline__ int lds_byte(int r, int c) { const int st = (r >> 4) * 2 + (c >> 5), rr = r & 15, cc = c & 31, ob = rr * 64 + cc * 2; return st * 1024 + (ob ^ (((ob >> 9) & 1) << 5)); }
__host__ __device__ __forceinline__ void stage_rc(int b, int& R, int& C) { const int st = b / 1024, sb = b % 1024, swz = sb ^ (((sb >> 9) & 1) << 5); R = (st >> 1) * 16 + swz / 64; C = (st & 1) * 32 + (swz % 64) / 2; }
__host__ __device__ __forceinline__ int perm32(int rho) { const int n = rho >> 4, i = rho & 15; return 8 * (i >> 2) + 4 * n + (i & 3); }

struct Unit { int pm, pn, ko, nt, ks; };
struct Gemm { const bf16_t* A; const bf16_t* Bt; int M, N, K; };

struct StaticOrder {
    int nM, nN, nwg, G, c; int ord = 0;
    int wgm = WGM;
    int ntf, nsplit, kblk, xM;
    __host__ __device__ void init(int M, int N, int G_, int c_, int K_ = 0, int nsplit_ = 0, int xM_ = 0) { nM = M / BM; nN = N / BM; nwg = nM * nN; G = G_; c = c_; ntf = K_ / BK; nsplit = nsplit_; kblk = K_ / 128; xM = xM_; }
    __host__ __device__ bool next(int i, Unit& u) const {
        const int P = G / NXCD, vc = (G % NXCD == 0) ? (c % NXCD) * P + c / NXCD : c;
        const long L = (long)i * G + (ord ? vc : c);
        const bool split = L >= nwg;
        if (split && (nsplit == 0 || L - nwg >= (long)nsplit * xM * nN)) return false;
        int wgid = split ? 0 : (int)L; { const int q = nwg / NXCD, r = nwg % NXCD, xcd = wgid % NXCD, off = wgid / NXCD; const int w0 = (xcd < r ? xcd * (q + 1) : r * (q + 1) + (xcd - r) * q) + off; wgid = ord == 0 ? w0 : (ord == 1 ? wgid : nwg - 1 - wgid); }
        const int nig = wgm * nN, gid = wgid / nig, fm = gid * wgm, gsz = (nM - fm) < wgm ? (nM - fm) : wgm;
        const int pm0 = fm + ((wgid % nig) % gsz), pn0 = (wgid % nig) / gsz;
        const int j = split ? (int)(L - nwg) : 0, per = xM * nN > 0 ? xM * nN : 1, ns = nsplit > 0 ? nsplit : 1;
        const int s = j / per, rem = j - s * per, q2 = kblk / ns, r2 = kblk % ns;
        const int pm1 = nM + rem / nN, pn1 = rem % nN, ko1 = 128 * (s * q2 + (s < r2 ? s : r2)), nt1 = 2 * (q2 + (s < r2 ? 1 : 0));
        u.pm = split ? pm1 : pm0; u.pn = split ? pn1 : pn0; u.ko = split ? ko1 : 0; u.nt = split ? nt1 : ntf; u.ks = split ? s : -1;
#if defined(__HIP_DEVICE_COMPILE__)
        u.pm = __builtin_amdgcn_readfirstlane(u.pm); u.pn = __builtin_amdgcn_readfirstlane(u.pn); u.ko = __builtin_amdgcn_readfirstlane(u.ko); u.nt = __builtin_amdgcn_readfirstlane(u.nt); u.ks = __builtin_amdgcn_readfirstlane(u.ks);
#endif
        return true;
    }
    __device__ __forceinline__ void a_ready(const Unit&) const {}
    __device__ __forceinline__ void done(const Unit&) const {}
};
__device__ __forceinline__ unsigned cvt_pk_bf16(float lo, float hi) { unsigned r; asm volatile("v_cvt_pk_bf16_f32 %0, %1, %2" : "=v"(r) : "v"(lo), "v"(hi)); return r; }
typedef float f32x2 __attribute__((ext_vector_type(2)));
typedef unsigned u32x2 __attribute__((ext_vector_type(2)));
struct EpiStore {
    static constexpr bool PERM = true, AFTER_DRAIN = false;
    bf16_t* O; int ldc;
    __device__ __forceinline__ void operator()(f32x4 (&acc)[2][2][4][2], const Unit& u, int wr, int wc, int fr, int fq) const {
        const int row0 = u.pm * BM + wr * 64 + fr, col0 = u.pn * BM + wc * 32 + 8 * fq;
#pragma unroll
        for (int ai = 0; ai < 2; ++ai)
#pragma unroll
            for (int m = 0; m < 4; ++m) { bf16_t* rowp = O + (size_t)(row0 + ai * HALF + m * 16) * ldc + col0;
#pragma unroll
                for (int bj = 0; bj < 2; ++bj) { const f32x4 v0 = acc[ai][bj][m][0], v1 = acc[ai][bj][m][1];
                    u32x4 w; w.x = cvt_pk_bf16(v0[0], v0[1]); w.y = cvt_pk_bf16(v0[2], v0[3]); w.z = cvt_pk_bf16(v1[0], v1[1]); w.w = cvt_pk_bf16(v1[2], v1[3]);
                    *(u32x4*)(rowp + bj * HALF) = w; } }
    }
};
struct EpiQK {
    static constexpr bool PERM = true, AFTER_DRAIN = false;
    bf16_t* O; int ldc; int nqk_tiles; const float* qg; const float* kg; const float* rope_c; const float* rope_s; PG8_LAS float* xch;
    __device__ __forceinline__ void operator()(f32x4 (&acc)[2][2][4][2], const Unit& u, int wr, int wc, int fr, int fq) const {
        const int row0 = u.pm * BM + wr * 64 + fr, col0 = u.pn * BM + wc * 32 + 8 * fq;
        if (u.pn < nqk_tiles) {
#pragma unroll
            for (int ai = 0; ai < 2; ++ai)
#pragma unroll
                for (int m = 0; m < 4; ++m)
#pragma unroll
                    for (int bj = 0; bj < 2; ++bj) { const f32x4 a = acc[ai][bj][m][0], b = acc[ai][bj][m][1];
                        float ss = (a[0] * a[0] + a[1] * a[1]) + (a[2] * a[2] + a[3] * a[3]) + (b[0] * b[0] + b[1] * b[1]) + (b[2] * b[2] + b[3] * b[3]);
                        ss = sum_xor16_32(ss);
                        if (fq == 0) xch[((ai * HALF + wr * 64 + m * 16 + fr) * 2 + bj) * 4 + wc] = ss; }
            asm volatile("s_waitcnt lgkmcnt(0)" ::: "memory"); __builtin_amdgcn_s_barrier(); asm volatile("" ::: "memory");
            const int ah = wc >> 1, fb = 16 * (wc & 1) + 4 * fq;
            const float* gp = (u.pn < 8 ? qg : kg) + 64 * ah + fb;
            const f32x4 glo = *(const f32x4*)gp, ghi = *(const f32x4*)(gp + 32);
            const bool dorope = (rope_c != nullptr) && (u.pm < 128);
#pragma unroll
            for (int ai = 0; ai < 2; ++ai)
#pragma unroll
                for (int m = 0; m < 4; ++m) { const int rl = ai * HALF + wr * 64 + m * 16 + fr;
                    f32x4 cs = (f32x4){1.f, 1.f, 1.f, 1.f}, sn = (f32x4){0.f, 0.f, 0.f, 0.f};
                    if (dorope) { const int t = (u.pm * BM + rl) & 8191, pos = ah ? (t & 63) : (t >> 6); cs = *(const f32x4*)(rope_c + pos * 32 + fb); sn = *(const f32x4*)(rope_s + pos * 32 + fb); }
                    bf16_t* rowp = O + (size_t)(u.pm * BM + rl) * ldc + col0;
#pragma unroll
                    for (int bj = 0; bj < 2; ++bj) { const f32x4 pr = *(const PG8_LAS f32x4*)(xch + (rl * 2 + bj) * 4);
                        const float rs = __builtin_amdgcn_rsqf(((pr[0] + pr[1]) + (pr[2] + pr[3])) * (1.0f / 128.0f) + 1e-6f);
                        unsigned wq[4];
#pragma unroll
                        for (int n = 0; n < 2; ++n) { const f32x4 v = acc[ai][bj][m][n];
                            const float x1a = v[0] * rs * glo[2 * n], x2a = v[1] * rs * ghi[2 * n], x1b = v[2] * rs * glo[2 * n + 1], x2b = v[3] * rs * ghi[2 * n + 1];
                            wq[2 * n] = cvt_pk_bf16(x1a * cs[2 * n] - x2a * sn[2 * n], x2a * cs[2 * n] + x1a * sn[2 * n]);
                            wq[2 * n + 1] = cvt_pk_bf16(x1b * cs[2 * n + 1] - x2b * sn[2 * n + 1], x2b * cs[2 * n + 1] + x1b * sn[2 * n + 1]); }
                        *(u32x4*)(rowp + bj * HALF) = (u32x4){wq[0], wq[1], wq[2], wq[3]}; }
                    asm volatile("" ::: "memory"); }
            return;
        }
#pragma unroll
        for (int ai = 0; ai < 2; ++ai)
#pragma unroll
            for (int m = 0; m < 4; ++m) { bf16_t* rowp = O + (size_t)(row0 + ai * HALF + m * 16) * ldc + col0;
#pragma unroll
                for (int bj = 0; bj < 2; ++bj) { const f32x4 v0 = acc[ai][bj][m][0], v1 = acc[ai][bj][m][1];
                    u32x4 w; w.x = cvt_pk_bf16(v0[0], v0[1]); w.y = cvt_pk_bf16(v0[2], v0[3]); w.z = cvt_pk_bf16(v1[0], v1[1]); w.w = cvt_pk_bf16(v1[2], v1[3]);
                    *(u32x4*)(rowp + bj * HALF) = w; } }
    }
};
typedef _Float16 h16x4 __attribute__((ext_vector_type(4)));
__device__ __forceinline__ f32x4 h4_to_f4(unsigned a, unsigned b) { const u32x2 t = {a, b}; return __builtin_convertvector(__builtin_bit_cast(h16x4, t), f32x4); }
__device__ __forceinline__ u32x2 f4_to_h4(f32x4 v) { return __builtin_bit_cast(u32x2, __builtin_convertvector(v, h16x4)); }
template <bool BASE16, bool OUT16> struct EpiResidT {
    static constexpr bool PERM = true, AFTER_DRAIN = false;
    const void* base_lat; void* out_lat; float* part; const float* gate; int ld, gstride;
    __device__ __forceinline__ void operator()(f32x4 (&acc)[2][2][4][2], const Unit& u, int wr, int wc, int fr, int fq) const {
        const int rl = wr * 64 + fr, col0 = u.pn * BM + wc * 32 + 8 * fq;
        if (u.ks >= 0) {
            _Float16* ps = (_Float16*)part + ((size_t)u.ks * 1024 + (size_t)(u.pm - 128) * BM) * ld;
#pragma unroll
            for (int ai = 0; ai < 2; ++ai)
#pragma unroll
                for (int m = 0; m < 4; ++m)
#pragma unroll
                    for (int bj = 0; bj < 2; ++bj) { const u32x2 a = f4_to_h4(acc[ai][bj][m][0]), b = f4_to_h4(acc[ai][bj][m][1]);
                        *(u32x4*)(ps + (size_t)(rl + ai * HALF + m * 16) * ld + col0 + bj * HALF) = (u32x4){a.x, a.y, b.x, b.y}; }
            return;
        }
        const size_t roff = (size_t)u.pm * BM * ld;
        const float* gv = gate + (size_t)(u.pm >> 5) * gstride;
        f32x4 g[2][2];
#pragma unroll
        for (int bj = 0; bj < 2; ++bj)
#pragma unroll
            for (int n = 0; n < 2; ++n) g[bj][n] = *(const f32x4*)(gv + col0 + bj * HALF + 4 * n);
        if constexpr (BASE16) {
            const _Float16* bs = (const _Float16*)base_lat + roff; const unsigned vo = (unsigned)(rl * ld + col0) * 2u;
            u32x4 hb[2][2][4];
#pragma unroll
            for (int ai = 0; ai < 2; ++ai)
#pragma unroll
                for (int bj = 0; bj < 2; ++bj)
#pragma unroll
                    for (int m = 0; m < 4; ++m) hb[ai][bj][m] = *(const u32x4*)((const char*)(bs + (size_t)(ai * HALF + m * 16) * ld + bj * HALF) + vo);
#pragma unroll
            for (int ai = 0; ai < 2; ++ai)
#pragma unroll
                for (int bj = 0; bj < 2; ++bj)
#pragma unroll
                    for (int m = 0; m < 4; ++m) {
                        const f32x4 r0 = h4_to_f4(hb[ai][bj][m].x, hb[ai][bj][m].y) + g[bj][0] * acc[ai][bj][m][0], r1 = h4_to_f4(hb[ai][bj][m].z, hb[ai][bj][m].w) + g[bj][1] * acc[ai][bj][m][1];
                        const size_t eo = (size_t)(rl + ai * HALF + m * 16) * ld + col0 + bj * HALF;
                        if constexpr (OUT16) { const u32x2 a = f4_to_h4(r0), b = f4_to_h4(r1); *(u32x4*)((_Float16*)out_lat + roff + eo) = (u32x4){a.x, a.y, b.x, b.y}; }
                        else { float* op = (float*)out_lat + roff + eo; *(f32x4*)op = r0; *(f32x4*)(op + 4) = r1; } }
            return;
        }
#pragma unroll
        for (int ai = 0; ai < 2; ++ai) {
            if constexpr (BASE16) {
            } else {
                const float* bs = (const float*)base_lat + roff;
#pragma unroll
                for (int bj = 0; bj < 2; ++bj) {
                    f32x4 b[4][2];
#pragma unroll
                    for (int m = 0; m < 4; ++m)
#pragma unroll
                        for (int n = 0; n < 2; ++n) b[m][n] = *(const f32x4*)(bs + (size_t)(rl + ai * HALF + m * 16) * ld + col0 + bj * HALF + 4 * n);
#pragma unroll
                    for (int m = 0; m < 4; ++m) {
                        const f32x4 r0 = b[m][0] + g[bj][0] * acc[ai][bj][m][0], r1 = b[m][1] + g[bj][1] * acc[ai][bj][m][1];
                        const size_t eo = (size_t)(rl + ai * HALF + m * 16) * ld + col0 + bj * HALF;
                        if constexpr (OUT16) { const u32x2 a = f4_to_h4(r0), b2 = f4_to_h4(r1); *(u32x4*)((_Float16*)out_lat + roff + eo) = (u32x4){a.x, a.y, b2.x, b2.y}; }
                        else { float* op = (float*)out_lat + roff + eo; *(f32x4*)op = r0; *(f32x4*)(op + 4) = r1; } }
                    asm volatile("" ::: "memory"); }
            }
            asm volatile("" ::: "memory");
        }
    }
};
__device__ __forceinline__ float dpp_ror1(float v) { return __builtin_bit_cast(float, __builtin_amdgcn_update_dpp(0, __builtin_bit_cast(int, v), 0x121, 0xf, 0xf, false)); }
__device__ __forceinline__ float dpp_rol1(float v) { return __builtin_bit_cast(float, __builtin_amdgcn_update_dpp(0, __builtin_bit_cast(int, v), 0x12F, 0xf, 0xf, false)); }
__device__ __forceinline__ float gelu_tanh(float x) {
    const float t = x * (1.0f + 0.044715f * x * x);
    const float e = __builtin_amdgcn_exp2f(-2.302208198f * t);
    return x * __builtin_amdgcn_rcpf(1.0f + e);
}
struct EpiGlu {
    static constexpr bool PERM = true, AFTER_DRAIN = false;
    bf16_t* act; float* edge; const float* cw; const float* cb; PG8_LAS float* xb; int dff;
    __device__ __forceinline__ void operator()(f32x4 (&acc)[2][2][4][2], const Unit& u, int wr, int wc, int fr, int fq) const {
        const int cg = wc * 32 + 8 * fq, f0 = u.pn * 128 + cg;
        f32x4 w0[2], w1[2], w2[2], bb[2];
#pragma unroll
        for (int n = 0; n < 2; ++n) { w0[n] = *(const f32x4*)(cw + f0 + 4 * n); w1[n] = *(const f32x4*)(cw + dff + f0 + 4 * n); w2[n] = *(const f32x4*)(cw + 2 * dff + f0 + 4 * n); bb[n] = *(const f32x4*)(cb + f0 + 4 * n); }
#pragma unroll
        for (int ai = 0; ai < 2; ++ai) { const int b = 2 * ai + wr;
            if (fr == 0) {
#pragma unroll
                for (int n = 0; n < 2; ++n) *(PG8_LAS f32x4*)(xb + (b * 2 + 0) * 128 + cg + 4 * n) = acc[ai][0][0][n]; }
            if (fr == 15) {
#pragma unroll
                for (int n = 0; n < 2; ++n) *(PG8_LAS f32x4*)(xb + (b * 2 + 1) * 128 + cg + 4 * n) = acc[ai][0][3][n]; } }
        asm volatile("s_waitcnt lgkmcnt(0)" ::: "memory"); __builtin_amdgcn_s_barrier(); asm volatile("" ::: "memory");
#pragma unroll
        for (int ai = 0; ai < 2; ++ai) { const int b = 2 * ai + wr;
#pragma unroll
            for (int n = 0; n < 2; ++n) {
                const f32x4 ep = (b > 0) ? *(const PG8_LAS f32x4*)(xb + ((b - 1) * 2 + 1) * 128 + cg + 4 * n) : (f32x4){0.f, 0.f, 0.f, 0.f};
                const f32x4 en = (b < 3) ? *(const PG8_LAS f32x4*)(xb + ((b + 1) * 2 + 0) * 128 + cg + 4 * n) : (f32x4){0.f, 0.f, 0.f, 0.f};
                f32x4 R[4], L[4];
#pragma unroll
                for (int m = 0; m < 4; ++m)
#pragma unroll
                    for (int j = 0; j < 4; ++j) { R[m][j] = dpp_ror1(acc[ai][0][m][n][j]); L[m][j] = dpp_rol1(acc[ai][0][m][n][j]); }
#pragma unroll
                for (int m = 0; m < 4; ++m) {
                    const int rl = ai * HALF + wr * 64 + m * 16 + fr;
                    const f32x4 gp = (fr == 0) ? (m == 0 ? ep : R[m == 0 ? 0 : m - 1]) : R[m];
                    const f32x4 gn = (fr == 15) ? (m == 3 ? en : L[m == 3 ? 3 : m + 1]) : L[m];
                    const f32x4 g = acc[ai][0][m][n], uu = acc[ai][1][m][n];
                    const f32x4 gc = bb[n] + w0[n] * gp + w1[n] * g + w2[n] * gn;
                    if (rl == 0 || rl == 255) {
                        float* eb = edge + ((size_t)u.pm * 6 + (rl == 255 ? 3 : 0)) * dff + f0 + 4 * n;
                        *(f32x4*)eb = gc; *(f32x4*)(eb + dff) = uu; *(f32x4*)(eb + 2 * dff) = g;
                    } else {
                        u32x2 w; w.x = cvt_pk_bf16(gelu_tanh(gc[0]) * uu[0], gelu_tanh(gc[1]) * uu[1]); w.y = cvt_pk_bf16(gelu_tanh(gc[2]) * uu[2], gelu_tanh(gc[3]) * uu[3]);
                        *(u32x2*)(act + (size_t)(u.pm * BM + rl) * dff + f0 + 4 * n) = w;
                    }
                }
            }
        }
    }
};
template <class Epi, class Sched, bool ALIGN_EPI = false, bool SP2 = false>
__device__ __forceinline__ void gemm_phase(PG8_LAS unsigned char* lds, const Gemm g, const Sched& S, const Epi& E, int wave_id) {
    const int tid = opq(wave_id * 64 + lane_now()), wid = wave_id, lane = tid & 63, wr = wid >> 2, wc = wid & 3, fr = lane & 15, fq = lane >> 4;
    const int K = g.K;
    unsigned voffA[2], voffB[2];
#pragma unroll
    for (int i = 0; i < 2; ++i) { int R, C; stage_rc(tid * 16 + i * 8192, R, C); const int Rb = Epi::PERM ? ((R & ~31) + perm32(R & 31)) : R;
        voffA[i] = (unsigned)(R * K + C) * 2u; voffB[i] = (unsigned)(Rb * K + C) * 2u; }
    const size_t kstep = (size_t)(BK * 2);
    const size_t hstep = (size_t)HALF * K * 2;
    const size_t tstep = 2 * hstep;
    const unsigned ldsw = (unsigned)wid * 1024u;
    const int aoff = lds_byte(wr * 64 + fr, fq * 8), boff = lds_byte(wc * 32 + fr, fq * 8);
#define PG8_SA(b, h) (((b) * 2 + (h)) * HTB)
#define PG8_SB(b, h) ((4 + (b) * 2 + (h)) * HTB)
#define PG8_STAGE(bufoff, gbase, voff) do { _Pragma("unroll") for (int _i = 0; _i < 2; ++_i) \
        __builtin_amdgcn_global_load_lds((const unsigned*)((const char*)(gbase) + (voff)[_i]), (PG8_LAS unsigned*)(lds + (bufoff) + ldsw + _i * 8192), 16, 0, 0); } while (0)
#define PG8_LDA(dst, b, h) do { _Pragma("unroll") for (int m = 0; m < 4; ++m) _Pragma("unroll") for (int k = 0; k < 2; ++k) dst[m][k] = *(const PG8_LAS bf16x8*)(lds + PG8_SA(b, h) + aoff + m * 2048 + k * 1024); } while (0)
#define PG8_LDB(dst, b, h) do { _Pragma("unroll") for (int n = 0; n < 2; ++n) _Pragma("unroll") for (int k = 0; k < 2; ++k) dst[n][k] = *(const PG8_LAS bf16x8*)(lds + PG8_SB(b, h) + boff + n * 2048 + k * 1024); } while (0)
#define PG8_MMA(ai, bj, At, Bt) do { __builtin_amdgcn_s_setprio(1); _Pragma("unroll") for (int m = 0; m < 4; ++m) _Pragma("unroll") for (int n = 0; n < 2; ++n) _Pragma("unroll") for (int k = 0; k < 2; ++k) \
        acc[ai][bj][m][n] = __builtin_amdgcn_mfma_f32_16x16x32_bf16(Bt[n][k], At[m][k], acc[ai][bj][m][n], 0, 0, 0); __builtin_amdgcn_s_setprio(0); } while (0)
#define PG8_WAIT_V(n) asm volatile("s_waitcnt vmcnt(" #n ")" ::: "memory")
#define PG8_WAIT_L(n) asm volatile("s_waitcnt lgkmcnt(" #n ")" ::: "memory")
#define PG8_BAR __builtin_amdgcn_s_barrier()
#define PG8_SCHED __builtin_amdgcn_sched_barrier(0)
    Unit cur, nxt; int ui = 0;
    if (!S.next(0, cur)) return;
    f32x4 acc[2][2][4][2];
#pragma unroll
    for (int a = 0; a < 2; ++a)
#pragma unroll
        for (int b = 0; b < 2; ++b)
#pragma unroll
            for (int m = 0; m < 4; ++m)
#pragma unroll
                for (int n = 0; n < 2; ++n) acc[a][b][m][n] = (f32x4){0.f, 0.f, 0.f, 0.f};
    bf16x8 At[4][2], B0[2][2], B1[2][2];
    const char* cA = (const char*)g.A + (size_t)cur.pm * tstep + (size_t)cur.ko * 2; const char* cB = (const char*)g.Bt + (size_t)cur.pn * tstep + (size_t)cur.ko * 2;
    S.a_ready(cur);
    if constexpr (SP2) {
        PG8_STAGE(PG8_SB(0, 0), cB, voffB); PG8_STAGE(PG8_SB(0, 1), cB + hstep, voffB); PG8_STAGE(PG8_SA(0, 0), cA, voffA); PG8_STAGE(PG8_SA(0, 1), cA + hstep, voffA);
        if (wr == 1) PG8_BAR;
        PG8_WAIT_V(2); PG8_BAR;
        PG8_STAGE(PG8_SB(1, 0), cB + kstep, voffB); PG8_STAGE(PG8_SA(1, 0), cA + kstep, voffA); PG8_STAGE(PG8_SB(1, 1), cB + hstep + kstep, voffB);
        PG8_WAIT_V(6); PG8_BAR;
    } else {
        PG8_STAGE(PG8_SB(0, 0), cB, voffB); PG8_STAGE(PG8_SA(0, 0), cA, voffA); PG8_STAGE(PG8_SB(0, 1), cB + hstep, voffB); PG8_STAGE(PG8_SA(0, 1), cA + hstep, voffA);
        if (wr == 1) PG8_BAR;
        PG8_WAIT_V(4); PG8_BAR;
        PG8_STAGE(PG8_SB(1, 0), cB + kstep, voffB); PG8_STAGE(PG8_SA(1, 0), cA + kstep, voffA); PG8_STAGE(PG8_SB(1, 1), cB + hstep + kstep, voffB);
        PG8_WAIT_V(6); PG8_BAR;
    }
    for (;;) {
        const bool has_next = S.next(ui + 1, nxt);
        const char* nA = has_next ? (const char*)g.A + (size_t)nxt.pm * tstep + (size_t)nxt.ko * 2 : cA; const char* nB = has_next ? (const char*)g.Bt + (size_t)nxt.pn * tstep + (size_t)nxt.ko * 2 : cB;
        const int nt = cur.nt;
        for (int t = 0; t < nt; t += 2) {
            const bool last = (t == nt - 2);
            const char* a1 = cA + (size_t)(t + 1) * kstep;
            const char* a2 = last ? nA : cA + (size_t)(t + 2) * kstep; const char* b2 = last ? nB : cB + (size_t)(t + 2) * kstep;
            const char* a3 = a2 + kstep; const char* b3 = b2 + kstep;
            if (last && has_next) S.a_ready(nxt);
            if constexpr (SP2) {
            PG8_LDB(B0, 0, 0); PG8_LDB(B1, 0, 1); PG8_SCHED; PG8_LDA(At, 0, 0); PG8_STAGE(PG8_SA(1, 1), a1 + hstep, voffA);
            PG8_WAIT_V(8); PG8_WAIT_L(0); PG8_BAR; PG8_MMA(0, 0, At, B0); PG8_MMA(0, 1, At, B1); PG8_BAR; PG8_SCHED;
            PG8_LDA(At, 0, 1); PG8_STAGE(PG8_SB(0, 0), b2, voffB); PG8_STAGE(PG8_SB(0, 1), b2 + hstep, voffB); PG8_STAGE(PG8_SA(0, 0), a2, voffA);
            PG8_WAIT_V(8); PG8_WAIT_L(0); PG8_BAR; PG8_MMA(1, 0, At, B0); PG8_MMA(1, 1, At, B1); PG8_BAR; PG8_SCHED;
            PG8_LDB(B0, 1, 0); PG8_LDB(B1, 1, 1); PG8_SCHED; PG8_LDA(At, 1, 0); PG8_STAGE(PG8_SA(0, 1), a2 + hstep, voffA);
            PG8_WAIT_V(8); PG8_WAIT_L(0); PG8_BAR; PG8_MMA(0, 0, At, B0); PG8_MMA(0, 1, At, B1); PG8_BAR; PG8_SCHED;
            PG8_LDA(At, 1, 1); PG8_STAGE(PG8_SB(1, 0), b3, voffB); PG8_STAGE(PG8_SB(1, 1), b3 + hstep, voffB); PG8_STAGE(PG8_SA(1, 0), a3, voffA);
            PG8_WAIT_V(8); PG8_WAIT_L(0); PG8_BAR; PG8_MMA(1, 0, At, B0); PG8_MMA(1, 1, At, B1); PG8_BAR; PG8_SCHED;
            } else {
            PG8_LDB(B0, 0, 0); PG8_SCHED; PG8_LDA(At, 0, 0); PG8_STAGE(PG8_SA(1, 1), a1 + hstep, voffA);
            PG8_WAIT_L(8); PG8_BAR; PG8_WAIT_L(0); PG8_MMA(0, 0, At, B0); PG8_BAR; PG8_SCHED;
            PG8_LDB(B1, 0, 1); PG8_STAGE(PG8_SB(0, 0), b2, voffB);
            PG8_BAR; PG8_WAIT_L(0); PG8_MMA(0, 1, At, B1); PG8_BAR;
            PG8_LDA(At, 0, 1); PG8_STAGE(PG8_SA(0, 0), a2, voffA);
            PG8_BAR; PG8_WAIT_L(0); PG8_MMA(1, 0, At, B0); PG8_BAR; PG8_SCHED;
            PG8_STAGE(PG8_SB(0, 1), b2 + hstep, voffB);
            PG8_WAIT_V(6); PG8_BAR; PG8_MMA(1, 1, At, B1); PG8_BAR;
            PG8_LDB(B0, 1, 0); PG8_SCHED; PG8_LDA(At, 1, 0); PG8_STAGE(PG8_SA(0, 1), a2 + hstep, voffA);
            PG8_WAIT_L(8); PG8_BAR; PG8_WAIT_L(0); PG8_MMA(0, 0, At, B0); PG8_BAR; PG8_SCHED;
            PG8_LDB(B1, 1, 1); PG8_STAGE(PG8_SB(1, 0), b3, voffB);
            PG8_BAR; PG8_WAIT_L(0); PG8_MMA(0, 1, At, B1); PG8_BAR;
            PG8_LDA(At, 1, 1); PG8_STAGE(PG8_SA(1, 0), a3, voffA);
            PG8_BAR; PG8_WAIT_L(0); PG8_MMA(1, 0, At, B0); PG8_BAR; PG8_SCHED;
            PG8_STAGE(PG8_SB(1, 1), b3 + hstep, voffB);
            PG8_WAIT_V(6); PG8_BAR; PG8_MMA(1, 1, At, B1); PG8_BAR;
            }
        }
        if constexpr (ALIGN_EPI) { if (wr == 0) PG8_BAR; }
        if constexpr (!Epi::AFTER_DRAIN) { E(acc, cur, wr, wc, fr, fq); S.done(cur); }
        if (!has_next) break;
#pragma unroll
        for (int a = 0; a < 2; ++a)
#pragma unroll
            for (int b = 0; b < 2; ++b)
#pragma unroll
                for (int m = 0; m < 4; ++m)
#pragma unroll
                    for (int n = 0; n < 2; ++n) acc[a][b][m][n] = (f32x4){0.f, 0.f, 0.f, 0.f};
        cur = nxt; cA = nA; cB = nB; ++ui;
        if constexpr (ALIGN_EPI) { if (wr == 1) PG8_BAR; }
    }
    PG8_WAIT_V(0);
    if constexpr (!ALIGN_EPI) { if (wr == 0) PG8_BAR; }
    PG8_BAR;
    if constexpr (Epi::AFTER_DRAIN) { E.fused(acc, cur, wr, wc, fr, fq, lds, wid, lane); S.done(cur); }
#undef PG8_SA
#undef PG8_SB
#undef PG8_STAGE
#undef PG8_LDA
#undef PG8_LDB
#undef PG8_MMA
#undef PG8_WAIT_V
#undef PG8_WAIT_L
#undef PG8_BAR
#undef PG8_SCHED
}
}
#ifndef PG8_SP2
#define PG8_SP2 true
#endif
constexpr int NWAVES = 8;
constexpr int DM = 2048, NBATCH = 4, SEQ = 8192, CTXL = 256, GRIDW = 64;
constexpr int MLAT = NBATCH * SEQ, MCTX = NBATCH * CTXL, MT = MLAT + MCTX;
constexpr int DFF = 5632, NMOD = 6 * DM, HD = 128, NH = 16;
constexpr int ML_W = 6160;
constexpr float NORM_EPS = 1e-6f;
constexpr float ATT_SCALE = 0.088388347648318440f;

enum { I_X = 0, I_C, I_CTX, I_CCTX, I_ADAW, I_ADAB, I_N1G, I_N2G, I_FWIN, I_FCW, I_FCB, I_FWOUT, I_NAQKV, I_NAQG, I_NAKG, I_NARB, I_NAWO, I_SWQKV, I_SWQG, I_SWKG, I_SWSINK, I_SWWO,
       I_MLWIN, I_MLGB, I_MLHG, I_MLWO, I_GQQKV, I_GQQG, I_GQKG, I_GQWO, N_IN };

constexpr size_t MiB = 1u << 20;
constexpr size_t WS_CTL = 0, CTL_ZERO_BYTES = 1 * MiB;
constexpr size_t WS_ROPE = 1 * MiB;
constexpr size_t WS_MOD = 2 * MiB;
constexpr size_t WS_MODP = 3 * MiB;
constexpr size_t WS_XC = 12 * MiB;
constexpr size_t WS_GATES = 20 * MiB;
constexpr size_t WS_EDGE = 24 * MiB;
constexpr size_t WS_WQKV = 48 * MiB;
constexpr size_t WS_WO = WS_WQKV + 70 * MiB;
constexpr size_t WS_WIN = WS_WO + 32 * MiB;
constexpr size_t WS_WOUT = WS_WIN + 176 * MiB;
constexpr size_t WS_HX = 416 * MiB;
constexpr size_t WS_QKV = WS_HX + 132 * MiB;
constexpr size_t WS_AO = WS_QKV + 396 * MiB;
constexpr size_t WS_HB = WS_AO + 132 * MiB;
constexpr size_t WS_PART = WS_HB + 132 * MiB;
constexpr size_t WS_END = WS_PART + 64 * MiB;
static_assert(WS_WOUT + 88 * MiB <= WS_HX, "weights fit");
__host__ __device__ constexpr int nqkv_of(int L) { return L == 0 ? 6144 : (L == 1 ? 2560 : (L == 2 ? 6144 : 3072)); }
__host__ __device__ constexpr size_t wqkv_off(int L) { return (L == 0 ? 0 : (L == 1 ? 24 : (L == 2 ? 34 : 58))) * MiB; }

constexpr int CW_TMO = 0, CW_CODE = 1;
constexpr int CW_CHK = 16;
constexpr int CW_BAR = 4096;

constexpr int RING_OFF = 0, RING_BYTES = 131072;
constexpr int XB_OFF = RING_BYTES;
constexpr int LDSCTL_OFF = XB_OFF + 4096, MISC_OFF = LDSCTL_OFF + 320;
#ifndef QKF_MASK
#define QKF_MASK 0x0
#endif
constexpr int QKX_OFF = 136192;
constexpr int LDS_BYTES = 147456;
static_assert(MISC_OFF + 128 <= LDS_BYTES, "LDS map");

#define GAS __attribute__((address_space(1)))
#define LAS __attribute__((address_space(3)))
typedef unsigned short bf16;
typedef unsigned v4u __attribute__((ext_vector_type(4)));
typedef unsigned v2u __attribute__((ext_vector_type(2)));
typedef float f32x4 __attribute__((ext_vector_type(4)));
typedef float f32x16 __attribute__((ext_vector_type(16)));
typedef short bf16x8 __attribute__((ext_vector_type(8)));
typedef short s16x4 __attribute__((ext_vector_type(4)));
typedef GAS unsigned gu32;
#define RLX_AGENT __ATOMIC_RELAXED, __HIP_MEMORY_SCOPE_AGENT
#define LDS_WAIT() asm volatile("s_waitcnt lgkmcnt(0)" ::: "memory")
#define VM_WAIT() asm volatile("s_waitcnt vmcnt(0)" ::: "memory")
__device__ __forceinline__ unsigned f2bf(float f) { unsigned u = __builtin_bit_cast(unsigned, f); return (u + 0x7fffu + ((u >> 16) & 1u)) >> 16; }
__device__ __forceinline__ unsigned pk2(float lo, float hi) { unsigned r; asm("v_cvt_pk_bf16_f32 %0, %1, %2" : "=v"(r) : "v"(lo), "v"(hi)); return r; }
__device__ __forceinline__ float bf_lo(unsigned w) { return __builtin_bit_cast(float, w << 16); }
__device__ __forceinline__ float bf_hi(unsigned w) { return __builtin_bit_cast(float, w & 0xffff0000u); }
__device__ __forceinline__ float bf2f(bf16 b) { return __builtin_bit_cast(float, (unsigned)b << 16); }
#define XB_TMO      128
#define XB_XCNT(j)  (256  + 64 * (j))
#define XB_XSUB(j)  (1280 + 64 * (j))
#define XB_XGEN(j)  (2304 + 64 * (j))
#define XB_TOP      3328
#define XB_TOPGEN   3392
#define XCD_BAR_WORDS 3456
#define XB_SPIN_CAP (1u << 18)

__device__ __forceinline__ unsigned xb_ld(unsigned* p)              { return __hip_atomic_load(p, __ATOMIC_RELAXED, __HIP_MEMORY_SCOPE_AGENT); }
__device__ __forceinline__ unsigned xb_add(unsigned* p, unsigned v) { return __hip_atomic_fetch_add(p, v, __ATOMIC_RELAXED, __HIP_MEMORY_SCOPE_AGENT); }
__device__ __forceinline__ unsigned xb_xcc_id() { return (unsigned)__builtin_amdgcn_s_getreg((3 << 11) | 20) & 0xFu; }
#define XB_SPIN(cond, bar) do { unsigned _sp = 0; while (cond) { __builtin_amdgcn_s_sleep(1); \
    if ((++_sp & 255u) == 0u) { if (xb_ld(&(bar)[XB_TMO])) break; if (_sp > XB_SPIN_CAP) { atomicAdd(&(bar)[XB_TMO], 1u); break; } } } } while (0)

struct XcdBarrier {
    unsigned* bar; unsigned x; unsigned w0;
    volatile LAS unsigned* st;
};

__device__ __forceinline__ XcdBarrier xcd_barrier_post(unsigned* bar, volatile LAS unsigned* st) {
    XcdBarrier b; b.bar = bar; b.x = xb_xcc_id(); b.st = st; b.w0 = (__builtin_amdgcn_readfirstlane((int)threadIdx.x >> 6) == 0) ? 1u : 0u;
    if (threadIdx.x == 0) (void)xb_add(&bar[XB_XCNT(b.x)], 1u);
    return b;
}
__device__ __forceinline__ void xcd_barrier_complete(unsigned* bar, unsigned x, unsigned& nloc, unsigned& nx) {
    const unsigned G = gridDim.x * gridDim.y * gridDim.z;
    unsigned sum, cnt, mine, sp = 0u;
    for (;;) {
        sum = 0u; cnt = 0u; mine = 0u;
#pragma unroll
        for (unsigned j = 0; j < 16; ++j) { const unsigned c = xb_ld(&bar[XB_XCNT(j)]); sum += c; cnt += (c > 0u) ? 1u : 0u; mine = (j == x) ? c : mine; }
        if (sum == G) break;
        __builtin_amdgcn_s_sleep(1);
        if ((++sp & 255u) == 0u) { if (xb_ld(&bar[XB_TMO])) break; if (sp > XB_SPIN_CAP) { atomicAdd(&bar[XB_TMO], 1u); break; } }
    }
    nloc = mine > 0u ? mine : 1u; nx = cnt > 0u ? cnt : 1u;
}

__device__ __forceinline__ void xcd_barrier(const XcdBarrier& b) {
    asm volatile("s_waitcnt vmcnt(0)" ::: "memory");
    __syncthreads();
    if (b.w0 != 0u && lane_now() == 0) {
        unsigned* bar = b.bar;
        __builtin_amdgcn_s_waitcnt(0);
        unsigned nloc = b.st[0], nx = b.st[1];
        if (nloc == 0u) { xcd_barrier_complete(bar, b.x, nloc, nx); b.st[0] = nloc; b.st[1] = nx; }
        const unsigned old = xb_add(&bar[XB_XSUB(b.x)], 1u);
        const unsigned gen = old / nloc;
        if (old + 1u == (gen + 1u) * nloc) {
            __builtin_amdgcn_fence(__ATOMIC_RELEASE, "agent");
            asm volatile("s_waitcnt vmcnt(0)" ::: "memory");
            const unsigned og = xb_add(&bar[XB_TOP], 1u);
            const unsigned tg = og / nx;
            if (og + 1u == (tg + 1u) * nx) xb_add(&bar[XB_TOPGEN], 1u);
            else XB_SPIN(xb_ld(&bar[XB_TOPGEN]) == tg, bar);
            __builtin_amdgcn_fence(__ATOMIC_ACQUIRE, "agent");
            xb_add(&bar[XB_XGEN(b.x)], 1u);
            asm volatile("s_waitcnt vmcnt(0)" ::: "memory");
        } else {
            XB_SPIN(xb_ld(&bar[XB_XGEN(b.x)]) == gen, bar);
            __builtin_amdgcn_fence(__ATOMIC_ACQUIRE, "agent");
            asm volatile("s_waitcnt vmcnt(0)" ::: "memory");
        }
    }
    __syncthreads();
}

struct Args { const float* in[N_IN]; float* out; unsigned char* ws; int ph_lo, ph_hi; };
struct Frame {
    LAS unsigned char* lds; volatile LAS unsigned* MISC; gu32* ctl;
    int wave, vcu, G;
    __device__ __forceinline__ int wv() const { return (int)opq_u((unsigned)wave); }
    __device__ __forceinline__ int vc() const { return (int)opq_u((unsigned)vcu); }
    int bx;
    __device__ __forceinline__ int bx_() const { return (int)opq_u((unsigned)bx); }
    __device__ __forceinline__ int ng() const { return (int)opq_u((unsigned)G); }
    __device__ __forceinline__ int lane_id() const { return lane_now(); }
    __device__ __forceinline__ int tid_() const { return wv() * 64 + lane_now(); }
    __device__ __forceinline__ LAS unsigned char* ldsp() const { return (LAS unsigned char*)(uintptr_t)opq_u((unsigned)(uintptr_t)lds); }
};
__device__ __forceinline__ float fast_exp(float x) { return __builtin_amdgcn_exp2f(x * 1.4426950408889634f); }

__device__ __forceinline__ void transpose_item(const float* W, int ldw, int K, bf16* WT, int dst_row0, int k0, int n0, LAS float* scr, int lane, int dstep = 1) {
#pragma unroll 8
    for (int i = 0; i < 32; ++i) { const int kk = 2 * i + (lane >> 5); scr[kk * 33 + (lane & 31)] = W[(size_t)(k0 + kk) * ldw + n0 + (lane & 31)]; }
    LDS_WAIT(); asm volatile("" ::: "memory");
    const int c = lane & 7;
#pragma unroll
    for (int j = 0; j < 4; ++j) { const int n = (lane >> 3) + 8 * j; const LAS float* s = scr + (8 * c) * 33 + n;
        v4u o; o.x = pk2(s[0 * 33], s[1 * 33]); o.y = pk2(s[2 * 33], s[3 * 33]); o.z = pk2(s[4 * 33], s[5 * 33]); o.w = pk2(s[6 * 33], s[7 * 33]);
        *(GAS v4u*)(WT + (size_t)(dst_row0 + n * dstep) * K + k0 + 8 * c) = o; }
    LDS_WAIT(); asm volatile("" ::: "memory");
}
#ifndef PRO_ALL
#define PRO_ALL 0
#endif
#ifndef TAILFILL
#define TAILFILL 1
#endif
#ifndef CONV_NT
#define CONV_NT 0
#endif
#ifndef TAIL_OWN3
#define TAIL_OWN3 1
#endif
#ifndef TAIL1_PCT
#define TAIL1_PCT 55
#endif
#ifndef TAIL3_PCT
#define TAIL3_PCT 20
#endif
static_assert(QKF_MASK == 0, "the 64 x 64 conversion items do not carry the q/k rope-pair row permutation of the fused q/k-norm epilogue");
__host__ __device__ constexpr int conv_items(int L) { return nqkv_of(L) / 2 + 1024 + 5632 + 2816; }
template <int L> __device__ __forceinline__ void conv_decode(unsigned char* ws, int r, const float*& src, int& ldw, bf16*& dst, int& K) {
    constexpr int N = nqkv_of(L);
    if (r < N / 2) {
        const int nblk = N / 64, kb = r / nblk, nb = r % nblk;
        const float* W = ldarg(L == 0 ? I_NAQKV : (L == 1 ? I_SWQKV : (L == 2 ? I_MLWIN : I_GQQKV)));
        ldw = L == 2 ? ML_W : N; K = DM; src = W + (size_t)(kb * 64) * ldw + nb * 64; dst = (bf16*)(ws + WS_WQKV + wqkv_off(L)) + (size_t)(nb * 64) * DM + kb * 64; return; }
    r -= N / 2;
    if (r < 1024) { const int kb = r >> 5, nb = r & 31;
        const float* W = ldarg(L == 0 ? I_NAWO : (L == 1 ? I_SWWO : (L == 2 ? I_MLWO : I_GQWO)));
        ldw = DM; K = DM; src = W + (size_t)(kb * 64) * DM + nb * 64; dst = (bf16*)(ws + WS_WO) + (size_t)L * DM * DM + (size_t)(nb * 64) * DM + kb * 64; return; }
    r -= 1024;
    if (r < 5632) { const int kb = r / 176, nb = r % 176, n0 = nb * 64;
        const int f0 = n0 < DFF ? n0 : n0 - DFF; const int drow = 256 * (f0 >> 7) + (f0 & 127) + (n0 < DFF ? 0 : 128);
        ldw = 2 * DFF; K = DM; src = ldarg(I_FWIN) + (size_t)L * DM * 2 * DFF + (size_t)(kb * 64) * (2 * DFF) + n0; dst = (bf16*)(ws + WS_WIN) + (size_t)L * 2 * DFF * DM + (size_t)drow * DM + kb * 64; return; }
    r -= 5632;
    { const int kb = r >> 5, nb = r & 31;
      ldw = DM; K = DFF; src = ldarg(I_FWOUT) + (size_t)L * DFF * DM + (size_t)(kb * 64) * DM + nb * 64; dst = (bf16*)(ws + WS_WOUT) + (size_t)L * DM * DFF + (size_t)(nb * 64) * DFF + kb * 64; }
}
constexpr int CONV_SCR = 64 * 65 * 4;
typedef float cf32x2 __attribute__((ext_vector_type(2)));
template <int L> __device__ __forceinline__ void convert_range(unsigned char* ws, int it0, int hi, int stride, LAS float* scr, int lane) {
    if (it0 >= hi) return;
    const float* src; int ldw; bf16* dst; int K;
    conv_decode<L>(ws, it0, src, ldw, dst, K);
    cf32x2 v[32];
#pragma unroll
    for (int i = 0; i < 32; ++i) v[i] = *(const GAS cf32x2*)(src + (size_t)(2 * i + (lane >> 5)) * ldw + 2 * (lane & 31));
    for (int it = it0; it < hi; it += stride) {
#pragma unroll
        for (int i = 0; i < 32; ++i) { LAS float* sp = scr + (2 * i + (lane >> 5)) * 65 + 2 * (lane & 31); sp[0] = v[i].x; sp[1] = v[i].y; }
        bf16* cdst = dst; const int cK = K;
        if (it + stride < hi) {
            conv_decode<L>(ws, it + stride, src, ldw, dst, K);
#pragma unroll
            for (int i = 0; i < 32; ++i) v[i] = *(const GAS cf32x2*)(src + (size_t)(2 * i + (lane >> 5)) * ldw + 2 * (lane & 31));
        }
        LDS_WAIT(); asm volatile("" ::: "memory");
        const int c = lane & 7;
#pragma unroll
        for (int j = 0; j < 8; ++j) { const int n = (lane >> 3) + 8 * j; const LAS float* s_ = scr + (8 * c) * 65 + n;
            v4u o; o.x = pk2(s_[0 * 65], s_[1 * 65]); o.y = pk2(s_[2 * 65], s_[3 * 65]); o.z = pk2(s_[4 * 65], s_[5 * 65]); o.w = pk2(s_[6 * 65], s_[7 * 65]);
            *(GAS v4u*)(cdst + (size_t)n * cK + 8 * c) = o; }
        LDS_WAIT(); asm volatile("" ::: "memory");
    }
}
template <int L> __device__ __forceinline__ void convert_tail(Frame& F, const Args& A, int nwg, int lo, int hi) {
    const int G = F.ng(), rem = nwg % G, vc = F.vc();
    if (rem != 0 && vc < rem) return;
    const int first = rem, nidle = G - first, lane_ = opq(F.lane_id());
    unsigned char* ws = opq_ptr(A.ws); LAS float* scr = (LAS float*)(F.ldsp() + F.wv() * CONV_SCR);
    convert_range<L>(ws, lo + (vc - first) * NWAVES + F.wv(), hi, nidle * NWAVES, scr, lane_);
}
__device__ __forceinline__ void prologue_phase(Frame& F, const Args& A) {
    const int tid_ = opq(F.tid_()); const int lane_ = tid_ & 63;
    unsigned char* ws = opq_ptr(A.ws);
    const int gw = F.vc() * NWAVES + F.wv(), NGW = F.ng() * NWAVES;
    LAS float* sil = (LAS float*)(F.ldsp() + 71680);
    for (int i = tid_; i < 5 * DM; i += NWAVES * 64) { const float v = (i < 4 * DM) ? ldarg(I_C)[i] : ldarg(I_CCTX)[i - 4 * DM]; sil[i] = v / (1.0f + __expf(-v)); }
    __syncthreads();
    if (gw < 4 * 48 * 8) {
        const int l = gw / 384, rem = gw % 384, cb = rem >> 3, ks = rem & 7;
        const float* W = ldarg(I_ADAW) + ((size_t)l * DM + ks * 256) * NMOD + cb * 256 + 4 * lane_;
        f32x4 acc[5];
#pragma unroll
        for (int r = 0; r < 5; ++r) acc[r] = (f32x4){0.f, 0.f, 0.f, 0.f};
#pragma unroll 8
        for (int k = 0; k < 256; ++k) { const f32x4 w = *(const GAS f32x4*)(W + (size_t)k * NMOD);
#pragma unroll
            for (int r = 0; r < 5; ++r) acc[r] += w * sil[r * DM + ks * 256 + k]; }
        float* P = (float*)(ws + WS_MODP) + ((size_t)(ks * 4 + l) * 5) * NMOD + cb * 256 + 4 * lane_;
#pragma unroll
        for (int r = 0; r < 5; ++r) *(GAS f32x4*)(P + (size_t)r * NMOD) = acc[r];
    }
    { const int gt = F.vc() * (NWAVES * 64) + tid_;
      if (gt < 4096) { const int pos = gt >> 5, f = gt & 31; const float inv = powf(10000.0f, -(float)f / 32.0f); const float ang = (float)pos * inv; float sn, cs; sincosf(ang, &sn, &cs);
          float* R = (float*)(ws + WS_ROPE); R[gt] = cs; R[4096 + gt] = sn; } }
    { const GAS f32x4* s = (const GAS f32x4*)ldarg(I_CTX); GAS f32x4* d = (GAS f32x4*)(ws + WS_XC);
      for (int i = F.vc() * (NWAVES * 64) + tid_; i < MCTX * DM / 4; i += F.ng() * NWAVES * 64) d[i] = s[i]; }
    __syncthreads();
    LAS float* scr = (LAS float*)(F.ldsp() + F.wv() * CONV_SCR);
    convert_range<0>(ws, gw, conv_items(0), NGW, scr, lane_);
    { constexpr int skip = (TAILFILL && !PRO_ALL) ? TAIL1_PCT + TAIL3_PCT : 0;
      if (skip < 100) { convert_range<1>(ws, conv_items(1) * skip / 100 + gw, conv_items(1), NGW, scr, lane_); convert_range<2>(ws, conv_items(2) * skip / 100 + gw, conv_items(2), NGW, scr, lane_);
                        if (!(TAILFILL && !PRO_ALL && TAIL_OWN3)) convert_range<3>(ws, conv_items(3) * skip / 100 + gw, conv_items(3), NGW, scr, lane_); } }
}
__device__ __forceinline__ void modred_phase(Frame& F, const Args& A) {
    const int tid_ = opq(F.tid_());
    const float* P = (const float*)(opq_ptr(A.ws) + WS_MODP); float* Mo = (float*)(opq_ptr(A.ws) + WS_MOD);
    for (int i = F.vc() * (NWAVES * 64) + tid_; i < 4 * 5 * NMOD / 4; i += F.ng() * NWAVES * 64) {
        const int l = i / (5 * NMOD / 4), col4 = i % (NMOD / 4);
        f32x4 s = *(const GAS f32x4*)(ldarg(I_ADAB) + (size_t)l * NMOD + 4 * col4);
#pragma unroll
        for (int ks = 0; ks < 8; ++ks) s += *(const GAS f32x4*)(P + (size_t)ks * 4 * 5 * NMOD + 4 * (size_t)i);
        *(GAS f32x4*)(Mo + 4 * (size_t)i) = s;
    }
}

__device__ __forceinline__ void norm_phase(Frame& F, const Args& A, const void* xlat, bool x16, const float* gain, const float* modl, int shift_chunk, bool with_ctx, bool do_gates, const float* pend_gate, bool down = false) {
    const int tid_ = opq(F.tid_());
    unsigned char* ws = opq_ptr(A.ws); bf16* HX = (bf16*)(ws + WS_HX);
    const int gw = F.vc() * NWAVES + F.wv(), NGW = F.ng() * NWAVES, lane_ = opq(F.lane_id());
    LAS float* Wg = (LAS float*)(F.ldsp());
    if (do_gates) {
        for (int idx = tid_; idx < DM * 4; idx += NWAVES * 64) { const int k = idx >> 2, part = idx & 3;
            const f32x4 w = *(const GAS f32x4*)(ldarg(I_MLWIN) + (size_t)k * ML_W + 6144 + 4 * part);
#pragma unroll
            for (int e = 0; e < 4; ++e) Wg[(4 * part + e) * DM + k] = w[e]; }
        __syncthreads();
    }
    for (int bi_ = 0; bi_ < (with_ctx ? 5 : 4); ++bi_) { const int bsel = down ? (with_ctx ? 4 : 3) - bi_ : bi_;
        const bool h16 = x16 && bsel < 4;
        const float* src = bsel < 4 ? (const float*)xlat + (size_t)bsel * SEQ * DM : (const float*)(ws + WS_XC);
        const _Float16* src16 = (const _Float16*)xlat + (size_t)bsel * SEQ * DM;
        const int nrows = bsel < 4 ? SEQ : MCTX, row0 = bsel < 4 ? bsel * SEQ : MLAT;
        const float* sh = modl + (size_t)bsel * NMOD + shift_chunk * DM; const float* sc = sh + DM;
        f32x4 a[8], bs[8];
#pragma unroll
        for (int j = 0; j < 8; ++j) { const int c = 4 * lane_ + 256 * j; const f32x4 g = *(const GAS f32x4*)(gain + c), s = *(const GAS f32x4*)(sc + c); a[j] = g * (1.0f + s); bs[j] = *(const GAS f32x4*)(sh + c); }
        f32x4 vn[8];
        v2u vh[8];
        if (!do_gates && gw < nrows) { const size_t r0_ = (size_t)(down ? nrows - 1 - gw : gw);
            if (h16) { const GAS v2u* xr = (const GAS v2u*)(src16 + r0_ * DM) + lane_;
#pragma unroll
                for (int j = 0; j < 8; ++j) vh[j] = xr[64 * j]; }
            else { const GAS f32x4* xr = (const GAS f32x4*)(src + r0_ * DM) + lane_;
#pragma unroll
                for (int j = 0; j < 8; ++j) vn[j] = xr[64 * j]; } }
        for (int i_ = gw; i_ < nrows; i_ += NGW) { const int i = down ? nrows - 1 - i_ : i_;
            const GAS f32x4* xr = (const GAS f32x4*)(src + (size_t)i * DM) + lane_;
            f32x4 v[8]; float ss = 0.f;
            if (do_gates) {
                if (h16) { const GAS v2u* xh = (const GAS v2u*)(src16 + (size_t)i * DM) + lane_;
#pragma unroll
                    for (int j = 0; j < 8; ++j) { const v2u t_ = xh[64 * j]; v[j] = pg8::h4_to_f4(t_.x, t_.y); } }
                else {
#pragma unroll
                    for (int j = 0; j < 8; ++j) v[j] = xr[64 * j]; }
            } else if (h16) {
#pragma unroll
                for (int j = 0; j < 8; ++j) v[j] = pg8::h4_to_f4(vh[j].x, vh[j].y);
                if (i_ + NGW < nrows) { const GAS v2u* xn = (const GAS v2u*)(src16 + (size_t)(down ? i - NGW : i + NGW) * DM) + lane_;
#pragma unroll
                    for (int j = 0; j < 8; ++j) vh[j] = xn[64 * j]; }
            } else {
#pragma unroll
                for (int j = 0; j < 8; ++j) v[j] = vn[j];
                if (i_ + NGW < nrows) { const GAS f32x4* xn = (const GAS f32x4*)(src + (size_t)(down ? i - NGW : i + NGW) * DM) + lane_;
#pragma unroll
                    for (int j = 0; j < 8; ++j) vn[j] = xn[64 * j]; }
            }
            if (bsel == 4 && pend_gate != nullptr) {
                const _Float16* pp = (const _Float16*)(ws + WS_PART) + (size_t)i * DM + 4 * lane_;
#pragma unroll
                for (int j = 0; j < 8; ++j) { v2u pr[8];
#pragma unroll
                    for (int ks = 0; ks < 8; ++ks) pr[ks] = *(const GAS v2u*)(pp + (size_t)ks * MCTX * DM + 256 * j);
                    f32x4 s = pg8::h4_to_f4(pr[0].x, pr[0].y);
#pragma unroll
                    for (int ks = 1; ks < 8; ++ks) s += pg8::h4_to_f4(pr[ks].x, pr[ks].y);
                    v[j] += *(const GAS f32x4*)(pend_gate + 4 * lane_ + 256 * j) * s;
                    ((GAS f32x4*)((float*)(ws + WS_XC) + (size_t)i * DM) + lane_)[64 * j] = v[j]; }
            }
#pragma unroll
            for (int j = 0; j < 8; ++j) ss += (v[j].x * v[j].x + v[j].y * v[j].y) + (v[j].z * v[j].z + v[j].w * v[j].w);
            const float rstd = 1.0f / sqrtf(wave_sum(ss) * (1.0f / DM) + NORM_EPS);
            GAS v2u* o8 = (GAS v2u*)(HX + (size_t)(row0 + i) * DM) + lane_;
#pragma unroll
            for (int j = 0; j < 8; ++j) { v[j] = (v[j] * rstd) * a[j] + bs[j]; v2u w; w.x = pk2(v[j].x, v[j].y); w.y = pk2(v[j].z, v[j].w); o8[64 * j] = w; }
            if (do_gates) {
                float mine = 0.f;
#pragma unroll
                for (int g = 0; g < 16; ++g) { float s = 0.f;
#pragma unroll
                    for (int j = 0; j < 8; ++j) { const f32x4 w = *(const LAS f32x4*)(Wg + g * DM + 4 * lane_ + 256 * j); s += (v[j].x * w.x + v[j].y * w.y) + (v[j].z * w.z + v[j].w * w.w); }
                    s = wave_sum(s); mine = (lane_ == g) ? s : mine; }
                if (lane_ < 16) ((float*)(ws + WS_GATES))[(size_t)(row0 + i) * 16 + lane_] = mine + ldarg(I_MLGB)[lane_];
            }
        }
    }
    if (do_gates) __syncthreads();
}

__device__ __forceinline__ void qkn_phase(Frame& F, const Args& A, int ld, int nh, const float* qg, const float* kg, bool rope, bool probe_scratch = false, int h0 = 0) {
    unsigned char* ws = opq_ptr(A.ws); bf16* QKV = (bf16*)(ws + WS_QKV); const float* RC = (const float*)(ws + WS_ROPE); const float* RS = RC + 4096;
    const int lane_ = opq(F.lane_id()); const int gw = F.vc() * NWAVES + F.wv(), NGW = F.ng() * NWAVES, i16 = lane_ & 15, sub = lane_ >> 4;
    const int nhe = nh - h0, nitems = MT * nhe;
    const f32x4 gq0 = *(const GAS f32x4*)(qg + 8 * i16), gq1 = *(const GAS f32x4*)(qg + 8 * i16 + 4), gk0 = *(const GAS f32x4*)(kg + 8 * i16), gk1 = *(const GAS f32x4*)(kg + 8 * i16 + 4);
    for (int p_ = gw; p_ * 16 < nitems; p_ += NGW) { const int p = nitems / 16 - 1 - p_;
        GAS v4u* ptr[4]; v4u raw[4]; int rowv[4], headv[4];
#pragma unroll
        for (int k = 0; k < 4; ++k) { const int item = p * 16 + k * 4 + sub; rowv[k] = item / nhe; headv[k] = h0 + item - rowv[k] * nhe;
            ptr[k] = (GAS v4u*)(QKV + (size_t)rowv[k] * ld + headv[k] * HD + 8 * i16); raw[k] = *ptr[k]; }
#pragma unroll
        for (int k = 0; k < 4; ++k) {
            const int row = rowv[k], head = headv[k];
            float x[8] = {bf_lo(raw[k].x), bf_hi(raw[k].x), bf_lo(raw[k].y), bf_hi(raw[k].y), bf_lo(raw[k].z), bf_hi(raw[k].z), bf_lo(raw[k].w), bf_hi(raw[k].w)};
            float ss = 0.f;
#pragma unroll
            for (int e = 0; e < 8; ++e) ss += x[e] * x[e];
            const float rstd = 1.0f / sqrtf(sum16(ss) * (1.0f / HD) + NORM_EPS);
            const f32x4 g0 = head < NH ? gq0 : gk0, g1 = head < NH ? gq1 : gk1;
#pragma unroll
            for (int e = 0; e < 8; ++e) x[e] = x[e] * rstd * (e < 4 ? g0[e] : g1[e - 4]);
            const bool dorope = rope && row < MLAT;
            float xp[8];
#pragma unroll
            for (int e = 0; e < 8; ++e) xp[e] = xor4_in16(x[e], i16);
            if (dorope) {
                const int t = row & (SEQ - 1), pos = (i16 >> 3) ? (t & (GRIDW - 1)) : (t >> 6), f0 = 8 * (i16 & 3);
                const f32x4 c0 = *(const GAS f32x4*)(RC + pos * 32 + f0), c1 = *(const GAS f32x4*)(RC + pos * 32 + f0 + 4), s0 = *(const GAS f32x4*)(RS + pos * 32 + f0), s1 = *(const GAS f32x4*)(RS + pos * 32 + f0 + 4);
                const float sg = (i16 & 4) ? 1.0f : -1.0f;
#pragma unroll
                for (int e = 0; e < 8; ++e) { const float c = e < 4 ? c0[e] : c1[e - 4], sn = e < 4 ? s0[e] : s1[e - 4]; x[e] = x[e] * c + sg * xp[e] * sn; }
            }
            v4u o; o.x = pk2(x[0], x[1]); o.y = pk2(x[2], x[3]); o.z = pk2(x[4], x[5]); o.w = pk2(x[6], x[7]);
            if (probe_scratch) *(GAS v4u*)((bf16*)(ws + WS_AO) + (size_t)row * (nh * HD) + head * HD + 8 * i16) = o; else *ptr[k] = o;
        }
    }
}

__device__ __forceinline__ void fix_phase(Frame& F, const Args& A, int L, int npanels) {
    const int tid_ = opq(F.tid_());
    unsigned char* ws = opq_ptr(A.ws); bf16* ACT = (bf16*)(ws + WS_QKV); const float* E = (const float*)(ws + WS_EDGE); const float* cw = ldarg(I_FCW) + (size_t)L * 3 * DFF;
    const int ntask = npanels * 2 * (DFF / 4);
    for (int i = F.vc() * (NWAVES * 64) + tid_; i < ntask; i += F.ng() * NWAVES * 64) {
        const int f = 4 * (i % (DFF / 4)), pe = i / (DFF / 4), pm = pe >> 1, e = pe & 1;
        const float* eb = E + ((size_t)pm * 6 + 3 * e) * DFF + f;
        f32x4 gc = *(const GAS f32x4*)eb; const f32x4 uu = *(const GAS f32x4*)(eb + DFF);
        const bool has = pm < 128 && (e ? (pm & 31) != 31 : (pm & 31) != 0);
        if (has) { const f32x4 w = *(const GAS f32x4*)(cw + (e ? 2 * DFF : 0) + f); const f32x4 gnb = *(const GAS f32x4*)(E + ((size_t)(e ? pm + 1 : pm - 1) * 6 + (e ? 2 : 5)) * DFF + f); gc += w * gnb; }
        v2u o; o.x = pk2(pg8::gelu_tanh(gc.x) * uu.x, pg8::gelu_tanh(gc.y) * uu.y); o.y = pk2(pg8::gelu_tanh(gc.z) * uu.z, pg8::gelu_tanh(gc.w) * uu.w);
        *(GAS v2u*)(ACT + (size_t)(pm * 256 + (e ? 255 : 0)) * DFF + f) = o;
    }
}

__device__ __forceinline__ void mlro_phase(Frame& F, const Args& A) {
    unsigned char* ws = opq_ptr(A.ws); const bf16* HF = (const bf16*)(ws + WS_AO); const bf16* HBk = (const bf16*)(ws + WS_HB); const bf16* QKV = (const bf16*)(ws + WS_QKV); bf16* HX = (bf16*)(ws + WS_HX);
    const int lane_ = opq(F.lane_id()); const int gw = F.vc() * NWAVES + F.wv(), NGW = F.ng() * NWAVES, c0 = lane_ * 8;
    const float* hg = ldarg(I_MLHG) + c0;
    for (int row = gw; row < MT; row += NGW) {
        const GAS v4u* pf = (const GAS v4u*)(HF + (size_t)row * DM + c0); const GAS v4u* pb = (const GAS v4u*)(HBk + (size_t)row * DM + c0); const GAS v4u* po = (const GAS v4u*)(QKV + (size_t)row * 6144 + 4096 + c0);
        float h[32]; v4u ov[4];
#pragma unroll
        for (int q = 0; q < 4; ++q) { const v4u a = pf[64 * q], b = pb[64 * q]; ov[q] = po[64 * q];
            h[8 * q + 0] = bf_lo(a.x) + bf_lo(b.x); h[8 * q + 1] = bf_hi(a.x) + bf_hi(b.x); h[8 * q + 2] = bf_lo(a.y) + bf_lo(b.y); h[8 * q + 3] = bf_hi(a.y) + bf_hi(b.y);
            h[8 * q + 4] = bf_lo(a.z) + bf_lo(b.z); h[8 * q + 5] = bf_hi(a.z) + bf_hi(b.z); h[8 * q + 6] = bf_lo(a.w) + bf_lo(b.w); h[8 * q + 7] = bf_hi(a.w) + bf_hi(b.w); }
        GAS v4u* px = (GAS v4u*)(HX + (size_t)row * DM + c0);
#pragma unroll
        for (int q = 0; q < 4; ++q) { float ss = 0.f;
#pragma unroll
            for (int e = 0; e < 8; ++e) ss += h[8 * q + e] * h[8 * q + e];
            const float rstd = 1.0f / sqrtf(wave_sum(ss) * (1.0f / 512.0f) + NORM_EPS);
            const f32x4 g0 = *(const GAS f32x4*)(hg + 512 * q), g1 = *(const GAS f32x4*)(hg + 512 * q + 4);
            const float o[8] = {bf_lo(ov[q].x), bf_hi(ov[q].x), bf_lo(ov[q].y), bf_hi(ov[q].y), bf_lo(ov[q].z), bf_hi(ov[q].z), bf_lo(ov[q].w), bf_hi(ov[q].w)};
            float r[8];
#pragma unroll
            for (int e = 0; e < 8; ++e) { const float sg = 1.0f / (1.0f + __expf(-o[e])); r[e] = sg * (h[8 * q + e] * rstd * (e < 4 ? g0[e] : g1[e - 4])); }
            v4u w; w.x = pk2(r[0], r[1]); w.y = pk2(r[2], r[3]); w.z = pk2(r[4], r[5]); w.w = pk2(r[6], r[7]); px[64 * q] = w; }
    }
}

#ifndef TILE_SKIP
#define TILE_SKIP 1
#endif
#ifndef PV_TWO
#define PV_TWO 1
#endif
namespace att {
constexpr int QBLK = 32, KVBLK = 64, D = 128;
constexpr float SCALE = ATT_SCALE, THR = 8.f;
constexpr int SHM_V = KVBLK * D * 2, SHM_K = KVBLK * D * 2;
constexpr int NB = 4, BUFB = SHM_V + SHM_K;
constexpr int OFF_WS = NB * BUFB, OFF_TAB = 139264, ATT_LDS = OFF_TAB + 15 * 128 * 4;
static_assert(OFF_WS + NWAVES * 256 <= 135168 && ATT_LDS <= 147456, "attention LDS map");
#define KSWZ(row, colB) ((row) * 256 + ((colB) ^ (((row) & 7) << 4)))
#define SBAR() __builtin_amdgcn_sched_barrier(0)
__device__ __forceinline__ int crow(int r, int hi) { return (r & 3) + 8 * (r >> 2) + 4 * hi; }
__device__ __forceinline__ unsigned cvtpk(float lo, float hi) { unsigned r; asm volatile("v_cvt_pk_bf16_f32 %0, %1, %2" : "=v"(r) : "v"(lo), "v"(hi)); return r; }
struct MaskInfo { int a, b, c, d; };
template <int MODE> __device__ __forceinline__ void apply_mask(f32x16& p0, f32x16& p1, int widx, int lo, int nwin, const MaskInfo& mi, int hi, const LAS float* tab) {
    if (MODE == 3 || widx < 0) return;
    if (MODE == 1) {
        const int d0 = 64 * (lo + widx) - mi.a + 128;
#pragma unroll
        for (int r = 0; r < 16; ++r) { const int kc = crow(r, hi);
            p0[r] = ((unsigned)(d0 + kc) <= 256u) ? p0[r] : -1e30f; p1[r] = ((unsigned)(d0 + kc + 32) <= 256u) ? p1[r] : -1e30f; }
    }
    if (MODE == 0) {
        const int kr = lo + widx;
        const bool rowok = widx < nwin && (unsigned)(kr - mi.d) < 8u;
        if (!rowok) {
#pragma unroll
            for (int r = 0; r < 16; ++r) { p0[r] = -1e30f; p1[r] = -1e30f; }
        } else {
            const LAS float* tb = tab + (kr - mi.a + 7) * 128 + 63 - mi.b;
#pragma unroll
            for (int r4 = 0; r4 < 16; r4 += 8) {
                float b0[8], b1[8];
#pragma unroll
                for (int i = 0; i < 8; ++i) { const int kc = crow(r4 + i, hi); b0[i] = tb[kc]; b1[i] = tb[kc + 32]; }
                asm volatile("s_waitcnt lgkmcnt(0)" ::: "memory");
#pragma unroll
                for (int i = 0; i < 8; ++i) { const int r = r4 + i, kc = crow(r, hi);
                    p0[r] = ((unsigned)(kc - mi.c) < 16u) ? p0[r] + b0[i] : -1e30f; p1[r] = ((unsigned)(kc + 32 - mi.c) < 16u) ? p1[r] + b1[i] : -1e30f; }
                SBAR();
            }
        }
    }
}
__device__ __forceinline__ void partialSM(f32x16& p0, f32x16& p1, float& m_reg, float& mn, float& alpha) {
    constexpr float C = SCALE * 1.4426950408889634f;
    float pmax = p0[0];
#pragma unroll
    for (int r = 1; r < 16; ++r) pmax = fmaxf(pmax, p0[r]);
#pragma unroll
    for (int r = 0; r < 16; ++r) pmax = fmaxf(pmax, p1[r]);
    { auto rr = __builtin_amdgcn_permlane32_swap(__float_as_uint(pmax), __float_as_uint(pmax), false, false);
      pmax = fmaxf(__uint_as_float(rr[0]), __uint_as_float(rr[1])); }
    if (__builtin_expect(__all(pmax - m_reg <= THR / SCALE), 1)) { mn = m_reg; alpha = 1.f; }
    else { mn = fmaxf(m_reg, pmax); alpha = __builtin_amdgcn_exp2f((m_reg - mn) * C); m_reg = mn; }
    const float mnC = -mn * C;
#pragma unroll
    for (int r = 0; r < 16; ++r) p0[r] = fmaf(p0[r], C, mnC);
#pragma unroll
    for (int r = 0; r < 16; ++r) p1[r] = fmaf(p1[r], C, mnC);
#pragma unroll
    for (int r = 0; r < 16; ++r) p0[r] = __builtin_amdgcn_exp2f(p0[r]);
}
__device__ __forceinline__ void finishSM(f32x16& p0, f32x16& p1, float alpha, float& l_reg, bf16x8& pa0, bf16x8& pa1, bf16x8& pa2, bf16x8& pa3) {
#pragma unroll
    for (int r = 0; r < 16; ++r) p1[r] = __builtin_amdgcn_exp2f(p1[r]);
    float ps = 0;
#pragma unroll
    for (int r = 0; r < 16; ++r) ps += p0[r];
#pragma unroll
    for (int r = 0; r < 16; ++r) ps += p1[r];
    { auto rr = __builtin_amdgcn_permlane32_swap(__float_as_uint(ps), __float_as_uint(ps), false, false);
      ps = __uint_as_float(rr[0]) + __uint_as_float(rr[1]); }
    l_reg = l_reg * alpha + ps;
#define PK4(P, BASE, OUT) do { unsigned a0 = cvtpk(P[BASE + 0], P[BASE + 1]), a1 = cvtpk(P[BASE + 2], P[BASE + 3]);   \
    unsigned b0 = cvtpk(P[BASE + 4], P[BASE + 5]), b1 = cvtpk(P[BASE + 6], P[BASE + 7]);                              \
    auto r0 = __builtin_amdgcn_permlane32_swap(a0, b0, false, false); auto r1 = __builtin_amdgcn_permlane32_swap(a1, b1, false, false); \
    v4u w = {r0[0], r1[0], r0[1], r1[1]}; OUT = __builtin_bit_cast(bf16x8, w); } while (0)
    PK4(p0, 0, pa0); PK4(p0, 8, pa1); PK4(p1, 0, pa2); PK4(p1, 8, pa3);
#undef PK4
}
__device__ __forceinline__ void qkt(f32x16& p0, f32x16& p1, const LAS char* Ks, const bf16x8* qr, int r32, int hi) {
    p0 = f32x16{}; p1 = f32x16{};
#pragma unroll
    for (int d0 = 0; d0 < 8; ++d0) { const int cb = (d0 * 16 + hi * 8) * 2;
        const bf16x8 b0 = *(const LAS bf16x8*)(Ks + KSWZ(r32, cb));
        const bf16x8 b1 = *(const LAS bf16x8*)(Ks + KSWZ(32 + r32, cb));
        p0 = __builtin_amdgcn_mfma_f32_32x32x16_bf16(b0, qr[d0], p0, 0, 0, 0);
        p1 = __builtin_amdgcn_mfma_f32_32x32x16_bf16(b1, qr[d0], p1, 0, 0, 0); }
}
__device__ __forceinline__ int v_st(int k, int c) { const int kk = (k & ~0xC) | ((k & 4) << 1) | ((k & 8) >> 1); return ((kk >> 3) * 4 + (c >> 5)) * 512 + ((kk & 7) * 32 + (c & 31)) * 2; }
__device__ __forceinline__ int v_rd_base(int lane) { return ((lane & 3) << 3) | (((lane >> 2) & 3) << 6) | (((lane >> 4) & 1) << 5) | (((lane >> 5) & 1) << 8); }
constexpr int v_rd_off(int d0, int ks, int half) { return d0 * 512 + ks * 4096 + half * 2048; }
template <int OFF> __device__ __forceinline__ s16x4 tr_read(int vb) {
    s16x4 r; asm volatile("ds_read_b64_tr_b16 %0, %1 offset:%2" : "=&v"(r) : "v"(vb), "i"(OFF) : "memory"); return r;
}
template <int D0> __device__ __forceinline__ void pv_one(f32x16& od, int vb, bf16x8 pa0, bf16x8 pa1, bf16x8 pa2, bf16x8 pa3) {
    const s16x4 l0 = tr_read<v_rd_off(D0, 0, 0)>(vb), h0 = tr_read<v_rd_off(D0, 0, 1)>(vb), l1 = tr_read<v_rd_off(D0, 1, 0)>(vb), h1 = tr_read<v_rd_off(D0, 1, 1)>(vb);
    const s16x4 l2 = tr_read<v_rd_off(D0, 2, 0)>(vb), h2 = tr_read<v_rd_off(D0, 2, 1)>(vb), l3 = tr_read<v_rd_off(D0, 3, 0)>(vb), h3 = tr_read<v_rd_off(D0, 3, 1)>(vb);
    asm volatile("s_waitcnt lgkmcnt(0)" ::: "memory"); SBAR();
#define PK(L, H) (bf16x8){L[0], L[1], L[2], L[3], H[0], H[1], H[2], H[3]}
    od = __builtin_amdgcn_mfma_f32_32x32x16_bf16(pa0, PK(l0, h0), od, 0, 0, 0);
    od = __builtin_amdgcn_mfma_f32_32x32x16_bf16(pa1, PK(l1, h1), od, 0, 0, 0);
    od = __builtin_amdgcn_mfma_f32_32x32x16_bf16(pa2, PK(l2, h2), od, 0, 0, 0);
    od = __builtin_amdgcn_mfma_f32_32x32x16_bf16(pa3, PK(l3, h3), od, 0, 0, 0);
#undef PK
}
template <int D0> __device__ __forceinline__ void pv_two(f32x16& oa, f32x16& ob, int vb, bf16x8 pa0, bf16x8 pa1, bf16x8 pa2, bf16x8 pa3) {
    const s16x4 l0 = tr_read<v_rd_off(D0, 0, 0)>(vb), h0 = tr_read<v_rd_off(D0, 0, 1)>(vb), l1 = tr_read<v_rd_off(D0, 1, 0)>(vb), h1 = tr_read<v_rd_off(D0, 1, 1)>(vb);
    const s16x4 l2 = tr_read<v_rd_off(D0, 2, 0)>(vb), h2 = tr_read<v_rd_off(D0, 2, 1)>(vb), l3 = tr_read<v_rd_off(D0, 3, 0)>(vb), h3 = tr_read<v_rd_off(D0, 3, 1)>(vb);
    const s16x4 m0 = tr_read<v_rd_off(D0 + 1, 0, 0)>(vb), n0 = tr_read<v_rd_off(D0 + 1, 0, 1)>(vb), m1 = tr_read<v_rd_off(D0 + 1, 1, 0)>(vb), n1 = tr_read<v_rd_off(D0 + 1, 1, 1)>(vb);
    const s16x4 m2 = tr_read<v_rd_off(D0 + 1, 2, 0)>(vb), n2 = tr_read<v_rd_off(D0 + 1, 2, 1)>(vb), m3 = tr_read<v_rd_off(D0 + 1, 3, 0)>(vb), n3 = tr_read<v_rd_off(D0 + 1, 3, 1)>(vb);
    asm volatile("s_waitcnt lgkmcnt(0)" ::: "memory"); SBAR();
#define PK(L, H) (bf16x8){L[0], L[1], L[2], L[3], H[0], H[1], H[2], H[3]}
    oa = __builtin_amdgcn_mfma_f32_32x32x16_bf16(pa0, PK(l0, h0), oa, 0, 0, 0); ob = __builtin_amdgcn_mfma_f32_32x32x16_bf16(pa0, PK(m0, n0), ob, 0, 0, 0);
    oa = __builtin_amdgcn_mfma_f32_32x32x16_bf16(pa1, PK(l1, h1), oa, 0, 0, 0); ob = __builtin_amdgcn_mfma_f32_32x32x16_bf16(pa1, PK(m1, n1), ob, 0, 0, 0);
    oa = __builtin_amdgcn_mfma_f32_32x32x16_bf16(pa2, PK(l2, h2), oa, 0, 0, 0); ob = __builtin_amdgcn_mfma_f32_32x32x16_bf16(pa2, PK(m2, n2), ob, 0, 0, 0);
    oa = __builtin_amdgcn_mfma_f32_32x32x16_bf16(pa3, PK(l3, h3), oa, 0, 0, 0); ob = __builtin_amdgcn_mfma_f32_32x32x16_bf16(pa3, PK(m3, n3), ob, 0, 0, 0);
#undef PK
}
__device__ __forceinline__ void pv_d0(f32x16* o, int vb, bf16x8 pa0, bf16x8 pa1, bf16x8 pa2, bf16x8 pa3) {
#if PV_TWO
    pv_two<0>(o[0], o[1], vb, pa0, pa1, pa2, pa3); pv_two<2>(o[2], o[3], vb, pa0, pa1, pa2, pa3);
#else
    pv_one<0>(o[0], vb, pa0, pa1, pa2, pa3); pv_one<1>(o[1], vb, pa0, pa1, pa2, pa3); pv_one<2>(o[2], vb, pa0, pa1, pa2, pa3); pv_one<3>(o[3], vb, pa0, pa1, pa2, pa3);
#endif
}

template <int MODE> __device__ __forceinline__ bool tile_active(int widx, int lo, int nwin, int qa, int md) {
    if (!TILE_SKIP || MODE == 3 || widx < 0) return true;
    bool a = true;
    if (MODE == 0) a = widx < nwin && (unsigned)(lo + widx - md) < 8u;
    if (MODE == 1) { const int k0 = 64 * (lo + widx); a = widx < nwin && k0 + 63 >= qa - 128 && k0 <= qa + 31 + 128; }
    return __builtin_amdgcn_readfirstlane(a ? 1 : 0) != 0;
}
template <int MODE>
__device__ __forceinline__ void attn_unit(const bf16* __restrict__ QKV, int ldq, int qcol, int kcol, int vcol, bf16* __restrict__ AO, int qrow0, int ctx0, int lat0, int lo, int nwin, int NT,
                                          MaskInfo mi, const float* extra, bool use_sink, LAS char* lds, int wave_id, const float* qg, const float* rope_c) {
    const int tid = opq(wave_id * 64 + lane_now()), wid = wave_id, lane = tid & 63, r32 = lane & 31, hi = lane >> 5;
    LAS float* wsx = (LAS float*)(lds + OFF_WS) + wid * 64; LAS float* li_l = wsx; LAS float* al_l = wsx + 32;
    LAS float* tab = (LAS float*)(lds + OFF_TAB);
    if (MODE == 0) {
        for (int idx = tid; idx < 15 * 128; idx += NWAVES * 64) { const int drow = idx >> 7, dcol = (idx & 127) - 48;
            tab[idx] = (extra != nullptr && dcol >= 0 && dcol < 31) ? extra[drow * 31 + dcol] * (1.0f / SCALE) : 0.f; }
    }
    float m_reg = -1e30f, l_reg = 0; f32x16 o[4] = {}; bf16x8 qr[8];
    const bf16* Qw = QKV + (size_t)(qrow0 + wid * QBLK + r32) * ldq + qcol + hi * 8;
#pragma unroll
    for (int d0 = 0; d0 < 8; ++d0) qr[d0] = *(const GAS bf16x8*)(Qw + d0 * 16);
    const int vb0 = (int)(uintptr_t)lds + v_rd_base(lane);
    unsigned goff[4];
#pragma unroll
    for (int i = 0; i < 4; ++i) { const int s_ = 512 * i + tid;
        if (i < 2) { const int ob = s_ * 16, sub = ob >> 9, kk = (sub >> 2) * 8 + ((ob & 511) >> 6), k = (kk & ~0xC) | ((kk & 4) << 1) | ((kk & 8) >> 1), c = (sub & 3) * 32 + ((ob & 63) >> 1); goff[i] = (unsigned)(k * ldq + vcol + c); }
        else { const int ob = (s_ - 1024) * 16, row = ob >> 8, cb = (ob & 255) ^ ((row & 7) << 4); goff[i] = (unsigned)(row * ldq + kcol + (cb >> 1)); } }
#define TROW(j) ((j) < 4 ? ctx0 + 64 * (j) : lat0 + 64 * (((j) - 4) < nwin ? ((j) - 4) : nwin - 1))
#define DMA(j) do { const GAS bf16* tb_ = (const GAS bf16*)QKV + (size_t)TROW(j) * ldq; LAS char* db_ = lds + ((j) & 3) * BUFB + wid * 1024; \
    _Pragma("unroll") for (int i_ = 0; i_ < 4; ++i_) __builtin_amdgcn_global_load_lds((const unsigned*)(const void*)(tb_ + goff[i_]), (LAS unsigned*)(db_ + i_ * 8192), 16, 0, 0); } while (0)
#define WAITV4() asm volatile("s_waitcnt vmcnt(4)" ::: "memory")
#define WAITV0() asm volatile("s_waitcnt vmcnt(0)" ::: "memory")
#define BAR() do { asm volatile("" ::: "memory"); __builtin_amdgcn_s_barrier(); asm volatile("" ::: "memory"); } while (0)
#define KBUF(j) (lds + ((j) & 3) * BUFB + SHM_V)
#define VBUF(j) (vb0 + ((j) & 3) * BUFB)
#define RESC(a) do { if (__any((a) < 1.f)) { if (hi == 0) al_l[r32] = (a); asm volatile("s_waitcnt lgkmcnt(0)" ::: "memory"); \
    _Pragma("unroll") for (int d = 0; d < 4; ++d) _Pragma("unroll") for (int r = 0; r < 16; ++r) o[d][r] *= al_l[crow(r, hi)]; } } while (0)
#define MASK(P0, P1, j) apply_mask<MODE>(P0, P1, (j) - 4, lo, nwin, mi, hi, tab)
    f32x16 pA0, pA1, pB0, pB1; float mnA, mnB, alA, alB; bf16x8 pa0, pa1, pa2, pa3;
    DMA(0); DMA(1);
    if (qg != nullptr) {
        float ss = 0.f;
#pragma unroll
        for (int d0 = 0; d0 < 8; ++d0)
#pragma unroll
            for (int e = 0; e < 8; ++e) { const float x = bf2f((bf16)qr[d0][e]); ss += x * x; }
        { auto rr = __builtin_amdgcn_permlane32_swap(__float_as_uint(ss), __float_as_uint(ss), false, false); ss = __uint_as_float(rr[0]) + __uint_as_float(rr[1]); }
        const float rstd = 1.0f / sqrtf(ss * (1.0f / HD) + NORM_EPS);
        const int t = (qrow0 + wid * QBLK + r32) & (SEQ - 1);
#pragma unroll
        for (int a = 0; a < 2; ++a)
#pragma unroll
            for (int dd = 0; dd < 2; ++dd) { const int d1 = 4 * a + dd, d2 = d1 + 2, c1 = d1 * 16 + hi * 8;
                const f32x4 g1a = *(const GAS f32x4*)(qg + c1), g1b = *(const GAS f32x4*)(qg + c1 + 4), g2a = *(const GAS f32x4*)(qg + c1 + 32), g2b = *(const GAS f32x4*)(qg + c1 + 36);
                float x1[8], x2[8];
#pragma unroll
                for (int e = 0; e < 8; ++e) { x1[e] = bf2f((bf16)qr[d1][e]) * rstd * (e < 4 ? g1a[e & 3] : g1b[e & 3]); x2[e] = bf2f((bf16)qr[d2][e]) * rstd * (e < 4 ? g2a[e & 3] : g2b[e & 3]); }
                if (rope_c != nullptr) { const int pos = a ? (t & (GRIDW - 1)) : (t >> 6), f0 = dd * 16 + hi * 8; const float* cp = rope_c + pos * 32 + f0;
                    const f32x4 ca = *(const GAS f32x4*)cp, cb = *(const GAS f32x4*)(cp + 4), sa = *(const GAS f32x4*)(cp + 4096), sb = *(const GAS f32x4*)(cp + 4100);
#pragma unroll
                    for (int e = 0; e < 8; ++e) { const float c = e < 4 ? ca[e & 3] : cb[e & 3], sn = e < 4 ? sa[e & 3] : sb[e & 3]; const float n1 = x1[e] * c - x2[e] * sn, n2 = x2[e] * c + x1[e] * sn; x1[e] = n1; x2[e] = n2; } }
                const v4u w1 = {cvtpk(x1[0], x1[1]), cvtpk(x1[2], x1[3]), cvtpk(x1[4], x1[5]), cvtpk(x1[6], x1[7])}, w2 = {cvtpk(x2[0], x2[1]), cvtpk(x2[2], x2[3]), cvtpk(x2[4], x2[5]), cvtpk(x2[6], x2[7])};
                qr[d1] = __builtin_bit_cast(bf16x8, w1); qr[d2] = __builtin_bit_cast(bf16x8, w2); }
    }
    WAITV4(); BAR();
    DMA(2);
    const int qa_u = __builtin_amdgcn_readfirstlane(mi.a), md_u = __builtin_amdgcn_readfirstlane(mi.d);
#define ACT(j) tile_active<MODE>((j) - 4, lo, nwin, qa_u, md_u)
    bool aA = true, aB = true;
    qkt(pA0, pA1, KBUF(0), qr, r32, hi); MASK(pA0, pA1, 0); partialSM(pA0, pA1, m_reg, mnA, alA);
    for (int j = 1; j + 1 < NT; j += 2) {
        WAITV4(); BAR();
        if (j + 2 < NT) DMA(j + 2);
        aB = ACT(j);
        SBAR(); if (aB) qkt(pB0, pB1, KBUF(j), qr, r32, hi);
        if (aA) { finishSM(pA0, pA1, alA, l_reg, pa0, pa1, pa2, pa3); SBAR();
                  pv_d0(o, VBUF(j - 1), pa0, pa1, pa2, pa3); }
        if (aB) { MASK(pB0, pB1, j); partialSM(pB0, pB1, m_reg, mnB, alB);
                  RESC(alB); }
        if (j + 2 < NT) WAITV4(); else WAITV0();
        BAR();
        if (j + 3 < NT) DMA(j + 3);
        aA = ACT(j + 1);
        SBAR(); if (aA) qkt(pA0, pA1, KBUF(j + 1), qr, r32, hi);
        if (aB) { finishSM(pB0, pB1, alB, l_reg, pa0, pa1, pa2, pa3); SBAR();
                  pv_d0(o, VBUF(j), pa0, pa1, pa2, pa3); }
        if (aA) { MASK(pA0, pA1, j + 1); partialSM(pA0, pA1, m_reg, mnA, alA);
                  RESC(alA); }
    }
    WAITV0(); BAR();
    aB = ACT(NT - 1);
    SBAR(); if (aB) qkt(pB0, pB1, KBUF(NT - 1), qr, r32, hi);
    if (aA) { finishSM(pA0, pA1, alA, l_reg, pa0, pa1, pa2, pa3); SBAR();
              pv_d0(o, VBUF(NT - 2), pa0, pa1, pa2, pa3); }
    if (aB) { MASK(pB0, pB1, NT - 1); partialSM(pB0, pB1, m_reg, mnB, alB);
              RESC(alB);
              finishSM(pB0, pB1, alB, l_reg, pa0, pa1, pa2, pa3); SBAR();
              pv_d0(o, VBUF(NT - 1), pa0, pa1, pa2, pa3); }
#undef ACT
    if (MODE == 1 && use_sink) l_reg += __builtin_amdgcn_exp2f(extra[0] * 1.4426950408889634f - m_reg * (SCALE * 1.4426950408889634f));
    if (hi == 0) li_l[r32] = l_reg; asm volatile("s_waitcnt lgkmcnt(0)" ::: "memory");
    float rli[16];
#pragma unroll
    for (int r = 0; r < 16; ++r) rli[r] = __builtin_amdgcn_rcpf(li_l[crow(r, hi)]);
    bf16* Ow = AO + (size_t)(qrow0 + wid * QBLK) * DM + qcol;
#pragma unroll
    for (int r = 0; r < 16; ++r) { const int orow = crow(r, hi);
#pragma unroll
        for (int d0 = 0; d0 < 4; ++d0) ((GAS bf16*)Ow)[(size_t)orow * DM + d0 * 32 + r32] = (bf16)(pk2(o[d0][r] * rli[r], 0.f) & 0xffffu); }
#undef TROW
#undef DMA
#undef WAITV4
#undef WAITV0
#undef BAR
#undef KBUF
#undef VBUF
#undef RESC
#undef MASK
}
#undef KSWZ

template <int MODE>
__device__ __forceinline__ void attn_phase(Frame& F, const Args& A, int ldq, int nkv, const float* extra, bool with_ctx, const float* qg, const float* rope_c) {
    const bf16* QKV = (const bf16*)(opq_ptr(A.ws) + WS_QKV); bf16* AO = (bf16*)(opq_ptr(A.ws) + WS_AO); LAS char* lds = (LAS char*)F.ldsp();
    const int G_ = NH / nkv, nunits = 2048 + (with_ctx ? 64 : 0);
    const int wid = F.wv(), r32 = opq(F.lane_id()) & 31;
    for (int u = F.vc(); u < nunits; u += F.ng()) {
        const bool cu = u >= 2048;
        const int b = cu ? (u - 2048) >> 4 : u >> 9, h = cu ? (u - 2048) & 15 : (u >> 5) & 15, qt = u & 31, kvh = h / G_;
        const int qcol = h * HD, kcol = DM + kvh * HD, vcol = DM + nkv * HD + kvh * HD, ctx0 = MLAT + b * CTXL;
        int qrow0, lat0 = 0, lo = 0, nwin = 0, NT = 4; MaskInfo mi{0, 0, 0, 0};
        if (cu) { qrow0 = ctx0; }
        else {
            qrow0 = b * SEQ + qt * 256;
            if (MODE == 3) { lo = 0; nwin = SEQ / 64; }
            if (MODE == 1) { lo = qt * 4 - 2 < 0 ? 0 : qt * 4 - 2; const int hiT = qt * 4 + 6 > SEQ / 64 ? SEQ / 64 : qt * 4 + 6; nwin = hiT - lo; mi.a = qt * 256 + wid * 32 + r32; }
            if (MODE == 0) { lo = qt * 4 - 4 < 0 ? 0 : qt * 4 - 4; const int hc_ = qt * 4 - 1 < 0 ? 0 : (qt * 4 - 1 > 120 ? 120 : qt * 4 - 1); const int hiR = hc_ + 7; nwin = hiR - lo + 1;
                const int qr_ = qt * 4 + (wid >> 1), qc = (wid & 1) * 32 + r32; mi.a = qr_; mi.b = qc; mi.c = qc - 8 < 0 ? 0 : (qc - 8 > 48 ? 48 : qc - 8); mi.d = qr_ - 4 < 0 ? 0 : (qr_ - 4 > 120 ? 120 : qr_ - 4); }
            lat0 = b * SEQ + lo * 64; NT = 4 + nwin; NT += NT & 1;
        }
        const float* ex = nullptr; bool sink = false;
        if (MODE == 0) ex = cu ? nullptr : extra + h * (15 * 31);
        if (MODE == 1) { ex = extra + h; sink = true; }
        attn_unit<MODE>(QKV, ldq, qcol, kcol, vcol, AO, qrow0, ctx0, lat0, lo, nwin, NT, mi, ex, sink, lds, F.wv(), qg, cu ? nullptr : rope_c);
        __syncthreads();
    }
}
}

namespace ml {
typedef short v4i16_t __attribute__((ext_vector_type(4)));
constexpr int NCH = 132;
constexpr size_t OFF_WB = 0, OFF_TAB = 40 * MiB, OFF_NLOC = 48 * MiB;
constexpr int TAB_P = 0, TAB_E = 64, TAB_DEN = 128, TAB_DECAY = 192, TAB_N = 320;
constexpr int QSTR = 528, VSTR = 144;
__device__ __forceinline__ bf16x8 trfrag(const LAS char* p0, const LAS char* p1) {
    const s16x4 a = __builtin_bit_cast(s16x4, __builtin_amdgcn_ds_read_tr16_b64_v4i16((LAS v4i16_t*)p0));
    const s16x4 b = __builtin_bit_cast(s16x4, __builtin_amdgcn_ds_read_tr16_b64_v4i16((LAS v4i16_t*)p1));
    return (bf16x8){a[0], a[1], a[2], a[3], b[0], b[1], b[2], b[3]};
}
__device__ __forceinline__ float rdlane(float v, int l) { return __builtin_bit_cast(float, __builtin_amdgcn_readlane(__builtin_bit_cast(int, v), l)); }
__device__ __forceinline__ float log_sigmoid(float g) { return fminf(g, 0.f) - log1pf(__expf(-fabsf(g))); }
__device__ __forceinline__ int chrow(int b, int dir, int c, int s) {
    return c < 4 ? (dir ? MLAT + b * CTXL + 255 - (64 * c + s) : MLAT + b * CTXL + 64 * c + s) : (dir ? b * SEQ + SEQ - 1 - (64 * (c - 4) + s) : b * SEQ + 64 * (c - 4) + s);
}

namespace pa { constexpr int QS = 0, KS = 33792, GI = 67584, GF = 67840, TAB = 68096  , DENP = 78336  , NP = 78848  , BL = 80896  , PM = 81424  ; }
__device__ __forceinline__ void mlstm_pre_a(Frame& F, const Args& A) {
    using namespace pa;
    unsigned char* ws = opq_ptr(A.ws); const bf16* QKV = (const bf16*)(ws + WS_QKV); const float* GT = (const float*)(ws + WS_GATES);
    bf16* WB = (bf16*)(ws + WS_PART + OFF_WB); float* TABG = (float*)(ws + WS_PART + OFF_TAB); float* NLOC = (float*)(ws + WS_PART + OFF_NLOC); bf16* KTW = (bf16*)(ws + WS_HX);
    LAS char* lds = (LAS char*)F.ldsp();
    const int tid = opq(F.tid_()), w = F.wv(), lane = tid & 63, r = lane & 15, q = lane >> 4;
    LAS float* tabA = (LAS float*)(lds + TAB + w * 1280); LAS float* tabM = tabA + 64; LAS float* tabP = tabA + 128; LAS float* tabE = tabA + 192; LAS float* tabW = tabA + 256;
    for (int u = F.vc(); u < 256; u += F.ng()) {
        const int seg = u & 7, chain = u >> 3, dir = chain & 1, h = (chain >> 1) & 3, b = chain >> 3;
        const int gi_idx = (dir ? 8 : 0) + h, gf_idx = (dir ? 12 : 4) + h, qcol = h * 256, kcol = 1024 + h * 256;
        const int c0 = seg * 17, c1 = c0 + 17 < NCH ? c0 + 17 : NCH;
        for (int cb = w; cb < c0; cb += 4 * NWAVES) {
            float gi4[4], gf4[4];
#pragma unroll
            for (int k = 0; k < 4; ++k) { const int c = cb + k * NWAVES; const float* gp = GT + (size_t)chrow(b, dir, c < c0 ? c : cb, lane) * 16; gi4[k] = gp[gi_idx]; gf4[k] = gp[gf_idx]; }
#pragma unroll
            for (int k = 0; k < 4; ++k) { const int c = cb + k * NWAVES;
                const float bs = scan_add(log_sigmoid(gf4[k]));
                const float pm = wave_max(gi4[k] - bs);
                if (lane == 63 && c < c0) { ((LAS float*)(lds + BL))[c] = bs; ((LAS float*)(lds + PM))[c] = pm; } } }
        __syncthreads();
        float m = 0.f;
        for (int c = 0; c < c0; ++c) m = ((LAS float*)(lds + BL))[c] + fmaxf(m, ((LAS float*)(lds + PM))[c]);
        v4u pq[4], pk[4]; float pgi = 0.f, pgf = 0.f;
#define PREFETCH(c) do { _Pragma("unroll") for (int i_ = 0; i_ < 4; ++i_) { const int pi_ = tid + 512 * i_, s_ = pi_ >> 5, cp_ = pi_ & 31; const bf16* rp_ = QKV + (size_t)chrow(b, dir, c, s_) * 6144 + 8 * cp_; \
            pq[i_] = *(const GAS v4u*)(rp_ + qcol); pk[i_] = *(const GAS v4u*)(rp_ + kcol); } \
        if (tid < 64) { const float* gp_ = GT + (size_t)chrow(b, dir, c, tid) * 16; pgi = gp_[gi_idx]; pgf = gp_[gf_idx]; } } while (0)
#define COMMIT() do { _Pragma("unroll") for (int i_ = 0; i_ < 4; ++i_) { const int pi_ = tid + 512 * i_, s_ = pi_ >> 5, cp_ = pi_ & 31; \
            *(LAS v4u*)(lds + QS + s_ * QSTR + cp_ * 16) = pq[i_]; *(LAS v4u*)(lds + KS + s_ * QSTR + cp_ * 16) = pk[i_]; } \
        if (tid < 64) { ((LAS float*)(lds + GI))[tid] = pgi; ((LAS float*)(lds + GF))[tid] = pgf; } } while (0)
        PREFETCH(c0); VM_WAIT(); COMMIT(); __syncthreads();
        for (int c = c0; c < c1; ++c) {
            if (c + 1 < c1) PREFETCH(c + 1);
            const size_t cc = (size_t)chain * NCH + c;
            float decay, m_next;
            { const float gi = ((LAS float*)(lds + GI))[lane], lf = log_sigmoid(((LAS float*)(lds + GF))[lane]);
              const float bsum = scan_add(lf);
              const float a = gi - bsum; const float pm = scan_max(a);
              const float M = fmaxf(m, pm), Ml = rdlane(M, 63), bl = rdlane(bsum, 63);
              tabA[lane] = a; tabM[lane] = M; tabP[lane] = fast_exp(m - M); tabE[lane] = fast_exp(-(bsum + M)); tabW[lane] = fast_exp(a - Ml) * 0.0625f;
              decay = fast_exp(m - Ml); m_next = bl + Ml; }
            LDS_WAIT();
            { const int tb = w >> 1, sbh = w & 1; float rs = 0.f;
              const float Mt = tabM[16 * tb + r];
#pragma unroll
              for (int sbi = 0; sbi < 2; ++sbi) { const int sb = 2 * sbh + sbi; f32x4 wv = (f32x4){0.f, 0.f, 0.f, 0.f};
                  if (sb <= tb) { f32x4 acc = (f32x4){0.f, 0.f, 0.f, 0.f};
#pragma unroll
                      for (int kk = 0; kk < 8; ++kk) { const bf16x8 ka = *(const LAS bf16x8*)(lds + KS + (16 * sb + r) * QSTR + (32 * kk + 8 * q) * 2); const bf16x8 qb = *(const LAS bf16x8*)(lds + QS + (16 * tb + r) * QSTR + (32 * kk + 8 * q) * 2);
                          acc = __builtin_amdgcn_mfma_f32_16x16x32_bf16(ka, qb, acc, 0, 0, 0); }
                      const f32x4 a4 = *(const LAS f32x4*)(tabA + 16 * sb + 4 * q);
#pragma unroll
                      for (int i = 0; i < 4; ++i) wv[i] = (16 * sb + 4 * q + i <= 16 * tb + r) ? fast_exp(a4[i] - Mt) * acc[i] * 0.0625f : 0.f; }
                  rs += (wv[0] + wv[1]) + (wv[2] + wv[3]);
                  v2u o; o.x = pk2(wv[0], wv[1]); o.y = pk2(wv[2], wv[3]);
                  *(GAS v2u*)(WB + cc * 4096 + (16 * tb + r) * 64 + 16 * sb + 4 * q) = o; }
              rs = sum_xor16_32(rs);
              if (q == 0) ((LAS float*)(lds + DENP))[sbh * 64 + 16 * tb + r] = rs; }
            { const int d = tid & 255, sh = tid >> 8; float ns = 0.f; unsigned pkd[16];
#pragma unroll
              for (int i = 0; i < 16; ++i) { const int s0 = 32 * sh + 2 * i; const float v0 = tabW[s0] * bf2f(*(const LAS bf16*)(lds + KS + s0 * QSTR + d * 2)), v1 = tabW[s0 + 1] * bf2f(*(const LAS bf16*)(lds + KS + (s0 + 1) * QSTR + d * 2));
                  ns += v0 + v1; pkd[i] = pk2(v0, v1); }
              GAS v4u* kp = (GAS v4u*)(KTW + cc * 16384 + d * 64 + 32 * sh);
#pragma unroll
              for (int i = 0; i < 4; ++i) kp[i] = (v4u){pkd[4 * i], pkd[4 * i + 1], pkd[4 * i + 2], pkd[4 * i + 3]};
              ((LAS float*)(lds + NP))[sh * 256 + d] = ns; }
            __syncthreads();
            if (tid < 64) { float* tg = TABG + cc * TAB_N; tg[TAB_P + tid] = tabP[tid]; tg[TAB_E + tid] = tabE[tid]; tg[TAB_DEN + tid] = ((LAS float*)(lds + DENP))[tid] + ((LAS float*)(lds + DENP))[64 + tid]; if (tid == 0) tg[TAB_DECAY] = decay; }
            if (tid < 256) NLOC[cc * 256 + tid] = ((LAS float*)(lds + NP))[tid] + ((LAS float*)(lds + NP))[256 + tid];
            m = m_next;
            if (c + 1 < c1) { COMMIT(); }
            __syncthreads();
        }
#undef PREFETCH
#undef COMMIT
    }
}

namespace pb_ { constexpr int NSL = 0  , QNP = 1024  ; }
__device__ __forceinline__ void mlstm_pre_b(Frame& F, const Args& A) {
    using namespace pb_;
    unsigned char* ws = opq_ptr(A.ws); const bf16* QKV = (const bf16*)(ws + WS_QKV);
    float* TABG = (float*)(ws + WS_PART + OFF_TAB); const float* NLOC = (const float*)(ws + WS_PART + OFF_NLOC);
    LAS char* lds = (LAS char*)F.ldsp();
    const int tid = opq(F.tid_()), w = F.wv(), lane = tid & 63;
    for (int u = F.vc(); u < 256; u += F.ng()) {
        const int seg = u & 7, chain = u >> 3, dir = chain & 1, h = (chain >> 1) & 3, b = chain >> 3, qcol = h * 256;
        const int c0 = seg * 17, c1 = c0 + 17 < NCH ? c0 + 17 : NCH;
        float n = 0.f;
        if (tid < 256) {
            int c = 0;
            for (; c + 8 <= c0; c += 8) { float dk[8], vk[8];
#pragma unroll
                for (int k = 0; k < 8; ++k) { const size_t cc = (size_t)chain * NCH + c + k; dk[k] = TABG[cc * TAB_N + TAB_DECAY]; vk[k] = NLOC[cc * 256 + tid]; }
#pragma unroll
                for (int k = 0; k < 8; ++k) n = dk[k] * n + vk[k]; }
            for (; c < c0; ++c) { const size_t cc = (size_t)chain * NCH + c; n = TABG[cc * TAB_N + TAB_DECAY] * n + NLOC[cc * 256 + tid]; } }
        v4u qn[4];
        { const bf16* qp = QKV + (size_t)chrow(b, dir, c0, lane) * 6144 + qcol + 32 * w;
#pragma unroll
          for (int i = 0; i < 4; ++i) qn[i] = *(const GAS v4u*)(qp + 8 * i); }
        for (int c = c0; c < c1; ++c) {
            const size_t cc = (size_t)chain * NCH + c;
            if (tid < 256) ((LAS float*)(lds + NSL))[tid] = n;
            v4u qv4[4];
#pragma unroll
            for (int i = 0; i < 4; ++i) qv4[i] = qn[i];
            if (c + 1 < c1) { const bf16* qp = QKV + (size_t)chrow(b, dir, c + 1, lane) * 6144 + qcol + 32 * w;
#pragma unroll
                for (int i = 0; i < 4; ++i) qn[i] = *(const GAS v4u*)(qp + 8 * i); }
            float dcy = 0.f, nlc = 0.f;
            if (tid < 256) { dcy = TABG[cc * TAB_N + TAB_DECAY]; nlc = NLOC[cc * 256 + tid]; }
            __syncthreads();
            { float s = 0.f; const LAS float* ns = (const LAS float*)(lds + NSL) + 32 * w;
#pragma unroll
              for (int i = 0; i < 4; ++i) { const v4u qv = qv4[i]; const f32x4 n0 = *(const LAS f32x4*)(ns + 8 * i), n1 = *(const LAS f32x4*)(ns + 8 * i + 4);
                  s += bf_lo(qv.x) * n0.x + bf_hi(qv.x) * n0.y + bf_lo(qv.y) * n0.z + bf_hi(qv.y) * n0.w + bf_lo(qv.z) * n1.x + bf_hi(qv.z) * n1.y + bf_lo(qv.w) * n1.z + bf_hi(qv.w) * n1.w; }
              ((LAS float*)(lds + QNP))[w * 64 + lane] = s; }
            __syncthreads();
            if (tid < 64) { float qn_ = 0.f;
#pragma unroll
                for (int ww = 0; ww < 8; ++ww) qn_ += ((LAS float*)(lds + QNP))[ww * 64 + tid];
                float* tg = TABG + cc * TAB_N; tg[TAB_DEN + tid] += tg[TAB_P + tid] * qn_; }
            if (tid < 256) n = dcy * n + nlc;
        }
        __syncthreads();
    }
}

namespace sc { constexpr int QS = 0, KT = 33792  , VS = 74752  , WS_ = 83968  , TABL = 94208  , KSTR = 160, CT = 95232  ; }
__device__ __forceinline__ void mlstm_scan(Frame& F, const Args& A) {
    using namespace sc;
    unsigned char* ws = opq_ptr(A.ws); const bf16* QKV = (const bf16*)(ws + WS_QKV);
    const bf16* WB = (const bf16*)(ws + WS_PART + OFF_WB); const float* TABG = (const float*)(ws + WS_PART + OFF_TAB); const bf16* KTW = (const bf16*)(ws + WS_HX);
    LAS char* lds = (LAS char*)F.ldsp();
    const int tid = opq(F.tid_()), w = F.wv(), lane = tid & 63, r = lane & 15, q = lane >> 4, nb = w & 3, th = w >> 2;
    for (int u = F.vc(); u < 256; u += F.ng()) {
        const int j = u & 7, chain = u >> 3, dir = chain & 1, h = (chain >> 1) & 3, b = chain >> 3;
        bf16* OUT = (bf16*)(ws + (dir ? WS_HB : WS_AO));
        const int qcol = h * 256, vcol = 2048 + h * 512 + j * 64, ocol = h * 512 + j * 64;
        f32x4 Cw[2][4];
#pragma unroll
        for (int rb = 0; rb < 2; ++rb)
#pragma unroll
            for (int cb = 0; cb < 4; ++cb) Cw[rb][cb] = (f32x4){0.f, 0.f, 0.f, 0.f};
        for (int i = tid; i < 64 * QSTR / 16; i += NWAVES * 64) *(LAS v4u*)(lds + CT + 16 * i) = (v4u){0u, 0u, 0u, 0u};
        v4u pq[4], pk[4], pv, pw; f32x4 pt = (f32x4){0.f, 0.f, 0.f, 0.f};
#define PREFETCH(c) do { const size_t cc_ = (size_t)chain * NCH + (c); \
        _Pragma("unroll") for (int i_ = 0; i_ < 4; ++i_) { const int pi_ = tid + 512 * i_; pq[i_] = *(const GAS v4u*)(QKV + (size_t)chrow(b, dir, c, pi_ >> 5) * 6144 + qcol + 8 * (pi_ & 31)); \
            pk[i_] = *(const GAS v4u*)(KTW + cc_ * 16384 + (size_t)pi_ * 8); } \
        pv = *(const GAS v4u*)(QKV + (size_t)chrow(b, dir, c, tid >> 3) * 6144 + vcol + 8 * (tid & 7)); pw = *(const GAS v4u*)(WB + cc_ * 4096 + (size_t)tid * 8); \
        if (tid < 49) pt = *(const GAS f32x4*)(TABG + cc_ * TAB_N + 4 * tid); } while (0)
#define COMMIT() do { _Pragma("unroll") for (int i_ = 0; i_ < 4; ++i_) { const int pi_ = tid + 512 * i_; *(LAS v4u*)(lds + QS + (pi_ >> 5) * QSTR + (pi_ & 31) * 16) = pq[i_]; \
            *(LAS v4u*)(lds + KT + (pi_ >> 3) * KSTR + (pi_ & 7) * 16) = pk[i_]; } \
        *(LAS v4u*)(lds + VS + (tid >> 3) * VSTR + (tid & 7) * 16) = pv; *(LAS v4u*)(lds + WS_ + (tid >> 3) * KSTR + (tid & 7) * 16) = pw; \
        if (tid < 49) *(LAS f32x4*)(lds + TABL + 16 * tid) = pt; } while (0)
#define WARM(c) do { const size_t cc_ = (size_t)chain * NCH + (c); \
        const bf16* b0_ = (w < 4) ? QKV : KTW; const unsigned o0_ = (w < 4) ? (unsigned)((chrow(b, dir, c, tid >> 2) * 6144 + qcol + 64 * (tid & 3)) * 2) : (unsigned)((cc_ * 16384 + (size_t)(tid - 256) * 64) * 2); \
        asm volatile("global_load_dword %0, %1, %2" : "+v"(wrm0) : "v"(o0_), "s"(b0_) : "memory"); } while (0)
        int wrm0 = 0;
        PREFETCH(0); VM_WAIT(); COMMIT(); __syncthreads();
        WARM(1);
        for (int c = 0; c < NCH; ++c) {
            if (c + 1 < NCH) PREFETCH(c + 1);
            if (c + 2 < NCH) WARM(c + 2);
            const LAS float* tl = (const LAS float*)(lds + TABL);
            unsigned hout[4];
            bf16x8 vb[2];
#pragma unroll
            for (int ks = 0; ks < 2; ++ks) { const LAS char* vp = lds + VS + (32 * ks + 8 * q + (r >> 2)) * VSTR + (16 * nb + 4 * (r & 3)) * 2; vb[ks] = trfrag(vp, vp + 4 * VSTR); }
            { f32x4 intra[2], inter[2];
#pragma unroll
              for (int tbi = 0; tbi < 2; ++tbi) { intra[tbi] = (f32x4){0.f, 0.f, 0.f, 0.f}; inter[tbi] = (f32x4){0.f, 0.f, 0.f, 0.f}; }
#pragma unroll
              for (int ks = 0; ks < 2; ++ks)
#pragma unroll
                  for (int tbi = 0; tbi < 2; ++tbi) { const bf16x8 wa = *(const LAS bf16x8*)(lds + WS_ + (16 * (2 * th + tbi) + r) * KSTR + (32 * ks + 8 * q) * 2);
                      intra[tbi] = __builtin_amdgcn_mfma_f32_16x16x32_bf16(wa, vb[ks], intra[tbi], 0, 0, 0); }
#pragma unroll
              for (int hk = 0; hk < 2; ++hk) {
                  v4u cfr[4], qar[4][2];
#pragma unroll
                  for (int k4 = 0; k4 < 4; ++k4) { const int kk = 4 * hk + k4;
                      const LAS char* cp = lds + CT + (16 * nb + r) * QSTR + (32 * kk + 4 * q) * 2;
                      const v2u clo = *(const LAS v2u*)cp, chi = *(const LAS v2u*)(cp + 32); cfr[k4] = (v4u){clo.x, clo.y, chi.x, chi.y};
#pragma unroll
                      for (int tbi = 0; tbi < 2; ++tbi) { const LAS char* qp = lds + QS + (16 * (2 * th + tbi) + r) * QSTR + (32 * kk + 4 * q) * 2;
                          const v2u lo = *(const LAS v2u*)qp, hi2 = *(const LAS v2u*)(qp + 32); qar[k4][tbi] = (v4u){lo.x, lo.y, hi2.x, hi2.y}; } }
#pragma unroll
                  for (int k4 = 0; k4 < 4; ++k4)
#pragma unroll
                      for (int tbi = 0; tbi < 2; ++tbi) inter[tbi] = __builtin_amdgcn_mfma_f32_16x16x32_bf16(__builtin_bit_cast(bf16x8, qar[k4][tbi]), __builtin_bit_cast(bf16x8, cfr[k4]), inter[tbi], 0, 0, 0);
                  __builtin_amdgcn_sched_barrier(0);
              }
#pragma unroll
              for (int tbi = 0; tbi < 2; ++tbi) { const int t0 = 16 * (2 * th + tbi) + 4 * q;
                  const f32x4 P4 = *(const LAS f32x4*)(tl + TAB_P + t0), E4 = *(const LAS f32x4*)(tl + TAB_E + t0), D4 = *(const LAS f32x4*)(tl + TAB_DEN + t0);
                  float hv[4];
#pragma unroll
                  for (int i = 0; i < 4; ++i) hv[i] = (intra[tbi][i] + P4[i] * inter[tbi][i]) / fmaxf(fabsf(D4[i]), E4[i]);
                  hout[2 * tbi] = pk2(hv[0], hv[1]); hout[2 * tbi + 1] = pk2(hv[2], hv[3]); } }
            __builtin_amdgcn_sched_barrier(0);
            { const float decay = tl[TAB_DECAY];
#pragma unroll
              for (int rb = 0; rb < 2; ++rb)
#pragma unroll
                  for (int cb = 0; cb < 4; ++cb) Cw[rb][cb] *= decay;
              bf16x8 ka[2][2];
#pragma unroll
              for (int rb = 0; rb < 2; ++rb)
#pragma unroll
                  for (int ks = 0; ks < 2; ++ks) ka[rb][ks] = *(const LAS bf16x8*)(lds + KT + (32 * w + 16 * rb + r) * KSTR + (32 * ks + 8 * q) * 2);
#pragma unroll
              for (int cb = 0; cb < 4; ++cb) { bf16x8 vx[2];
#pragma unroll
                  for (int ks = 0; ks < 2; ++ks) { const LAS char* vp = lds + VS + (32 * ks + 8 * q + (r >> 2)) * VSTR + (16 * cb + 4 * (r & 3)) * 2; vx[ks] = trfrag(vp, vp + 4 * VSTR); }
#pragma unroll
                  for (int rb = 0; rb < 2; ++rb)
#pragma unroll
                      for (int ks = 0; ks < 2; ++ks) Cw[rb][cb] = __builtin_amdgcn_mfma_f32_16x16x32_bf16(ka[rb][ks], vx[ks], Cw[rb][cb], 0, 0, 0); } }
            __syncthreads();
            if (c + 1 < NCH) { if (c + 2 < NCH) asm volatile("s_waitcnt vmcnt(1)" : "+v"(wrm0) :: "memory"); else asm volatile("s_waitcnt vmcnt(0)" : "+v"(wrm0) :: "memory"); COMMIT(); }
#pragma unroll
            for (int rb = 0; rb < 2; ++rb)
#pragma unroll
                for (int cb = 0; cb < 4; ++cb) { v2u cw; cw.x = pk2(Cw[rb][cb][0], Cw[rb][cb][1]); cw.y = pk2(Cw[rb][cb][2], Cw[rb][cb][3]);
                    *(LAS v2u*)(lds + CT + (16 * cb + r) * QSTR + (32 * w + 16 * rb + 4 * q) * 2) = cw; }
#pragma unroll
            for (int tbi = 0; tbi < 2; ++tbi)
#pragma unroll
                for (int i = 0; i < 4; ++i) ((GAS bf16*)OUT)[(size_t)chrow(b, dir, c, 16 * (2 * th + tbi) + 4 * q + i) * DM + ocol + 16 * nb + r] = (bf16)((hout[2 * tbi + (i >> 1)] >> (16 * (i & 1))) & 0xffffu);
            __syncthreads();
        }
#undef PREFETCH
#undef COMMIT
#undef WARM
    }
}
}

constexpr int NPH = 42;
#ifndef EN_ALL
#define EN_ALL 1
#endif
#ifndef EN_PRO
#define EN_PRO EN_ALL
#endif
#ifndef EN_NORM
#define EN_NORM EN_ALL
#endif
#ifndef EN_G1
#define EN_G1 EN_ALL
#endif
#ifndef EN_QKN
#define EN_QKN EN_ALL
#endif
#ifndef EN_A0
#define EN_A0 EN_ALL
#endif
#ifndef EN_A1
#define EN_A1 EN_ALL
#endif
#ifndef EN_ML
#define EN_ML EN_ALL
#endif
#ifndef EN_MLA
#define EN_MLA 1
#endif
#ifndef EN_MLB
#define EN_MLB 1
#endif
#ifndef EN_MLS
#define EN_MLS 1
#endif
#ifndef EN_A3
#define EN_A3 EN_ALL
#endif
#ifndef EN_RO
#define EN_RO EN_ALL
#endif
#ifndef EN_G2
#define EN_G2 EN_ALL
#endif
#ifndef EN_G3
#define EN_G3 EN_ALL
#endif
#ifndef EN_FIX
#define EN_FIX EN_ALL
#endif
#ifndef EN_G4
#define EN_G4 EN_ALL
#endif


#ifndef REP_PRO
#define REP_PRO 1
#endif
#ifndef REP_NORM
#define REP_NORM 1
#endif
#ifndef REP_G1
#define REP_G1 1
#endif
#ifndef REP_QKN
#define REP_QKN 1
#endif
#ifndef REP_A0
#define REP_A0 1
#endif
#ifndef REP_A1
#define REP_A1 1
#endif
#ifndef REP_ML
#define REP_ML 1
#endif
#ifndef REP_A3
#define REP_A3 1
#endif
#ifndef REP_RO
#define REP_RO 1
#endif
#ifndef REP_G3
#define REP_G3 1
#endif
#ifndef REP_FIX
#define REP_FIX 1
#endif
#ifndef REP_G2
#define REP_G2 1
#endif
#ifndef REP_G4
#define REP_G4 1
#endif
#ifndef REP_MLA
#define REP_MLA 1
#endif
#ifndef REP_MLS
#define REP_MLS 1
#endif
#ifndef WGM_G1
#define WGM_G1 4
#endif
#ifndef WGM_G2
#define WGM_G2 4
#endif
#ifndef WGM_G3
#define WGM_G3 4
#endif
#ifndef WGM_G4
#define WGM_G4 4
#endif
#ifndef ORD_G1
#define ORD_G1 1
#endif
#ifndef ORD_G2
#define ORD_G2 1
#endif
#ifndef ORD_G3
#define ORD_G3 1
#endif
#ifndef ORD_G4
#define ORD_G4 1
#endif
#ifndef DIR_N1
#define DIR_N1 1
#endif
#ifndef DIR_N2
#define DIR_N2 1
#endif
#ifndef QFUSE
#define QFUSE 1
#endif
#ifndef XBAR
#define XBAR 1
#endif
#ifndef MK_MODE
#define MK_MODE 0
#endif
__global__ void __launch_bounds__(NWAVES * 64, 2) fwd(Args args) {
    extern __shared__ __attribute__((aligned(16))) unsigned char lds[];
    Frame F;
    F.lds = (LAS unsigned char*)lds; F.MISC = (volatile LAS unsigned*)(F.lds + MISC_OFF);
    F.wave = __builtin_amdgcn_readfirstlane((int)threadIdx.x >> 6);
    F.G = gridDim.x; F.bx = blockIdx.x; { const int bx = blockIdx.x; F.vcu = (F.G % 8 == 0) ? (bx % 8) * (F.G / 8) + bx / 8 : bx; }
    unsigned char* ws = args.ws; F.ctl = (gu32*)(ws + WS_CTL);
    for (int u = threadIdx.x; u < (LDS_BYTES - LDSCTL_OFF) / 4; u += NWAVES * 64) ((LAS unsigned*)(F.lds + LDSCTL_OFF))[u] = 0u;
    __syncthreads();
    const int lo = args.ph_lo, hi = args.ph_hi;
    XcdBarrier bar = xcd_barrier_post((unsigned*)(F.ctl + CW_BAR) + lo * XCD_BAR_WORDS, F.MISC + 8);
#define RUN(k) (lo <= (k) && (k) < hi)
#define BAR_AFTER(k) do { if ((k) + 1 < hi) { xcd_barrier(bar); if (XBAR == 2) xcd_barrier(bar); } } while (0)
    float* const out = args.out;
#define WSP(off) (opq_ptr(args.ws) + (off))
#define HX ((bf16*)WSP(WS_HX))
#define QKVb ((bf16*)WSP(WS_QKV))
#define AOb ((bf16*)WSP(WS_AO))
#define ACT ((bf16*)WSP(WS_QKV))

    if (EN_PRO && RUN(0)) { for (int rep_ = 0; rep_ < REP_PRO; ++rep_) { if (rep_) __syncthreads(); prologue_phase(F, args); } BAR_AFTER(0); }
    if (RUN(1)) { modred_phase(F, args); BAR_AFTER(1); }

#define LAYER_BODY(L) { \
        const int pb = 2 + 10 * L; const bool last = (L == 3); \
        const float* modl = (const float*)WSP(WS_MOD) + (size_t)L * 5 * NMOD; \
        const int nq = nqkv_of(L), mrows = last ? MLAT : MT; \
        if (EN_NORM && RUN(pb + 0)) { for (int rep_ = 0; rep_ < REP_NORM; ++rep_) norm_phase(F, args, L == 0 ? (const void*)ldarg(I_X) : (const void*)out, (L) != 0, ldarg(I_N1G) + (size_t)L * DM, modl, 0, true, L == 2, L == 0 ? nullptr : modl - 5 * NMOD + 4 * NMOD + 5 * DM, DIR_N1 != 0); BAR_AFTER(pb + 0); } \
        if (EN_G1 && RUN(pb + 1)) { \
            pg8::Gemm g{HX, (const bf16*)WSP(WS_WQKV + wqkv_off(L)), MT, nq, DM}; pg8::StaticOrder S; S.init(MT, nq, F.ng(), F.bx_(), DM); S.wgm = WGM_G1; S.ord = ORD_G1; \
            if ((L) == 2 || !((QKF_MASK >> (L)) & 1)) { pg8::EpiStore E{QKVb, nq}; \
                for (int rep_ = 0; rep_ < REP_G1; ++rep_) pg8::gemm_phase<pg8::EpiStore, pg8::StaticOrder, true, PG8_SP2>(F.ldsp() + RING_OFF, g, S, E, F.wv()); } \
            else { pg8::EpiQK E{QKVb, nq, (NH + ((L) == 0 ? 16 : ((L) == 1 ? 2 : 4))) / 2, ldarg((L) == 0 ? I_NAQG : ((L) == 1 ? I_SWQG : I_GQQG)), ldarg((L) == 0 ? I_NAKG : ((L) == 1 ? I_SWKG : I_GQKG)), \
                    (L) == 0 ? (const float*)nullptr : (const float*)WSP(WS_ROPE), (L) == 0 ? (const float*)nullptr : (const float*)WSP(WS_ROPE) + 4096, (PG8_LAS float*)(F.ldsp() + QKX_OFF)}; \
                for (int rep_ = 0; rep_ < REP_G1; ++rep_) pg8::gemm_phase<pg8::EpiQK, pg8::StaticOrder, true, PG8_SP2>(F.ldsp() + RING_OFF, g, S, E, F.wv()); } \
            if (TAILFILL && TAIL_OWN3 && (L) == 3) convert_tail<3>(F, args, (MT / 256) * (nq / 256), conv_items(3) * (TAIL1_PCT + TAIL3_PCT) / 100, conv_items(3)); \
            if (TAILFILL && TAIL1_PCT > 0 && (L) < 3) convert_tail<((L) < 3 ? (L) + 1 : 3)>(F, args, (MT / 256) * (nq / 256), 0, conv_items((L) < 3 ? (L) + 1 : 3) * TAIL1_PCT / 100); \
            BAR_AFTER(pb + 1); } \
        if (EN_QKN && L != 2 && RUN(pb + 2)) { \
            const float* qg = ldarg(L == 0 ? I_NAQG : (L == 1 ? I_SWQG : I_GQQG)); const float* kg = ldarg(L == 0 ? I_NAKG : (L == 1 ? I_SWKG : I_GQKG)); \
            for (int rep_ = 0; rep_ < REP_QKN; ++rep_) qkn_phase(F, args, nq, NH + (L == 0 ? 16 : (L == 1 ? 2 : 4)), qg, kg, L != 0, rep_ > 0, QFUSE ? NH : 0); BAR_AFTER(pb + 2); } \
        if (RUN(pb + 3)) { \
            if (EN_A0 && L == 0) for (int rep_ = 0; rep_ < REP_A0; ++rep_) att::attn_phase<0>(F, args, nq, 16, ldarg(I_NARB), true, QFUSE ? ldarg(I_NAQG) : nullptr, nullptr); \
            else if (EN_A1 && L == 1) for (int rep_ = 0; rep_ < REP_A1; ++rep_) att::attn_phase<1>(F, args, nq, 2, ldarg(I_SWSINK), true, QFUSE ? ldarg(I_SWQG) : nullptr, (const float*)WSP(WS_ROPE)); \
            else if (EN_ML && L == 2) for (int rep_ = 0; rep_ < REP_ML; ++rep_) { if (rep_) xcd_barrier(bar); if (EN_MLA) ml::mlstm_pre_a(F, args); if (REP_MLA == 2) ml::mlstm_pre_a(F, args); xcd_barrier(bar); if (EN_MLB) ml::mlstm_pre_b(F, args); xcd_barrier(bar); if (EN_MLS) ml::mlstm_scan(F, args); if (REP_MLS == 2) ml::mlstm_scan(F, args); } \
            else if (EN_A3 && L == 3) for (int rep_ = 0; rep_ < REP_A3; ++rep_) att::attn_phase<3>(F, args, nq, 4, nullptr, false, QFUSE ? ldarg(I_GQQG) : nullptr, (const float*)WSP(WS_ROPE)); \
            BAR_AFTER(pb + 3); } \
        if (EN_RO && L == 2 && RUN(pb + 4)) { for (int rep_ = 0; rep_ < REP_RO; ++rep_) mlro_phase(F, args); BAR_AFTER(pb + 4); } \
        if (EN_G2 && RUN(pb + 5)) { \
            pg8::Gemm g{L == 2 ? HX : AOb, (const bf16*)WSP(WS_WO) + (size_t)L * DM * DM, MLAT, DM, DM}; pg8::StaticOrder S; S.init(MLAT, DM, F.ng(), F.bx_(), DM, last ? 0 : 8, 4); S.wgm = WGM_G2; S.ord = ORD_G2; \
            pg8::EpiResidT<(L) != 0, true> E{L == 0 ? (const void*)ldarg(I_X) : (const void*)out, last ? (void*)WSP(WS_HB) : (void*)out, (float*)WSP(WS_PART), modl + 2 * DM, DM, NMOD}; \
            for (int rep_ = 0; rep_ < REP_G2; ++rep_) { if (rep_) { E.out_lat = (void*)WSP(WS_QKV); } \
                pg8::gemm_phase<pg8::EpiResidT<(L) != 0, true>, pg8::StaticOrder, true, PG8_SP2>(F.ldsp() + RING_OFF, g, S, E, F.wv()); } \
            BAR_AFTER(pb + 5); } \
        if (EN_NORM && RUN(pb + 6)) { for (int rep_ = 0; rep_ < REP_NORM; ++rep_) norm_phase(F, args, last ? (const void*)WSP(WS_HB) : (const void*)out, true, ldarg(I_N2G) + (size_t)L * DM, modl, 3, !last, false, last ? nullptr : modl + 4 * NMOD + 2 * DM, DIR_N2 != 0); BAR_AFTER(pb + 6); } \
        if (EN_G3 && RUN(pb + 7)) { \
            pg8::Gemm g{HX, (const bf16*)WSP(WS_WIN) + (size_t)L * 2 * DFF * DM, mrows, 2 * DFF, DM}; pg8::StaticOrder S; S.init(mrows, 2 * DFF, F.ng(), F.bx_(), DM); S.wgm = WGM_G3; S.ord = ORD_G3; \
            pg8::EpiGlu E{ACT, (float*)WSP(WS_EDGE), ldarg(I_FCW) + (size_t)L * 3 * DFF, ldarg(I_FCB) + (size_t)L * DFF, (PG8_LAS float*)(F.ldsp() + XB_OFF), DFF}; \
            for (int rep_ = 0; rep_ < REP_G3; ++rep_) pg8::gemm_phase<pg8::EpiGlu, pg8::StaticOrder, true, PG8_SP2>(F.ldsp() + RING_OFF, g, S, E, F.wv()); \
            if (TAILFILL && TAIL3_PCT > 0 && (L) < 3) convert_tail<((L) < 3 ? (L) + 1 : 3)>(F, args, (mrows / 256) * (2 * DFF / 256), conv_items((L) < 3 ? (L) + 1 : 3) * TAIL1_PCT / 100, conv_items((L) < 3 ? (L) + 1 : 3) * (TAIL1_PCT + TAIL3_PCT) / 100); \
            BAR_AFTER(pb + 7); } \
        if (EN_FIX && RUN(pb + 8)) { for (int rep_ = 0; rep_ < REP_FIX; ++rep_) fix_phase(F, args, L, last ? 128 : 132); BAR_AFTER(pb + 8); } \
        if (EN_G4 && RUN(pb + 9)) { \
            pg8::Gemm g{ACT, (const bf16*)WSP(WS_WOUT) + (size_t)L * DM * DFF, MLAT, DM, DFF}; pg8::StaticOrder S; S.init(MLAT, DM, F.ng(), F.bx_(), DFF, last ? 0 : 8, 4); S.wgm = WGM_G4; S.ord = ORD_G4; \
            pg8::EpiResidT<true, (L) != 3> E{last ? (const void*)WSP(WS_HB) : (const void*)out, (void*)out, (float*)WSP(WS_PART), modl + 5 * DM, DM, NMOD}; \
            for (int rep_ = 0; rep_ < REP_G4; ++rep_) { if (rep_) { E.out_lat = (void*)WSP(WS_AO); } \
                pg8::gemm_phase<pg8::EpiResidT<true, (L) != 3>, pg8::StaticOrder, true, PG8_SP2>(F.ldsp() + RING_OFF, g, S, E, F.wv()); } \
            BAR_AFTER(pb + 9); } \
    }
    LAYER_BODY(0) LAYER_BODY(1) LAYER_BODY(2) LAYER_BODY(3)
#undef LAYER_BODY
#undef RUN
#undef WSP
#undef HX
#undef QKVb
#undef AOb
#undef ACT
#undef BAR_AFTER
}

static bool phase_exists(int ph) { if (ph < 2) return true; const int L = (ph - 2) / 10, k = (ph - 2) % 10; if (k == 2) return L != 2 && !((QKF_MASK >> L) & 1); if (k == 4) return L == 2; return true; }
extern "C" void kernel_launch(void* const* d_in, const int* in_sizes, int n_in, void* d_out, int out_size, void* d_ws, size_t ws_size, hipStream_t stream) {
    static int grid = 0;
    if (grid == 0) {
        if (n_in != N_IN || out_size != MLAT * DM || ws_size < WS_END) { fprintf(stderr, "kernel_launch: unexpected shapes: n_in %d out %d ws %zu (need %zu)\n", n_in, out_size, ws_size, (size_t)WS_END); grid = -1; return; }
        int dev = 0, cus = 0, per_cu = 0;
        if (hipGetDevice(&dev) != hipSuccess || hipDeviceGetAttribute(&cus, hipDeviceAttributeMultiprocessorCount, dev) != hipSuccess) { grid = -1; return; }
        if (hipFuncSetAttribute((const void*)fwd, hipFuncAttributeMaxDynamicSharedMemorySize, LDS_BYTES) != hipSuccess) { fprintf(stderr, "kernel_launch: hipFuncSetAttribute failed\n"); grid = -1; return; }
        if (hipOccupancyMaxActiveBlocksPerMultiprocessor(&per_cu, (const void*)fwd, NWAVES * 64, LDS_BYTES) != hipSuccess || per_cu < 1) fprintf(stderr, "kernel_launch: occupancy query reports %d\n", per_cu);
        (void)hipGetLastError();
        grid = cus;
    }
    if (grid < 0) return;
    (void)hipMemsetAsync((char*)d_ws + WS_CTL, 0, MK_MODE == 0 ? (size_t)(CW_BAR + XCD_BAR_WORDS) * 4 : CTL_ZERO_BYTES, stream);
    Args a{};
    for (int i = 0; i < N_IN; ++i) a.in[i] = (const float*)d_in[i];
    a.out = (float*)d_out; a.ws = (unsigned char*)d_ws;
#if MK_MODE == 0
    a.ph_lo = 0; a.ph_hi = NPH;
    hipLaunchKernelGGL(fwd, dim3(grid), dim3(NWAVES * 64), LDS_BYTES, stream, a);
#else
    for (int ph = 0; ph < NPH; ++ph) { if (!phase_exists(ph)) continue; a.ph_lo = ph; a.ph_hi = ph + 1;
        hipLaunchKernelGGL(fwd, dim3(grid), dim3(NWAVES * 64), LDS_BYTES, stream, a); }
#endif
    const hipError_t le = hipPeekAtLastError();
    if (le != hipSuccess) fprintf(stderr, "kernel_launch: launch failed: %s\n", hipGetErrorName(le));
}
```
